# Optimizing an MI355X kernel written in HIP

```python
import math
import jax, jax.numpy as jnp
from jax import lax
import numpy as np

D_MODEL = 1024
BATCH = 8
SEQ = 2048
DEPTH = 2
DEC_BATCH = 128
DEC_SEQ = 1
PAST_LEN = 16384
PAGE_SIZE = 128


N_META = 16
EPS = 1e-6
GLA_HEADS = 4
GLA_DK = 64
GLA_DV = 128
GLA_RANK = 16
GLA_TAU = 16.0
GLA_CHUNK = 64
GLA_K = GLA_HEADS * GLA_DK
GLA_V = GLA_HEADS * GLA_DV
S5_GROUPS = 32
S5_H = 16
S5_P = 64
S5_W = S5_GROUPS * S5_H
IN0 = 2 * GLA_K + 2 * GLA_V + GLA_RANK + S5_W
SPLIT0 = [GLA_K, 2 * GLA_K, 2 * GLA_K + GLA_V, 2 * GLA_K + 2 * GLA_V, 2 * GLA_K + 2 * GLA_V + GLA_RANK]
RNN_W = 1536
RNN_BLOCKS = 16
RNN_BW = RNN_W // RNN_BLOCKS
RNN_C = 8.0
RNN_CONV = 4
D_FF = 2816
FFN_CONV = 3

kernel_name = 'hybrid_gla_s5_rglru_convffn_step'


def rmsnorm(x, g):
    xf = x.astype(jnp.float32)
    y = xf * lax.rsqrt(jnp.mean(xf * xf, axis=-1, keepdims=True) + EPS)
    return (y * g.astype(jnp.float32)).astype(x.dtype)


def causal_dwconv(x, buf, w, b):
    W = w.shape[0]
    T = x.shape[1]
    xx = jnp.concatenate([buf.astype(x.dtype), x], axis=1)
    y = b + xx[:, 0:T] * w[0]
    for j in range(1, W):
        y = y + xx[:, j:j + T] * w[j]
    return y, xx[:, -(W - 1):]


def _lin_combine(e1, e2):
    a1, b1 = e1
    a2, b2 = e2
    return a1 * a2, a2 * b1 + b2


def _cplx_combine(e1, e2):
    a1r, a1i, b1r, b1i = e1
    a2r, a2i, b2r, b2i = e2
    return (a2r * a1r - a2i * a1i, a2r * a1i + a2i * a1r,
            a2r * b1r - a2i * b1i + b2r, a2r * b1i + a2i * b1r + b2i)


def gla_chunked(q, k, v, log_a, s0):
    B_, T = q.shape[:2]
    c = min(GLA_CHUNK, T)
    pad = (-T) % c
    n = (T + pad) // c

    def prep(z):
        z = jnp.pad(z.astype(jnp.float32), ((0, 0), (pad, 0), (0, 0), (0, 0)))
        return z.reshape(B_, n, c, GLA_HEADS, z.shape[-1]).transpose(1, 0, 3, 2, 4)

    qc, kc, vc, ac = prep(q), prep(k), prep(v), prep(log_a)
    mask = jnp.tril(jnp.ones((c, c), bool))[:, :, None]

    def step(S, xs):
        qi, ki, vi, ai = xs
        b = jnp.cumsum(ai, axis=2)
        o = jnp.einsum('bhcd,bhde->bhce', qi * jnp.exp(b), S)
        rel = b[:, :, :, None, :] - b[:, :, None, :, :]
        decay = jnp.exp(jnp.where(mask, rel, -jnp.inf))
        att = jnp.einsum('bhid,bhjd,bhijd->bhij', qi, ki, decay)
        o = o + jnp.einsum('bhij,bhje->bhie', att, vi)
        b_last = b[:, :, -1:, :]
        S = jnp.exp(b_last[:, :, 0, :, None]) * S + jnp.einsum('bhcd,bhce->bhde', ki * jnp.exp(b_last - b), vi)
        return S, o

    S, o = lax.scan(step, s0.astype(jnp.float32), (qc, kc, vc, ac))
    o = o.transpose(1, 0, 3, 2, 4).reshape(B_, T + pad, GLA_HEADS, GLA_DV)[:, pad:]
    return o, S


def s5_mixer(u, x0_re, x0_im, lam_re, lam_im, log_dt, b_re, b_im, c_re, c_im, d, w_glu, b_glu):
    f32 = jnp.float32
    B_, T = u.shape[:2]
    uf = u.astype(f32).reshape(B_, T, S5_GROUPS, S5_H)
    lr, li = lam_re.astype(f32), lam_im.astype(f32)
    dt = jnp.exp(log_dt.astype(f32))[:, None]
    mag = jnp.exp(lr * dt)
    ab_re, ab_im = mag * jnp.cos(li * dt), mag * jnp.sin(li * dt)
    den = lr * lr + li * li
    nr, ni = ab_re - 1.0, ab_im
    f_re = (nr * lr + ni * li) / den
    f_im = (ni * lr - nr * li) / den
    br, bi = b_re.astype(f32), b_im.astype(f32)
    bb_re = f_re[..., None] * br - f_im[..., None] * bi
    bb_im = f_re[..., None] * bi + f_im[..., None] * br
    bu_re = jnp.einsum('gph,btgh->btgp', bb_re, uf)
    bu_im = jnp.einsum('gph,btgh->btgp', bb_im, uf)
    full = (B_, T, S5_GROUPS, S5_P)
    a_re = jnp.broadcast_to(ab_re, full)
    a_im = jnp.broadcast_to(ab_im, full)
    Ar, Ai, xr, xi = lax.associative_scan(_cplx_combine, (a_re, a_im, bu_re, bu_im), axis=1)
    x0r = x0_re.astype(f32)[:, None]
    x0i = x0_im.astype(f32)[:, None]
    xr, xi = xr + Ar * x0r - Ai * x0i, xi + Ar * x0i + Ai * x0r
    y = (jnp.einsum('ghp,btgp->btgh', c_re.astype(f32), xr)
         - jnp.einsum('ghp,btgp->btgh', c_im.astype(f32), xi)
         + d.astype(f32) * uf).reshape(B_, T, S5_W)
    y = jax.nn.gelu(y)
    y = y * jax.nn.sigmoid(y @ w_glu.astype(f32) + b_glu.astype(f32))
    return y, xr[:, -1], xi[:, -1]


def even_mixer(x, s_gla, s_re, s_im, norm_mix, w_in, w_alpha, b_alpha, gla_norm,
               lam_re, lam_im, log_dt, b_re, b_im, c_re, c_im, d, w_glu, b_glu, w_out):
    B_, T, _ = x.shape
    z = rmsnorm(x, norm_mix) @ w_in
    q, k, v, g, lr, u = jnp.split(z, SPLIT0, axis=-1)
    log_a = jax.nn.log_sigmoid((lr @ w_alpha + b_alpha).astype(jnp.float32)) / GLA_TAU
    hd = lambda t, dh: t.reshape(B_, T, GLA_HEADS, dh)
    o, s_gla = gla_chunked(hd(q, GLA_DK) * (GLA_DK ** -0.5), hd(k, GLA_DK), hd(v, GLA_DV),
                           hd(log_a, GLA_DK), s_gla)
    o = rmsnorm(o, gla_norm).reshape(B_, T, GLA_V) * jax.nn.silu(g.astype(jnp.float32))
    y5, s_re, s_im = s5_mixer(u, s_re, s_im, lam_re, lam_im, log_dt, b_re, b_im, c_re, c_im, d, w_glu, b_glu)
    mix = jnp.concatenate([o, y5], axis=-1).astype(x.dtype) @ w_out
    return x + mix, s_gla, s_re, s_im


def odd_mixer(x, h0, conv_buf, norm_mix, w_in, conv_w, conv_b, w_a, b_a, w_x, b_x, lam, w_out):
    f32 = jnp.float32
    B_, T, _ = x.shape
    z = rmsnorm(x, norm_mix) @ w_in
    gate, xr = jnp.split(z, 2, axis=-1)
    xc, new_buf = causal_dwconv(xr, conv_buf, conv_w, conv_b)
    xc = xc.astype(f32)
    xb = xc.reshape(B_, T, RNN_BLOCKS, RNN_BW)
    r = jax.nn.sigmoid(jnp.einsum('btnc,ncd->btnd', xb, w_a.astype(f32)) + b_a.astype(f32)).reshape(B_, T, RNN_W)
    i = jax.nn.sigmoid(jnp.einsum('btnc,ncd->btnd', xb, w_x.astype(f32)) + b_x.astype(f32)).reshape(B_, T, RNN_W)
    log_a = -RNN_C * r * jax.nn.softplus(-lam.astype(f32))
    a = jnp.exp(log_a)
    bx = jnp.sqrt(-jnp.expm1(2.0 * log_a)) * (i * xc)
    a_cum, h = lax.associative_scan(_lin_combine, (a, bx), axis=1)
    h = h + a_cum * h0.astype(f32)[:, None]
    y = (h * jax.nn.gelu(gate.astype(f32))).astype(x.dtype) @ w_out
    return x + y, h[:, -1], new_buf


def conv_ffn(x, buf, norm, w_up, conv_w, conv_b, w_down):
    hup = rmsnorm(x, norm) @ w_up
    gate, val = jnp.split(hup, 2, axis=-1)
    gate, new_buf = causal_dwconv(gate, buf, conv_w, conv_b)
    return x + (jax.nn.gelu(gate) * val) @ w_down, new_buf


def trunk(x, s_gla, s_re, s_im, h_rnn, buf_rnn, buf_ffn, mix0, mix1, ffn, norm_final):
    norm_ffn, w_up, f_conv_w, f_conv_b, w_down = ffn
    new_ffn = []
    for layer in range(DEPTH):
        if layer % 2 == 0:
            x, s_gla, s_re, s_im = even_mixer(x, s_gla, s_re, s_im, *mix0)
        else:
            x, h_rnn, buf_rnn = odd_mixer(x, h_rnn, buf_rnn, *mix1)
        x, nb = conv_ffn(x, buf_ffn[layer], norm_ffn[layer], w_up[layer], f_conv_w[layer],
                         f_conv_b[layer], w_down[layer])
        new_ffn.append(nb)
    return rmsnorm(x, norm_final), s_gla, s_re, s_im, h_rnn, buf_rnn, jnp.stack(new_ffn)


def setup_inputs(seed: int = 0) -> dict:
    key = jax.random.key(seed)
    ks = iter(jax.random.split(key, 64))
    f32 = jnp.float32
    nrm = lambda shape, scale: jax.random.normal(next(ks), shape, f32) * scale
    gain = lambda shape: 1.0 + nrm(shape, 0.02)
    lam_re = -0.5 + nrm((S5_GROUPS, S5_P), 0.01)
    lam_im = math.pi * jnp.arange(S5_P, dtype=f32)[None, :] + nrm((S5_GROUPS, S5_P), 0.01)
    log_dt = jax.random.uniform(next(ks), (S5_GROUPS,), f32, math.log(1e-3), math.log(1e-1))
    d_a = jax.random.uniform(next(ks), (RNN_W,), f32, 0.9, 0.999) ** (1.0 / RNN_C)
    rnn_lam = jnp.log(d_a) - jnp.log1p(-d_a)
    return {
        'x_prompt': nrm((BATCH, SEQ, D_MODEL), 1.0),
        'x_sample': nrm((DEC_BATCH, DEC_SEQ, D_MODEL), 1.0),
        'state_gla': nrm((DEC_BATCH, GLA_HEADS, GLA_DK, GLA_DV), 0.5),
        'state_s5_re': nrm((DEC_BATCH, S5_GROUPS, S5_P), 0.3),
        'state_s5_im': nrm((DEC_BATCH, S5_GROUPS, S5_P), 0.3),
        'state_rglru': nrm((DEC_BATCH, RNN_W), 0.5),
        'cache_rglru_conv': nrm((DEC_BATCH, RNN_CONV - 1, RNN_W), 1.0),
        'cache_ffn_conv': nrm((DEPTH, DEC_BATCH, FFN_CONV - 1, D_FF), 1.0),
        'meta_tokens': nrm((N_META, D_MODEL), 1.0),
        'norm_mix_0': gain((D_MODEL,)),
        'w_in_0': nrm((D_MODEL, IN0), D_MODEL ** -0.5),
        'w_alpha_0': nrm((GLA_RANK, GLA_K), GLA_RANK ** -0.5),
        'b_alpha_0': nrm((GLA_K,), 0.1),
        'gla_norm_0': gain((GLA_HEADS, GLA_DV)),
        's5_lam_re': lam_re,
        's5_lam_im': lam_im,
        's5_log_dt': log_dt,
        's5_b_re': nrm((S5_GROUPS, S5_P, S5_H), (0.5 / S5_H) ** 0.5),
        's5_b_im': nrm((S5_GROUPS, S5_P, S5_H), (0.5 / S5_H) ** 0.5),
        's5_c_re': nrm((S5_GROUPS, S5_H, S5_P), S5_P ** -0.5),
        's5_c_im': nrm((S5_GROUPS, S5_H, S5_P), S5_P ** -0.5),
        's5_d': nrm((S5_GROUPS, S5_H), 1.0),
        's5_w_glu': nrm((S5_W, S5_W), S5_W ** -0.5),
        's5_b_glu': nrm((S5_W,), 0.02),
        'w_out_0': nrm((GLA_V + S5_W, D_MODEL), (GLA_V + S5_W) ** -0.5),
        'norm_mix_1': gain((D_MODEL,)),
        'w_in_1': nrm((D_MODEL, 2 * RNN_W), D_MODEL ** -0.5),
        'rnn_conv_w': nrm((RNN_CONV, RNN_W), RNN_CONV ** -0.5),
        'rnn_conv_b': nrm((RNN_W,), 0.02),
        'rnn_w_a': nrm((RNN_BLOCKS, RNN_BW, RNN_BW), RNN_BW ** -0.5),
        'rnn_b_a': nrm((RNN_BLOCKS, RNN_BW), 0.02),
        'rnn_w_x': nrm((RNN_BLOCKS, RNN_BW, RNN_BW), RNN_BW ** -0.5),
        'rnn_b_x': nrm((RNN_BLOCKS, RNN_BW), 0.02),
        'rnn_lam': rnn_lam,
        'w_out_1': nrm((RNN_W, D_MODEL), RNN_W ** -0.5),
        'norm_ffn': gain((DEPTH, D_MODEL)),
        'ffn_w_up': nrm((DEPTH, D_MODEL, 2 * D_FF), D_MODEL ** -0.5),
        'ffn_conv_w': nrm((DEPTH, FFN_CONV, D_FF), FFN_CONV ** -0.5),
        'ffn_conv_b': nrm((DEPTH, D_FF), 0.02),
        'ffn_w_down': nrm((DEPTH, D_FF, D_MODEL), D_FF ** -0.5),
        'norm_final': gain((D_MODEL,)),
    }


def reference(x_prompt, x_sample, state_gla, state_s5_re, state_s5_im, state_rglru, cache_rglru_conv,
              cache_ffn_conv, meta_tokens, norm_mix_0, w_in_0, w_alpha_0, b_alpha_0, gla_norm_0,
              s5_lam_re, s5_lam_im, s5_log_dt, s5_b_re, s5_b_im, s5_c_re, s5_c_im, s5_d, s5_w_glu,
              s5_b_glu, w_out_0, norm_mix_1, w_in_1, rnn_conv_w, rnn_conv_b, rnn_w_a, rnn_b_a, rnn_w_x,
              rnn_b_x, rnn_lam, w_out_1, norm_ffn, ffn_w_up, ffn_conv_w, ffn_conv_b, ffn_w_down, norm_final):
    f32 = jnp.float32
    mix0 = (norm_mix_0, w_in_0, w_alpha_0, b_alpha_0, gla_norm_0, s5_lam_re, s5_lam_im, s5_log_dt,
            s5_b_re, s5_b_im, s5_c_re, s5_c_im, s5_d, s5_w_glu, s5_b_glu, w_out_0)
    mix1 = (norm_mix_1, w_in_1, rnn_conv_w, rnn_conv_b, rnn_w_a, rnn_b_a, rnn_w_x, rnn_b_x, rnn_lam, w_out_1)
    ffn = (norm_ffn, ffn_w_up, ffn_conv_w, ffn_conv_b, ffn_w_down)

    bp = x_prompt.shape[0]
    meta = jnp.broadcast_to(meta_tokens.astype(x_prompt.dtype)[None], (bp, N_META, D_MODEL))
    xp = jnp.concatenate([meta, x_prompt], axis=1)
    yp, gla_p, re_p, im_p, h_p, rc_p, fc_p = trunk(
        xp,
        jnp.zeros((bp, GLA_HEADS, GLA_DK, GLA_DV), f32),
        jnp.zeros((bp, S5_GROUPS, S5_P), f32),
        jnp.zeros((bp, S5_GROUPS, S5_P), f32),
        jnp.zeros((bp, RNN_W), f32),
        jnp.zeros((bp, RNN_CONV - 1, RNN_W), x_prompt.dtype),
        jnp.zeros((DEPTH, bp, FFN_CONV - 1, D_FF), x_prompt.dtype),
        mix0, mix1, ffn, norm_final)
    yp = yp[:, N_META:]

    ys, gla_s, re_s, im_s, h_s, rc_s, fc_s = trunk(
        x_sample, state_gla, state_s5_re, state_s5_im, state_rglru, cache_rglru_conv, cache_ffn_conv,
        mix0, mix1, ffn, norm_final)

    return (yp, ys, gla_p, gla_s, re_p, re_s, im_p, im_s, h_p, h_s, rc_p, rc_s, fc_p, fc_s)
```

```cpp
#include <hip/hip_runtime.h>
#include <hip/hip_cooperative_groups.h>
#include <stdint.h>
#include <stdio.h>
namespace cg = cooperative_groups;

#ifndef MK_MULTI
#define MK_MULTI 0
#endif

#define LAS __attribute__((address_space(3)))
typedef unsigned short bf16_t;
typedef __attribute__((ext_vector_type(8))) short bf16x8;
typedef __attribute__((ext_vector_type(4))) float f32x4;

#define TP 2064
#define NPR 16512
#define NR 16640
#define EPSN 1e-6f
#define NPHASE 15
#define LDS_BYTES 153600
#define HALF_LDS 75776
#define LDS_SRS 151552
#define LDS_ST 152576
#define LDS_TKL 152592
#define NTHR 512

#define O_YP 0
#define O_YS 16777216
#define O_GLAP 16908288
#define O_GLAS 17170432
#define O_S5RP 21364736
#define O_S5RS 21381120
#define O_S5IP 21643264
#define O_S5IS 21659648
#define O_HP 21921792
#define O_HS 21934080
#define O_RCP 22130688
#define O_RCS 22167552
#define O_FCP 22757376
#define O_FCS 22847488

#define W_IN0 0
#define W_GLU 2359296
#define W_OUT0 2621440
#define W_UP 3670016
#define W_DOWN 15204352
#define W_IN1 20971520
#define W_OUT1 24117248
#define W_GATE 25690112

#define WS_XB 0ull
#define WS_XRES 34078720ull
#define WS_SSQ 102236160ull
#define WS_S5AB 106496000ull
#define WS_S5BB 106545152ull
#define WS_S5CC 106807296ull
#define WS_XLOC 106938368ull
#define WS_XST 111263744ull
#define WS_DEC 115589120ull
#define WS_SCR 115859456ull
#define SCR_ZB 0ull
#define SCR_ALOG 68157440ull
#define SCR_SLOC 85196800ull
#define SCR_ACT 0ull
#define SCR_XR 0ull
#define SCR_GG 51118080ull
#define WS_BAR (WS_SCR + 119799808ull)
#define WS_ZERO (WS_BAR + 15360ull)
#define WS_NSP (WS_BAR + 16384ull)
#define WS_SLAB (WS_NSP + 8192ull)
#define WS_FLAG (WS_SLAB + 12582912ull)
#define WS_SSQ2 (WS_FLAG + 20480ull)
#define WS_NEED (WS_SSQ2 + 8519680ull)

struct Params {
  const float* in[41];
  float* out;
  char* ws;
  int ph_lo, ph_hi;
};

__device__ __forceinline__ bf16_t f2bf(float f) { uint32_t u = __float_as_uint(f); u += 0x7fffu + ((u >> 16) & 1u); return (bf16_t)(u >> 16); }
__device__ __forceinline__ float bf2f(bf16_t h) { return __uint_as_float(((uint32_t)h) << 16); }
__device__ __forceinline__ uint32_t pack2(float a, float b) { return (uint32_t)f2bf(a) | ((uint32_t)f2bf(b) << 16); }
__device__ __forceinline__ float lo2f(uint32_t u) { return __uint_as_float(u << 16); }
__device__ __forceinline__ float hi2f(uint32_t u) { return __uint_as_float(u & 0xffff0000u); }
__device__ __forceinline__ float sigm(float x) { return 1.f / (1.f + __expf(-x)); }
__device__ __forceinline__ float gelu_t(float x) { float z = 0.7978845608f * (x + 0.044715f * x * x * x); float e = __expf(2.f * z); float t = 1.f - 2.f / (e + 1.f); return 0.5f * x * (1.f + t); }
__device__ __forceinline__ float softplusf_(float x) { return fmaxf(x, 0.f) + log1pf(__expf(-fabsf(x))); }
__device__ __forceinline__ float wave_sum(float v) {
#pragma unroll
  for (int o = 1; o < 64; o <<= 1) v += __shfl_xor(v, o);
  return v;
}
__device__ __forceinline__ int toff(int row, int chunk) { return row * 128 + ((chunk ^ (row & 7)) << 4); }
__device__ __forceinline__ f32x4 mfma16(bf16x8 a, bf16x8 b, f32x4 c) { return __builtin_amdgcn_mfma_f32_16x16x32_bf16(a, b, c, 0, 0, 0); }

__device__ __forceinline__ const float* xrow_src(const Params& p, int r) {
  if (r >= NPR) return p.in[1] + (size_t)(r - NPR) * 1024;
  int b = r / TP, t = r - b * TP;
  return t < 16 ? p.in[8] + t * 1024 : p.in[0] + ((size_t)b * 2048 + (t - 16)) * 1024;
}

#define TREFRESH() do { tid = threadIdx.x; asm volatile("" : "+v"(tid)); lane = tid & 63; w = tid >> 6; wr = w >> 2; wc = w & 3; lr = lane & 15; lq = lane >> 4; (void)w; (void)lane; } while (0)
__device__ __forceinline__ int lds_byte8(int r, int c) { const int st = (r >> 4) * 2 + (c >> 5), rr = r & 15, cc = c & 31, ob = rr * 64 + cc * 2; return st * 1024 + (ob ^ (((ob >> 9) & 1) << 5)); }
__device__ __forceinline__ void stage_rc8(int b, int& R, int& C) { const int st = b / 1024, sb = b % 1024, swz = sb ^ (((sb >> 9) & 1) << 5); R = (st >> 1) * 16 + swz / 64; C = (st & 1) * 32 + (swz % 64) / 2; }
template <class AF>
__device__ __forceinline__ void gemm_tile256(f32x4 (&acc)[8][4], const bf16_t* Ab, AF arow, const bf16_t* Bt, int ldb, int K, char* lds, const bf16_t* zpage) {
  const int wid = threadIdx.x >> 6, lane = threadIdx.x & 63, wr = wid >> 2, wc = wid & 3, fr = lane & 15, fq = lane >> 4;
#pragma unroll
  for (int m = 0; m < 8; ++m)
#pragma unroll
    for (int n = 0; n < 4; ++n) acc[m][n] = (f32x4){0.f, 0.f, 0.f, 0.f};
  int ao[2][2], bo[2][2];
#pragma unroll
  for (int i = 0; i < 2; ++i) {
    int r_, c_; stage_rc8(threadIdx.x * 16 + i * 8192, r_, c_);
#pragma unroll
    for (int h = 0; h < 2; ++h) {
      const int a = arow(h * 128 + r_);
      ao[h][i] = (a + c_) * 2;
      bo[h][i] = ((h * 128 + r_) * ldb + c_) * 2;
      asm volatile("" : "+v"(ao[h][i]), "+v"(bo[h][i]));
    }
  }
  char* lth = lds + threadIdx.x * 16;
  const __amdgpu_buffer_rsrc_t rA = __builtin_amdgcn_make_buffer_rsrc((void*)const_cast<bf16_t*>(Ab), (short)0, 0x7fffffff, 0x00020000);
  const __amdgpu_buffer_rsrc_t rB = __builtin_amdgcn_make_buffer_rsrc((void*)const_cast<bf16_t*>(Bt), (short)0, 0x7fffffff, 0x00020000);
#define SA8(b, h) (((b) * 2 + (h)) * 16384)
#define SB8(b, h) ((4 + (b) * 2 + (h)) * 16384)
#define STG_A(P, h, kt) do { _Pragma("unroll") for (int i_ = 0; i_ < 2; ++i_) \
    __builtin_amdgcn_raw_ptr_buffer_load_lds(rA, (LAS void*)(lth + (P) + i_ * 8192), 16, ao[h][i_], (kt) * 128, 0, 0); } while (0)
#define STG_B(P, h, kt) do { _Pragma("unroll") for (int i_ = 0; i_ < 2; ++i_) \
    __builtin_amdgcn_raw_ptr_buffer_load_lds(rB, (LAS void*)(lth + (P) + i_ * 8192), 16, bo[h][i_], (kt) * 128, 0, 0); } while (0)
#define LDA8(dst, b, h) do { _Pragma("unroll") for (int m = 0; m < 4; ++m) _Pragma("unroll") for (int k = 0; k < 2; ++k) \
    dst[m][k] = *(const bf16x8*)(lds + SA8(b, h) + lds_byte8(wr * 64 + m * 16 + fr, k * 32 + fq * 8)); } while (0)
#define LDB8(dst, b, h) do { _Pragma("unroll") for (int n = 0; n < 2; ++n) _Pragma("unroll") for (int k = 0; k < 2; ++k) \
    dst[n][k] = *(const bf16x8*)(lds + SB8(b, h) + lds_byte8(wc * 32 + n * 16 + fr, k * 32 + fq * 8)); } while (0)
#define MMA8(ai, bj, Ax, Bx) do { __builtin_amdgcn_s_setprio(1); \
    _Pragma("unroll") for (int m = 0; m < 4; ++m) _Pragma("unroll") for (int n = 0; n < 2; ++n) _Pragma("unroll") for (int k = 0; k < 2; ++k) \
      acc[(ai) * 4 + m][(bj) * 2 + n] = mfma16(Bx[n][k], Ax[m][k], acc[(ai) * 4 + m][(bj) * 2 + n]); \
    __builtin_amdgcn_s_setprio(0); } while (0)
#define WAIT_V(n) asm volatile("s_waitcnt vmcnt(" #n ")" ::: "memory")
#define WAIT_L(n) asm volatile("s_waitcnt lgkmcnt(" #n ")" ::: "memory")
#define BAR8 __builtin_amdgcn_s_barrier()
#define SCHED8 __builtin_amdgcn_sched_barrier(0)
  bf16x8 At[4][2], B0[2][2], B1[2][2];
  const int nt = K >> 6;
  STG_B(SB8(0, 0), 0, 0); STG_A(SA8(0, 0), 0, 0);
  STG_B(SB8(0, 1), 1, 0); STG_A(SA8(0, 1), 1, 0);
  if (wr == 1) BAR8;
  WAIT_V(4); BAR8;
  STG_B(SB8(1, 0), 0, 1); STG_A(SA8(1, 0), 0, 1); STG_B(SB8(1, 1), 1, 1);
  WAIT_V(6); BAR8;
  for (int t = 0; t < nt - 2; t += 2) {
    LDB8(B0, 0, 0); SCHED8; LDA8(At, 0, 0); STG_A(SA8(1, 1), 1, t + 1);
    WAIT_L(8); BAR8; WAIT_L(0); MMA8(0, 0, At, B0); BAR8; SCHED8;
    LDB8(B1, 0, 1); STG_B(SB8(0, 0), 0, t + 2);
    BAR8; WAIT_L(0); MMA8(0, 1, At, B1); BAR8;
    LDA8(At, 0, 1); STG_A(SA8(0, 0), 0, t + 2);
    BAR8; WAIT_L(0); MMA8(1, 0, At, B0); BAR8; SCHED8;
    STG_B(SB8(0, 1), 1, t + 2);
    WAIT_V(6); BAR8; MMA8(1, 1, At, B1); BAR8;
    LDB8(B0, 1, 0); SCHED8; LDA8(At, 1, 0); STG_A(SA8(0, 1), 1, t + 2);
    WAIT_L(8); BAR8; WAIT_L(0); MMA8(0, 0, At, B0); BAR8; SCHED8;
    LDB8(B1, 1, 1); STG_B(SB8(1, 0), 0, t + 3);
    BAR8; WAIT_L(0); MMA8(0, 1, At, B1); BAR8;
    LDA8(At, 1, 1); STG_A(SA8(1, 0), 0, t + 3);
    BAR8; WAIT_L(0); MMA8(1, 0, At, B0); BAR8; SCHED8;
    STG_B(SB8(1, 1), 1, t + 3);
    WAIT_V(6); BAR8; MMA8(1, 1, At, B1); BAR8;
  }
  { LDB8(B0, 0, 0); LDA8(At, 0, 0); STG_A(SA8(1, 1), 1, nt - 1);
    BAR8; WAIT_L(0); MMA8(0, 0, At, B0); BAR8;
    LDB8(B1, 0, 1); BAR8; WAIT_L(0); MMA8(0, 1, At, B1); BAR8;
    LDA8(At, 0, 1); WAIT_V(4); BAR8; WAIT_L(0); MMA8(1, 0, At, B0); MMA8(1, 1, At, B1); BAR8; }
  { LDB8(B0, 1, 0); LDA8(At, 1, 0); WAIT_V(2); BAR8; WAIT_L(0); MMA8(0, 0, At, B0); BAR8;
    LDB8(B1, 1, 1); WAIT_V(0); BAR8; WAIT_L(0); MMA8(0, 1, At, B1); BAR8;
    LDA8(At, 1, 1); BAR8; WAIT_L(0); MMA8(1, 0, At, B0); MMA8(1, 1, At, B1); BAR8; }
  if (wr == 0) BAR8;
#undef SA8
#undef SB8
#undef STG_A
#undef STG_B
#undef LDA8
#undef LDB8
#undef MMA8
  __syncthreads();
}

#define XB_TMO      128
#define XB_XCNT(j)  (256  + 64 * (j))
#define XB_XSUB(j)  (1280 + 64 * (j))
#define XB_XGEN(j)  (2304 + 64 * (j))
#define XB_TOP      3328
#define XB_TOPGEN   3392
#define XCD_BAR_WORDS 3456
#define XB_SPIN_CAP (1u << 22)
__device__ __forceinline__ unsigned xb_ld(unsigned* p)              { return __hip_atomic_load(p, __ATOMIC_RELAXED, __HIP_MEMORY_SCOPE_AGENT); }
__device__ __forceinline__ unsigned xb_add(unsigned* p, unsigned v) { return __hip_atomic_fetch_add(p, v, __ATOMIC_RELAXED, __HIP_MEMORY_SCOPE_AGENT); }
__device__ __forceinline__ unsigned xb_xcc_id() { return (unsigned)__builtin_amdgcn_s_getreg((3 << 11) | 20) & 0xFu; }
#define XB_SPIN(cond, bar) do { unsigned _sp = 0; while (cond) { __builtin_amdgcn_s_sleep(1); \
    if ((++_sp & 255u) == 0u) { if (xb_ld(&(bar)[XB_TMO])) break; if (_sp > XB_SPIN_CAP) { atomicAdd(&(bar)[XB_TMO], 1u); break; } } } } while (0)
struct XcdBarrier { unsigned* bar; unsigned x; volatile LAS unsigned* st; };
__device__ __forceinline__ XcdBarrier xcd_barrier_post(unsigned* bar, volatile LAS unsigned* st) {
    XcdBarrier b; b.bar = bar; b.x = xb_xcc_id(); b.st = st;
    if (threadIdx.x == 0) (void)xb_add(&bar[XB_XCNT(b.x)], 1u);
    return b;
}
__device__ __forceinline__ void xcd_barrier_complete(unsigned* bar, unsigned x, unsigned& nloc, unsigned& nx) {
    const unsigned G = gridDim.x * gridDim.y * gridDim.z;
    unsigned sum, cnt, mine, sp = 0u;
    for (;;) {
        sum = 0u; cnt = 0u; mine = 0u;
#pragma unroll
        for (unsigned j = 0; j < 16; ++j) { const unsigned c = xb_ld(&bar[XB_XCNT(j)]); sum += c; cnt += (c > 0u) ? 1u : 0u; mine = (j == x) ? c : mine; }
        if (sum == G) break;
        __builtin_amdgcn_s_sleep(1);
        if ((++sp & 255u) == 0u) { if (xb_ld(&bar[XB_TMO])) break; if (sp > XB_SPIN_CAP) { atomicAdd(&bar[XB_TMO], 1u); break; } }
    }
    nloc = mine > 0u ? mine : 1u; nx = cnt > 0u ? cnt : 1u;
}
__device__ __forceinline__ void xcd_barrier(const XcdBarrier& b) {
    asm volatile("s_waitcnt vmcnt(0)" ::: "memory");
    __syncthreads();
    if (threadIdx.x == 0) {
        unsigned* bar = b.bar;
        __builtin_amdgcn_s_waitcnt(0);
        unsigned nloc = b.st[0], nx = b.st[1];
        if (nloc == 0u) { xcd_barrier_complete(bar, b.x, nloc, nx); b.st[0] = nloc; b.st[1] = nx; }
        const unsigned old = xb_add(&bar[XB_XSUB(b.x)], 1u);
        const unsigned gen = old / nloc;
        if (old + 1u == (gen + 1u) * nloc) {
            __builtin_amdgcn_fence(__ATOMIC_RELEASE, "agent");
            asm volatile("s_waitcnt vmcnt(0)" ::: "memory");
            const unsigned og = xb_add(&bar[XB_TOP], 1u);
            const unsigned tg = og / nx;
            if (og + 1u == (tg + 1u) * nx) xb_add(&bar[XB_TOPGEN], 1u);
            else XB_SPIN(xb_ld(&bar[XB_TOPGEN]) == tg, bar);
            __builtin_amdgcn_fence(__ATOMIC_ACQUIRE, "agent");
            xb_add(&bar[XB_XGEN(b.x)], 1u);
            asm volatile("s_waitcnt vmcnt(0)" ::: "memory");
        } else {
            XB_SPIN(xb_ld(&bar[XB_XGEN(b.x)]) == gen, bar);
            __builtin_amdgcn_fence(__ATOMIC_ACQUIRE, "agent");
            asm volatile("s_waitcnt vmcnt(0)" ::: "memory");
        }
    }
    __syncthreads();
}


struct TileSched {
  int NT, m0, cnt, ntiles, nfull, local, nloc;
  __device__ __forceinline__ void init(int MT, int NT_) {
    NT = NT_;
    const int x = blockIdx.x & 7; local = blockIdx.x >> 3; nloc = gridDim.x >> 3;
    const int q = MT >> 3, r = MT & 7;
    cnt = q + (x < r ? 1 : 0); m0 = x * q + (x < r ? x : r);
    ntiles = cnt * NT; nfull = cnt >> 3;
  }
  int MTe, lin0;
  __device__ __forceinline__ void init_even(int MT, int NT_) {
    NT = NT_; MTe = MT;
    const int x = blockIdx.x & 7; local = blockIdx.x >> 3; nloc = gridDim.x >> 3;
    const int T = MT * NT_;
    lin0 = (int)(((long)T * x) >> 3);
    ntiles = (int)(((long)T * (x + 1)) >> 3) - lin0;
  }
  __device__ __forceinline__ void get_even(int i, int& mt, int& nt) const {
    const int L = lin0 + i, nfullg = MTe >> 3, full = nfullg * 8 * NT;
    if (L < full) { const int grp = L / (8 * NT), rem = L - grp * 8 * NT; nt = rem >> 3; mt = grp * 8 + (rem & 7); }
    else { const int i2 = L - full, gs = MTe - nfullg * 8; nt = i2 / gs; mt = nfullg * 8 + (i2 - nt * gs); }
  }
  __device__ __forceinline__ void get(int i, int& mt, int& nt) const {
    const int full = nfull * 8 * NT;
    if (i < full) { const int grp = i / (8 * NT), rem = i - grp * 8 * NT; nt = rem >> 3; mt = m0 + grp * 8 + (rem & 7); }
    else { const int i2 = i - full, gs = cnt - nfull * 8; nt = i2 / gs; mt = m0 + nfull * 8 + (i2 - nt * gs); }
  }
};

__device__ __forceinline__ float row_rstd(const float* ssq, int row) {
  float s = 0.f;
#pragma unroll
  for (int q = 0; q < 4; ++q) s += ssq[(size_t)q * NR + row];
  return rsqrtf(s * (1.f / 1024.f) + EPSN);
}

__device__ __forceinline__ void transpose_mat(const float* src, int ldsrc, int K, int N, bf16_t* dst, const float* scale, int kind, float* sm) {
  const int tid = threadIdx.x & 255;
  sm += (threadIdx.x >> 8) * 8448;
  const int nnb = N >> 7, ntile = (K >> 6) * nnb;
  for (int tile2 = blockIdx.x; tile2 < (ntile >> 1); tile2 += gridDim.x) {
    const int tile = tile2 * 2 + (threadIdx.x >> 8);
    const int kb = tile / nnb, nb4 = tile - kb * nnb;
    const int i = tid >> 3, j4 = tid & 7;
    float4 v[4][2];
#pragma unroll
    for (int sub = 0; sub < 4; ++sub) {
      const int nb = nb4 * 4 + sub;
      int scol;
      if (kind == 0) scol = nb * 32;
      else if (kind == 1) scol = nb * 32 < 1536 ? nb * 32 : nb * 32 + 16;
      else { int j = nb >> 3, half = (nb >> 2) & 1; scol = half * 2816 + j * 128 + (nb & 3) * 32; }
#pragma unroll
      for (int r = 0; r < 2; ++r) v[sub][r] = *(const float4*)(src + (size_t)(kb * 64 + i + 32 * r) * ldsrc + scol + j4 * 4);
    }
    const float sc0 = scale ? scale[kb * 64 + i] : 1.f, sc1 = scale ? scale[kb * 64 + i + 32] : 1.f;
#pragma unroll
    for (int sub = 0; sub < 4; ++sub) {
#pragma unroll
      for (int r = 0; r < 2; ++r) {
        const float sc = r ? sc1 : sc0;
        float* d = sm + sub * 2112 + (i + 32 * r) * 33 + j4 * 4;
        d[0] = v[sub][r].x * sc; d[1] = v[sub][r].y * sc; d[2] = v[sub][r].z * sc; d[3] = v[sub][r].w * sc;
      }
    }
    __syncthreads();
    {
      const int n = tid >> 3, kq = tid & 7;
#pragma unroll
      for (int sub = 0; sub < 4; ++sub) {
        const float* s2 = sm + sub * 2112 + (kq * 8) * 33 + n;
        uint4 o;
        o.x = pack2(s2[0], s2[33]); o.y = pack2(s2[66], s2[99]); o.z = pack2(s2[132], s2[165]); o.w = pack2(s2[198], s2[231]);
        *(uint4*)(dst + (size_t)((nb4 * 4 + sub) * 32 + n) * K + kb * 64 + kq * 8) = o;
      }
    }
    __syncthreads();
  }
}

__device__ __forceinline__ void phase_prep(const Params& p, char* lds) {
  const int tid = threadIdx.x, lane = tid & 63;
  bf16_t* wb = (bf16_t*)p.out;
  {
    bf16_t* xb = (bf16_t*)(p.ws + WS_XB);
    float* ssq = (float*)(p.ws + WS_SSQ2);
    const int gw = blockIdx.x * 8 + (tid >> 6), nw = gridDim.x * 8;
    for (int r = gw; r < NR; r += nw) {
      const float4* src = (const float4*)xrow_src(p, r);
      float s = 0.f;
#pragma unroll
      for (int j = 0; j < 4; ++j) {
        float4 v = src[lane + 64 * j];
        s += v.x * v.x + v.y * v.y + v.z * v.z + v.w * v.w;
        uint2 o; o.x = pack2(v.x, v.y); o.y = pack2(v.z, v.w);
        *(uint2*)(xb + (size_t)r * 1024 + (lane + 64 * j) * 4) = o;
      }
      s = wave_sum(s);
      if (lane < 4) ssq[(size_t)lane * NR + r] = lane == 0 ? s : 0.f;
    }
  }
  float* sm = (float*)lds;
  transpose_mat(p.in[10], 2064, 1024, 2048, wb + W_IN0, p.in[9], 1, sm);
  transpose_mat(p.in[22], 512, 512, 512, wb + W_GLU, nullptr, 0, sm);
  transpose_mat(p.in[24], 1024, 1024, 1024, wb + W_OUT0, nullptr, 0, sm);
  transpose_mat(p.in[36], 5632, 1024, 5632, wb + W_UP, p.in[35], 2, sm);
  transpose_mat(p.in[36] + (size_t)1024 * 5632, 5632, 1024, 5632, wb + W_UP + (size_t)5632 * 1024, p.in[35] + 1024, 2, sm);
  transpose_mat(p.in[39], 1024, 2816, 1024, wb + W_DOWN, nullptr, 0, sm);
  transpose_mat(p.in[39] + (size_t)2816 * 1024, 1024, 2816, 1024, wb + W_DOWN + (size_t)1024 * 2816, nullptr, 0, sm);
  transpose_mat(p.in[26], 3072, 1024, 3072, wb + W_IN1, p.in[25], 0, sm);
  transpose_mat(p.in[34], 1024, 1536, 1024, wb + W_OUT1, nullptr, 0, sm);
  const int gt = blockIdx.x * 512 + tid, ngt = gridDim.x * 512;
  for (int idx = gt; idx < 256 * 1024; idx += ngt) {
    const int c = idx >> 10, k = idx & 1023;
    const float* wi = p.in[10] + (size_t)k * 2064 + 1536;
    float s = 0.f;
#pragma unroll
    for (int r = 0; r < 16; ++r) s += wi[r] * p.in[11][r * 256 + c];
    wb[W_IN0 + (size_t)(2048 + c) * 1024 + k] = f2bf(s * p.in[9][k]);
  }
  for (int idx = gt; idx < 2 * 16 * 96 * 96; idx += ngt) {
    const int mat = idx / 147456, rem = idx - mat * 147456;
    const int nb = rem / 9216, r2 = rem - nb * 9216, d = r2 / 96, c = r2 - d * 96;
    const float* src = mat ? p.in[31] : p.in[29];
    wb[W_GATE + idx] = f2bf(src[nb * 9216 + c * 96 + d]);
  }
  for (int idx = gt; idx < 1536; idx += ngt) ((float*)(p.ws + WS_NSP))[idx] = -8.f * softplusf_(-p.in[33][idx]);
  for (int idx = gt; idx < 2048; idx += ngt) {
    const int g = idx >> 6;
    const float dt = expf(p.in[16][g]);
    const float lr = p.in[14][idx], li = p.in[15][idx];
    const float y = li * dt;
    const float kk = rintf(y * 0.15915494309189535f);
    float yr = fmaf(-kk, 6.2831854820251465f, y);
    yr = fmaf(-kk, -1.7484555e-7f, yr);
    const float sn = sinf(yr), cs = cosf(yr);
    const float mag = expf(lr * dt);
    const float abr = mag * cs, abi = mag * sn;
    const float sh = sinf(0.5f * yr);
    const float nr = expm1f(lr * dt) * cs - 2.f * sh * sh, ni = abi;
    const float den = lr * lr + li * li;
    const float fr = (nr * lr + ni * li) / den, fi = (ni * lr - nr * li) / den;
    float* ab = (float*)(p.ws + WS_S5AB);
    ab[idx] = abr; ab[2048 + idx] = abi;
    float pr = abr, pi = abi;
#pragma unroll
    for (int q = 0; q < 4; ++q) { float t = pr * pr - pi * pi; pi = 2.f * pr * pi; pr = t; }
    ab[4096 + idx] = pr; ab[6144 + idx] = pi;
#pragma unroll
    for (int q = 0; q < 2; ++q) { float t = pr * pr - pi * pi; pi = 2.f * pr * pi; pr = t; }
    ab[8192 + idx] = pr; ab[10240 + idx] = pi;
    float* bbr = (float*)(p.ws + WS_S5BB);
    float* bbi = bbr + 2048 * 16;
#pragma unroll
    for (int h = 0; h < 16; ++h) {
      const float br = p.in[17][idx * 16 + h], bi = p.in[18][idx * 16 + h];
      bbr[idx * 16 + h] = fr * br - fi * bi;
      bbi[idx * 16 + h] = fr * bi + fi * br;
    }
    bf16_t* cc = (bf16_t*)(p.ws + WS_S5CC);
    const int pp = idx & 63;
#pragma unroll
    for (int h = 0; h < 16; ++h) {
      cc[(g * 16 + h) * 128 + 2 * pp] = f2bf(p.in[19][(g * 16 + h) * 64 + pp]);
      cc[(g * 16 + h) * 128 + 2 * pp + 1] = f2bf(-p.in[20][(g * 16 + h) * 64 + pp]);
    }
  }
}

__device__ __forceinline__ void g1_store(const Params& p, bf16_t* zb, float* alog, int row, int col, float v0, float v1, float v2, float v3) {
  if (col < 2048) {
    if (col < 256) { v0 *= 0.125f; v1 *= 0.125f; v2 *= 0.125f; v3 *= 0.125f; }
    uint2 o; o.x = pack2(v0, v1); o.y = pack2(v2, v3);
    *(uint2*)(zb + (size_t)row * 2048 + col) = o;
  } else {
    const int c = col - 2048;
    const float4 ba = *(const float4*)(p.in[12] + c);
    float4 o;
    o.x = -softplusf_(-(v0 + ba.x)) * 0.0625f; o.y = -softplusf_(-(v1 + ba.y)) * 0.0625f;
    o.z = -softplusf_(-(v2 + ba.z)) * 0.0625f; o.w = -softplusf_(-(v3 + ba.w)) * 0.0625f;
    *(float4*)(alog + (size_t)row * 256 + c) = o;
  }
}
__device__ __forceinline__ void phase_g1(const Params& p, char* lds) {
  int tid, lane, w, wr, wc, lr, lq; TREFRESH();
  const bf16_t* zp = (const bf16_t*)(p.ws + WS_ZERO);
  const bf16_t* xb = (const bf16_t*)(p.ws + WS_XB);
  const bf16_t* W = (const bf16_t*)p.out + W_IN0;
  const float* ssq = (const float*)(p.ws + WS_SSQ2);
  bf16_t* zb = (bf16_t*)(p.ws + WS_SCR + SCR_ZB);
  float* alog = (float*)(p.ws + WS_SCR + SCR_ALOG);
  float* srs = (float*)(lds + LDS_SRS);
  unsigned* flg = (unsigned*)(p.ws + WS_FLAG);
  const int u = blockIdx.x;
  const bool unitA = u < 128, unitB = u >= 128 && u < 164;
  const int umt = unitA ? (u >> 1) : 64, unt = unitA ? 8 : ((u - 128) >> 2), uks = unitA ? (u & 1) : ((u - 128) & 3);
  const int uK = unitA ? 512 : 256, nsl = unitA ? 2 : 4;
  float* slab0 = unitA ? (float*)(p.ws + WS_SCR + SCR_SLOC) + (size_t)(u >> 1) * 2 * 65536 : (float*)(p.ws + WS_SLAB) + (size_t)unt * 4 * 65536;
  unsigned* tick = unitA ? flg + 4432 + (u >> 1) : flg + 4496 + unt;
  if (unitA || unitB) {
    const int k0 = uks * uK;
    f32x4 acc[8][4];
    gemm_tile256(acc, xb + k0, [&](int i) { return (umt * 256 + i) * 1024; }, W + (size_t)unt * 256 * 1024 + k0, 1024, uK, lds, zp);
    TREFRESH(); int zE = 0; asm volatile("" : "+v"(zE));
    float* slab = slab0 + (size_t)uks * 65536;
#pragma unroll
    for (int m = 0; m < 8; ++m)
#pragma unroll
      for (int n = 0; n < 4; ++n)
        *(float4*)(slab + ((m >> 2) * 128 + wr * 64 + (m & 3) * 16 + lr + zE) * 256 + (n >> 1) * 128 + wc * 32 + (n & 1) * 16 + lq * 4 + zE) = make_float4(acc[m][n][0], acc[m][n][1], acc[m][n][2], acc[m][n][3]);
    asm volatile("s_waitcnt vmcnt(0)" ::: "memory");
    __syncthreads();
    if (tid == 0) {
      __builtin_amdgcn_fence(__ATOMIC_RELEASE, "agent");
      asm volatile("s_waitcnt vmcnt(0)" ::: "memory");
      (void)xb_add(tick, 1u);
    }
  }
  TileSched ts; ts.init(64, 8);
  for (int ti = ts.local; ti < ts.ntiles; ti += ts.nloc) {
    int mt, nt; ts.get(ti, mt, nt);
    if (tid < 256) srs[tid] = row_rstd(ssq, mt * 256 + tid);
    f32x4 acc[8][4];
    gemm_tile256(acc, xb, [&](int i) { return (mt * 256 + i) * 1024; }, W + (size_t)nt * 256 * 1024, 1024, 1024, lds, zp);
    TREFRESH(); int zE = 0; asm volatile("" : "+v"(zE));
#pragma unroll
    for (int m = 0; m < 8; ++m) {
      const int r = (m >> 2) * 128 + wr * 64 + (m & 3) * 16 + lr + zE, row = mt * 256 + r;
      const float rs = srs[r];
#pragma unroll
      for (int n = 0; n < 4; ++n) {
        const int col = nt * 256 + (n >> 1) * 128 + wc * 32 + (n & 1) * 16 + lq * 4 + zE;
        f32x4 v = acc[m][n] * rs;
        if (col < 256) v = v * 0.125f;
        uint2 o; o.x = pack2(v[0], v[1]); o.y = pack2(v[2], v[3]);
        *(uint2*)(zb + (size_t)row * 2048 + col) = o;
      }
    }
    __syncthreads();
  }
  if (unitA || unitB) {
    if (tid == 0) {
      XB_SPIN(xb_ld(tick) < (unsigned)nsl, (unsigned*)(p.ws + WS_BAR));
      __builtin_amdgcn_fence(__ATOMIC_ACQUIRE, "agent");
      asm volatile("s_waitcnt vmcnt(0)" ::: "memory");
    }
    __syncthreads();
    const int rpb = 256 / nsl, r0 = uks * rpb;
    for (int rr = r0 + (tid >> 6); rr < r0 + rpb; rr += 8) {
      const int c4 = tid & 63, row = umt * 256 + rr, col = unt * 256 + c4 * 4;
      const float* s4 = slab0 + rr * 256 + c4 * 4;
      float4 sum = make_float4(0.f, 0.f, 0.f, 0.f);
      for (int q = 0; q < nsl; ++q) { const float4 v = *(const float4*)(s4 + (size_t)q * 65536); sum.x += v.x; sum.y += v.y; sum.z += v.z; sum.w += v.w; }
      const float rs = row_rstd(ssq, row);
      g1_store(p, zb, alog, row, col, sum.x * rs, sum.y * rs, sum.z * rs, sum.w * rs);
    }
  }
}

__device__ __forceinline__ void gla_chunk(const Params& p, int item, int mode, char* lds) {
  const int tid = threadIdx.x & 255, lane = tid & 63, w = tid >> 6, lr = lane & 15, lq = lane >> 4;
  const int bh = item / 33, c = item - bh * 33, b = bh >> 2, h = bh & 3;
  const int row0 = b * TP + (c == 0 ? 0 : 16 + 64 * (c - 1));
  const int len = c == 0 ? 16 : 64;
  bf16_t* zb = (bf16_t*)(p.ws + WS_SCR + SCR_ZB);
  const float* alog = (const float*)(p.ws + WS_SCR + SCR_ALOG);
  float* sloc = (float*)(p.ws + WS_SCR + SCR_SLOC) + (size_t)(bh * 33 + c) * 8192;
  float* sb = (float*)lds;
  char* Qs = lds + 16384; char* Ks = lds + 24576; char* VT = lds + 32768; char* ST = lds + 49152;
#pragma unroll
  for (int i = 0; i < 4; ++i) {
    const int idx = tid + 256 * i, r = idx >> 4, c4 = idx & 15;
    float4 v = make_float4(0.f, 0.f, 0.f, 0.f);
    if (r < len) v = *(const float4*)(alog + (size_t)(row0 + r) * 256 + h * 64 + c4 * 4);
    *(float4*)(sb + r * 64 + c4 * 4) = v;
  }
  __syncthreads();
  {
    float run = 0.f;
#pragma unroll
    for (int t = 0; t < 16; ++t) { run += sb[(16 * w + t) * 64 + lane]; sb[(16 * w + t) * 64 + lane] = run; }
  }
  __syncthreads();
  float off = 0.f;
#pragma unroll
  for (int s = 0; s < 3; ++s) if (s < w) off += sb[(16 * s + 15) * 64 + lane];
  __syncthreads();
#pragma unroll
  for (int t = 0; t < 16; ++t) sb[(16 * w + t) * 64 + lane] += off;
  __syncthreads();
#pragma unroll
  for (int i = 0; i < 2; ++i) {
    const int idx = tid + 256 * i, r = idx & 63, ch = idx >> 6;
    uint4 qv = make_uint4(0, 0, 0, 0), kv = make_uint4(0, 0, 0, 0);
    if (r < len) {
      const bf16_t* zr = zb + (size_t)(row0 + r) * 2048 + h * 64 + ch * 8;
      qv = *(const uint4*)zr; kv = *(const uint4*)(zr + 256);
    }
    float bv[8];
#pragma unroll
    for (int e = 0; e < 8; ++e) bv[e] = sb[r * 64 + ch * 8 + e];
    const uint32_t qq[4] = {qv.x, qv.y, qv.z, qv.w}, kq[4] = {kv.x, kv.y, kv.z, kv.w};
    if (mode == 1) {
      uint32_t oq[4], ok[4];
#pragma unroll
      for (int e = 0; e < 4; ++e) {
        const float e0 = __expf(bv[2 * e]), e1 = __expf(bv[2 * e + 1]);
        oq[e] = pack2(lo2f(qq[e]) * e0, hi2f(qq[e]) * e1);
        ok[e] = pack2(lo2f(kq[e]) / e0, hi2f(kq[e]) / e1);
      }
      *(uint4*)(Qs + toff(r, ch)) = make_uint4(oq[0], oq[1], oq[2], oq[3]);
      *(uint4*)(Ks + toff(r, ch)) = make_uint4(ok[0], ok[1], ok[2], ok[3]);
    } else {
#pragma unroll
      for (int e = 0; e < 8; ++e) {
        const int d = ch * 8 + e;
        const float kf = (e & 1) ? hi2f(kq[e >> 1]) : lo2f(kq[e >> 1]);
        const float kh = kf * __expf(sb[63 * 64 + d] - bv[e]);
        *(bf16_t*)(Qs + d * 128 + ((((r >> 3) ^ (d & 7))) << 4) + (r & 7) * 2) = f2bf(kh);
      }
    }
  }
#pragma unroll
  for (int i = 0; i < 4; ++i) {
    const int idx = tid + 256 * i, r = idx & 63, ch = idx >> 6;
    uint4 vv = make_uint4(0, 0, 0, 0);
    if (r < len) vv = *(const uint4*)(zb + (size_t)(row0 + r) * 2048 + 512 + h * 128 + ch * 8);
    const uint32_t vq[4] = {vv.x, vv.y, vv.z, vv.w};
#pragma unroll
    for (int e = 0; e < 8; ++e) {
      const int ee = ch * 8 + e;
      const bf16_t val = (bf16_t)((e & 1) ? (vq[e >> 1] >> 16) : (vq[e >> 1] & 0xffffu));
      *(bf16_t*)(VT + ee * 128 + ((((r >> 3) ^ (ee & 7))) << 4) + (r & 7) * 2) = val;
    }
  }
  if (mode == 1) {
#pragma unroll
    for (int i = 0; i < 4; ++i) {
      const int idx = tid + 256 * i, e = idx >> 3, ch = idx & 7;
      const float4 a = *(const float4*)(sloc + e * 64 + ch * 8);
      const float4 bq = *(const float4*)(sloc + e * 64 + ch * 8 + 4);
      *(uint4*)(ST + toff(e, ch)) = make_uint4(pack2(a.x, a.y), pack2(a.z, a.w), pack2(bq.x, bq.y), pack2(bq.z, bq.w));
    }
  }
  __syncthreads();
  if (mode == 1) {
    f32x4 at[4];
#pragma unroll
    for (int n = 0; n < 4; ++n) at[n] = (f32x4){0.f, 0.f, 0.f, 0.f};
#pragma unroll
    for (int s = 0; s < 2; ++s) {
      const bf16x8 a = *(const bf16x8*)(Qs + toff(16 * w + lr, s * 4 + lq));
#pragma unroll
      for (int n = 0; n < 4; ++n) {
        const bf16x8 bk = *(const bf16x8*)(Ks + toff(16 * n + lr, s * 4 + lq));
        at[n] = mfma16(bk, a, at[n]);
      }
    }
    char* P = lds;
    const int i = 16 * w + lr;
#pragma unroll
    for (int n = 0; n < 4; ++n) {
      const int j0 = 16 * n + lq * 4;
      float v0 = (j0 + 0 <= i) ? at[n][0] : 0.f, v1 = (j0 + 1 <= i) ? at[n][1] : 0.f;
      float v2 = (j0 + 2 <= i) ? at[n][2] : 0.f, v3 = (j0 + 3 <= i) ? at[n][3] : 0.f;
      uint2 o; o.x = pack2(v0, v1); o.y = pack2(v2, v3);
      *(uint2*)(P + i * 128 + ((((j0 >> 3) ^ (i & 7))) << 4) + (j0 & 7) * 2) = o;
    }
    __syncthreads();
    f32x4 o[8];
#pragma unroll
    for (int n = 0; n < 8; ++n) o[n] = (f32x4){0.f, 0.f, 0.f, 0.f};
#pragma unroll
    for (int s = 0; s < 2; ++s) {
      const bf16x8 aP = *(const bf16x8*)(P + toff(16 * w + lr, s * 4 + lq));
      const bf16x8 aQ = *(const bf16x8*)(Qs + toff(16 * w + lr, s * 4 + lq));
#pragma unroll
      for (int n = 0; n < 8; ++n) {
        const bf16x8 bV = *(const bf16x8*)(VT + toff(16 * n + lr, s * 4 + lq));
        const bf16x8 bS = *(const bf16x8*)(ST + toff(16 * n + lr, s * 4 + lq));
        o[n] = mfma16(bV, aP, o[n]);
        o[n] = mfma16(bS, aQ, o[n]);
      }
    }
    float ss = 0.f;
#pragma unroll
    for (int n = 0; n < 8; ++n) ss += o[n][0] * o[n][0] + o[n][1] * o[n][1] + o[n][2] * o[n][2] + o[n][3] * o[n][3];
    ss += __shfl_xor(ss, 16); ss += __shfl_xor(ss, 32);
    const float rstd = rsqrtf(ss * (1.f / 128.f) + EPSN);
    if (i < len) {
      bf16_t* zr = zb + (size_t)(row0 + i) * 2048;
#pragma unroll
      for (int n = 0; n < 8; ++n) {
        const int e0 = 16 * n + lq * 4;
        const uint2 g2 = *(const uint2*)(zr + 1024 + h * 128 + e0);
        const float4 gn = *(const float4*)(p.in[13] + h * 128 + e0);
        const float g0 = lo2f(g2.x), g1 = hi2f(g2.x), g2f = lo2f(g2.y), g3 = hi2f(g2.y);
        uint2 ov;
        ov.x = pack2(o[n][0] * rstd * gn.x * g0 * sigm(g0), o[n][1] * rstd * gn.y * g1 * sigm(g1));
        ov.y = pack2(o[n][2] * rstd * gn.z * g2f * sigm(g2f), o[n][3] * rstd * gn.w * g3 * sigm(g3));
        *(uint2*)(zr + 512 + h * 128 + e0) = ov;
      }
    }
  } else {
    f32x4 sl[8];
#pragma unroll
    for (int n = 0; n < 8; ++n) sl[n] = (f32x4){0.f, 0.f, 0.f, 0.f};
#pragma unroll
    for (int s = 0; s < 2; ++s) {
      const bf16x8 aK = *(const bf16x8*)(Qs + toff(16 * w + lr, s * 4 + lq));
#pragma unroll
      for (int n = 0; n < 8; ++n) {
        const bf16x8 bV = *(const bf16x8*)(VT + toff(16 * n + lr, s * 4 + lq));
        sl[n] = mfma16(aK, bV, sl[n]);
      }
    }
#pragma unroll
    for (int n = 0; n < 8; ++n) {
      const int e = 16 * n + lr, d0 = 16 * w + lq * 4;
      *(float4*)(sloc + e * 64 + d0) = make_float4(sl[n][0], sl[n][1], sl[n][2], sl[n][3]);
    }
    if (tid < 64) ((float*)(p.ws + WS_DEC))[(bh * 33 + c) * 64 + tid] = __expf(sb[63 * 64 + tid]);
  }
  __syncthreads();
}

__device__ __forceinline__ void gla_sample(const Params& p, int item, char* lds) {
  const int tid = threadIdx.x & 255;
  const int s = item >> 2, h = item & 3, row = NPR + s;
  bf16_t* zb = (bf16_t*)(p.ws + WS_SCR + SCR_ZB);
  const float* alog = (const float*)(p.ws + WS_SCR + SCR_ALOG);
  float* sq = (float*)lds; float* sk = sq + 64; float* sa = sk + 64; float* part = sa + 64; float* red = part + 256;
  if (tid < 64) {
    sq[tid] = bf2f(zb[(size_t)row * 2048 + h * 64 + tid]);
    sk[tid] = bf2f(zb[(size_t)row * 2048 + 256 + h * 64 + tid]);
    sa[tid] = __expf(alog[(size_t)row * 256 + h * 64 + tid]);
  }
  __syncthreads();
  const int e = tid & 127, half = tid >> 7;
  const float v = bf2f(zb[(size_t)row * 2048 + 512 + h * 128 + e]);
  const float* S0 = p.in[2] + (size_t)(s * 4 + h) * 8192;
  float* So = p.out + O_GLAS + (size_t)(s * 4 + h) * 8192;
  float acc = 0.f;
#pragma unroll 8
  for (int dd = 0; dd < 32; ++dd) {
    const int d = half * 32 + dd;
    const float sn = sa[d] * S0[d * 128 + e] + sk[d] * v;
    So[d * 128 + e] = sn;
    acc += sq[d] * sn;
  }
  part[tid] = acc;
  __syncthreads();
  float o = 0.f;
  if (tid < 128) { o = part[tid] + part[tid + 128]; }
  float ssv = wave_sum(tid < 128 ? o * o : 0.f);
  if ((tid & 63) == 0) red[tid >> 6] = ssv;
  __syncthreads();
  if (tid < 128) {
    const float rstd = rsqrtf((red[0] + red[1]) * (1.f / 128.f) + EPSN);
    const float g = bf2f(zb[(size_t)row * 2048 + 1024 + h * 128 + e]);
    zb[(size_t)row * 2048 + 512 + h * 128 + e] = f2bf(o * rstd * p.in[13][h * 128 + e] * g * sigm(g));
  }
  __syncthreads();
}

typedef __attribute__((ext_vector_type(2))) float f32x2;
__device__ __forceinline__ void s5_load_u(const bf16_t* zb, int row0, int len, int g, int lane, char* ul) {
  uint4 a = make_uint4(0, 0, 0, 0), b = a;
  if (lane < len) {
    const uint4* s = (const uint4*)(zb + (size_t)(row0 + lane) * 2048 + 1536 + g * 16);
    a = s[0]; b = s[1];
  }
  float4* d = (float4*)(ul + lane * 64);
  d[0] = make_float4(lo2f(a.x), hi2f(a.x), lo2f(a.y), hi2f(a.y));
  d[1] = make_float4(lo2f(a.z), hi2f(a.z), lo2f(a.w), hi2f(a.w));
  d[2] = make_float4(lo2f(b.x), hi2f(b.x), lo2f(b.y), hi2f(b.y));
  d[3] = make_float4(lo2f(b.z), hi2f(b.z), lo2f(b.w), hi2f(b.w));
}
__device__ __forceinline__ void s5_load_bb(const float* bbrp, int idx, f32x2 (&bb)[16]) {
#pragma unroll
  for (int q = 0; q < 4; ++q) {
    const float4 x = *(const float4*)(bbrp + idx * 16 + q * 4), y = *(const float4*)(bbrp + 32768 + idx * 16 + q * 4);
    bb[4 * q] = (f32x2){x.x, y.x}; bb[4 * q + 1] = (f32x2){x.y, y.y}; bb[4 * q + 2] = (f32x2){x.z, y.z}; bb[4 * q + 3] = (f32x2){x.w, y.w};
  }
}
__device__ __forceinline__ void s5_step(const char* ul, int t, const f32x2 (&bb)[16], float ar, float ai, float& xr, float& xi) {
  const float4* u = (const float4*)(ul + t * 64);
  const float4 u0 = u[0], u1 = u[1], u2 = u[2], u3 = u[3];
  f32x2 acc = bb[0] * u0.x;
  acc += bb[1] * u0.y; acc += bb[2] * u0.z; acc += bb[3] * u0.w;
  acc += bb[4] * u1.x; acc += bb[5] * u1.y; acc += bb[6] * u1.z; acc += bb[7] * u1.w;
  acc += bb[8] * u2.x; acc += bb[9] * u2.y; acc += bb[10] * u2.z; acc += bb[11] * u2.w;
  acc += bb[12] * u3.x; acc += bb[13] * u3.y; acc += bb[14] * u3.z; acc += bb[15] * u3.w;
  const float nr = ar * xr - ai * xi + acc[0], ni = ar * xi + ai * xr + acc[1];
  xr = nr; xi = ni;
}

__device__ __forceinline__ void s5_pass1(const Params& p, char* lds) {
  const int tid = threadIdx.x, lane = tid & 63, w = tid >> 6;
  const bf16_t* zb = (const bf16_t*)(p.ws + WS_SCR + SCR_ZB);
  const float* ab = (const float*)(p.ws + WS_S5AB);
  const float* bbrp = (const float*)(p.ws + WS_S5BB);
  float* xloc = (float*)(p.ws + WS_XLOC);
  char* ul = lds + w * 4096;
  const int nitem = 8 * 32 * 32;
  for (int base = blockIdx.x * 8; base < nitem; base += gridDim.x * 8) {
    const int item = base + w;
    const bool valid = item < nitem;
    const int it = valid ? item : 0;
    const int bg = it >> 5, c = it & 31, b = bg >> 5, g = bg & 31;
    const int row0 = b * TP + (c == 0 ? 0 : 16 + 64 * (c - 1));
    const int len = c == 0 ? 16 : 64;
    const int idx = g * 64 + lane;
    f32x2 bb[16];
    s5_load_bb(bbrp, idx, bb);
    const float ar = ab[idx], ai = ab[2048 + idx];
    __syncthreads();
    s5_load_u(zb, row0, len, g, lane, ul);
    __syncthreads();
    float xr = 0.f, xi = 0.f;
    for (int t = 0; t < len; ++t) s5_step(ul, t, bb, ar, ai, xr, xi);
    if (valid) {
      xloc[(size_t)(bg * 33 + c) * 64 + lane] = xr;
      xloc[540672 + (size_t)(bg * 33 + c) * 64 + lane] = xi;
    }
  }
}

__device__ __forceinline__ void s5_pass2(const Params& p) {
  const int gt = blockIdx.x * 512 + threadIdx.x;
  if (gt >= 16384) return;
  const int bg = gt >> 6, pp = gt & 63, g = bg & 31, idx = g * 64 + pp;
  const float* ab = (const float*)(p.ws + WS_S5AB);
  const float* xloc = (const float*)(p.ws + WS_XLOC);
  float* xst = (float*)(p.ws + WS_XST);
  const float a16r = ab[4096 + idx], a16i = ab[6144 + idx], a64r = ab[8192 + idx], a64i = ab[10240 + idx];
  float xr = 0.f, xi = 0.f;
  const size_t o0 = (size_t)bg * 33 * 64 + pp;
  xst[o0] = 0.f; xst[540672 + o0] = 0.f;
#pragma unroll 1
  for (int c0 = 0; c0 < 32; c0 += 8) {
    float lr_[8], li_[8];
#pragma unroll
    for (int q = 0; q < 8; ++q) { lr_[q] = xloc[o0 + (c0 + q) * 64]; li_[q] = xloc[540672 + o0 + (c0 + q) * 64]; }
#pragma unroll
    for (int q = 0; q < 8; ++q) {
      const int c = c0 + q;
      const float Ar = c == 0 ? a16r : a64r, Ai = c == 0 ? a16i : a64i;
      const float nr = Ar * xr - Ai * xi + lr_[q], ni = Ar * xi + Ai * xr + li_[q];
      xr = nr; xi = ni;
      xst[o0 + (c + 1) * 64] = xr; xst[540672 + o0 + (c + 1) * 64] = xi;
    }
  }
}

__device__ __forceinline__ void s5_pass3(const Params& p, char* lds) {
  const int tid = threadIdx.x, lane = tid & 63, w = tid >> 6, lr = lane & 15, lq = lane >> 4;
  bf16_t* zb = (bf16_t*)(p.ws + WS_SCR + SCR_ZB);
  const float* ab = (const float*)(p.ws + WS_S5AB);
  const float* bbrp = (const float*)(p.ws + WS_S5BB);
  const float* xst = (const float*)(p.ws + WS_XST);
  const bf16_t* cc = (const bf16_t*)(p.ws + WS_S5CC);
  char* ul = lds + w * 4096;
  char* X = lds + 32768 + w * 8192;
  const int nprompt = 8 * 32 * 33, nitem = nprompt + 128 * 32;
  for (int base = blockIdx.x * 8; base < nitem; base += gridDim.x * 8) {
    const int item = base + w;
    const bool valid = item < nitem;
    const int it = valid ? item : 0;
    int b, g, c, row0, len; bool last, smp;
    float xr, xi;
    if (it < nprompt) {
      const int bg = it / 33; c = it - bg * 33; b = bg >> 5; g = bg & 31; smp = false;
      row0 = b * TP + (c == 0 ? 0 : 16 + 64 * (c - 1)); len = c == 0 ? 16 : 64; last = c == 32;
      xr = xst[(size_t)it * 64 + lane]; xi = xst[540672 + (size_t)it * 64 + lane];
    } else {
      const int i2 = it - nprompt; b = i2 >> 5; g = i2 & 31; c = 0; smp = true;
      row0 = NPR + b; len = 1; last = true;
      xr = p.in[3][(b * 32 + g) * 64 + lane]; xi = p.in[4][(b * 32 + g) * 64 + lane];
    }
    const int idx = g * 64 + lane;
    f32x2 bb[16];
    s5_load_bb(bbrp, idx, bb);
    const float ar = ab[idx], ai = ab[2048 + idx];
    bf16x8 bC[4];
#pragma unroll
    for (int s = 0; s < 4; ++s) bC[s] = *(const bf16x8*)(cc + (g * 16 + lr) * 128 + 32 * s + 8 * lq);
    const float4 dd = *(const float4*)(p.in[21] + g * 16 + lq * 4);
    __syncthreads();
    s5_load_u(zb, row0, len, g, lane, ul);
    __syncthreads();
#pragma unroll 1
    for (int half = 0; half < 2; ++half) {
      const int tl = len - 32 * half < 32 ? len - 32 * half : 32;
      for (int tt = 0; tt < tl; ++tt) {
        s5_step(ul, 32 * half + tt, bb, ar, ai, xr, xi);
        *(uint32_t*)(X + tt * 256 + ((((lane >> 2) ^ (tt & 15))) << 4) + (lane & 3) * 4) = pack2(xr, xi);
      }
      __syncthreads();
      f32x4 y[2];
#pragma unroll
      for (int m = 0; m < 2; ++m) {
        y[m] = (f32x4){0.f, 0.f, 0.f, 0.f};
        const int row = 16 * m + lr;
#pragma unroll
        for (int s = 0; s < 4; ++s) {
          const bf16x8 a = *(const bf16x8*)(X + row * 256 + ((((s * 4 + lq) ^ (row & 15))) << 4));
          y[m] = mfma16(bC[s], a, y[m]);
        }
      }
#pragma unroll
      for (int m = 0; m < 2; ++m) {
        const int t = 32 * half + 16 * m + lr;
        if (valid && t < len) {
          const float4 u4 = *(const float4*)(ul + t * 64 + lq * 16);
          const float y0 = gelu_t(y[m][0] + dd.x * u4.x), y1 = gelu_t(y[m][1] + dd.y * u4.y);
          const float y2 = gelu_t(y[m][2] + dd.z * u4.z), y3 = gelu_t(y[m][3] + dd.w * u4.w);
          uint2 o; o.x = pack2(y0, y1); o.y = pack2(y2, y3);
          *(uint2*)(zb + (size_t)(row0 + t) * 2048 + 1536 + g * 16 + lq * 4) = o;
        }
      }
      __syncthreads();
    }
    if (valid && last) {
      if (smp) { p.out[O_S5RS + (b * 32 + g) * 64 + lane] = xr; p.out[O_S5IS + (b * 32 + g) * 64 + lane] = xi; }
      else { p.out[O_S5RP + (b * 32 + g) * 64 + lane] = xr; p.out[O_S5IP + (b * 32 + g) * 64 + lane] = xi; }
    }
  }
}

__device__ __forceinline__ void phase_mix_a(const Params& p, char* lds) {
  { const int hf = threadIdx.x >> 8; for (int pr = blockIdx.x; pr < 16 * 33; pr += gridDim.x) gla_chunk(p, pr * 2 + hf, 0, lds + hf * HALF_LDS); }
  __syncthreads();
  s5_pass1(p, lds);
}
__device__ __forceinline__ void phase_mix_b(const Params& p) {
  float* slocb = (float*)(p.ws + WS_SCR + SCR_SLOC);
  const float* dec = (const float*)(p.ws + WS_DEC);
  const int gt = blockIdx.x * 512 + threadIdx.x, ngt = gridDim.x * 512;
#pragma unroll 1
  for (int idx = gt; idx < 32 * 8192; idx += ngt) {
    const int bh = idx >> 13, ed = idx & 8191, e = ed >> 6, d = ed & 63;
    float S = 0.f;
#pragma unroll 1
    for (int c0 = 0; c0 < 33; c0 += 11) {
      float tmp[11], dc[11];
#pragma unroll
      for (int q = 0; q < 11; ++q) { tmp[q] = slocb[(size_t)(bh * 33 + c0 + q) * 8192 + ed]; dc[q] = dec[(bh * 33 + c0 + q) * 64 + d]; }
#pragma unroll
      for (int q = 0; q < 11; ++q) { slocb[(size_t)(bh * 33 + c0 + q) * 8192 + ed] = S; S = dc[q] * S + tmp[q]; }
    }
    p.out[O_GLAP + (size_t)(bh * 64 + d) * 128 + e] = S;
  }
  s5_pass2(p);
}
__device__ __forceinline__ void phase_mix_c(const Params& p, char* lds) {
  const int hf = threadIdx.x >> 8;
  for (int pr = blockIdx.x; pr < 16 * 33; pr += gridDim.x) gla_chunk(p, pr * 2 + hf, 1, lds + hf * HALF_LDS);
  __syncthreads();
  for (int pr = blockIdx.x; pr < 256; pr += gridDim.x) gla_sample(p, pr * 2 + hf, lds + hf * HALF_LDS);
  __syncthreads();
  s5_pass3(p, lds);
}

__device__ __forceinline__ void phase_glu(const Params& p, char* lds) {
  int tid, lane, w, wr, wc, lr, lq; TREFRESH();
  const bf16_t* zp = (const bf16_t*)(p.ws + WS_ZERO);
  bf16_t* zb = (bf16_t*)(p.ws + WS_SCR + SCR_ZB);
  const bf16_t* W = (const bf16_t*)p.out + W_GLU;
  TileSched ts; ts.init(65, 2);
  for (int ti = ts.local; ti < ts.ntiles; ti += ts.nloc) {
    int mt, nt; ts.get(ti, mt, nt);
    f32x4 acc[8][4];
    gemm_tile256(acc, (const bf16_t*)zb + 1536, [&](int i) { return (mt * 256 + i) * 2048; }, W + (size_t)nt * 256 * 512, 512, 512, lds, zp);
    TREFRESH(); int zE = 0; asm volatile("" : "+v"(zE));
#pragma unroll
    for (int m = 0; m < 8; ++m) {
      const int row = mt * 256 + (m >> 2) * 128 + wr * 64 + (m & 3) * 16 + lr + zE;
#pragma unroll
      for (int n = 0; n < 4; ++n) {
        const int col = nt * 256 + (n >> 1) * 128 + wc * 32 + (n & 1) * 16 + lq * 4 + zE;
        const uint2 y2 = *(const uint2*)(zb + (size_t)row * 2048 + 1536 + col);
        const float4 bg = *(const float4*)(p.in[23] + col);
        uint2 o;
        o.x = pack2(lo2f(y2.x) * sigm(acc[m][n][0] + bg.x), hi2f(y2.x) * sigm(acc[m][n][1] + bg.y));
        o.y = pack2(lo2f(y2.y) * sigm(acc[m][n][2] + bg.z), hi2f(y2.y) * sigm(acc[m][n][3] + bg.w));
        *(uint2*)(zb + (size_t)row * 2048 + 1024 + col) = o;
      }
      asm volatile("" ::: "memory");
    }
  }
}

__device__ __forceinline__ void phase_resid(const Params& p, char* lds, const bf16_t* A, int lda, const bf16_t* W, int K, int tkbase, int site) {
  int tid, lane, w, wr, wc, lr, lq; TREFRESH();
  const bf16_t* zp = (const bf16_t*)(p.ws + WS_ZERO);
  bf16_t* xb = (bf16_t*)(p.ws + WS_XB);
  float* ssq = (float*)(p.ws + WS_SSQ2) + (size_t)site * 4 * NR;
  const int ks = K >> 8;
  const bool isunit = (int)blockIdx.x < 4 * ks;
  const int unt = (int)blockIdx.x / ks, uksi = (int)blockIdx.x - unt * ks;
  unsigned* tick = (unsigned*)(p.ws + WS_FLAG) + 4352 + tkbase;
  if (isunit) {
    const int nt = unt, k0 = uksi * 256;
    f32x4 acc[8][4];
    gemm_tile256(acc, A + k0, [&](int i) { return (16384 + i) * lda; }, W + (size_t)nt * 256 * K + k0, K, 256, lds, zp);
    TREFRESH(); int zE = 0; asm volatile("" : "+v"(zE));
    float* slab = (float*)(p.ws + WS_SLAB) + (size_t)(nt * ks + uksi) * 65536;
#pragma unroll
    for (int m = 0; m < 8; ++m)
#pragma unroll
      for (int n = 0; n < 4; ++n)
        *(float4*)(slab + ((m >> 2) * 128 + wr * 64 + (m & 3) * 16 + lr + zE) * 256 + (n >> 1) * 128 + wc * 32 + (n & 1) * 16 + lq * 4 + zE) = make_float4(acc[m][n][0], acc[m][n][1], acc[m][n][2], acc[m][n][3]);
    asm volatile("s_waitcnt vmcnt(0)" ::: "memory");
    __syncthreads();
    if (tid == 0) {
      __builtin_amdgcn_fence(__ATOMIC_RELEASE, "agent");
      asm volatile("s_waitcnt vmcnt(0)" ::: "memory");
      (void)xb_add(&tick[nt], 1u);
    }
  }
  TileSched ts; ts.init(64, 4);
  for (int ti = ts.local; ti < ts.ntiles; ti += ts.nloc) {
    int mt, nt; ts.get(ti, mt, nt);
    f32x4 acc[8][4];
    gemm_tile256(acc, A, [&](int i) { return (mt * 256 + i) * lda; }, W + (size_t)nt * 256 * K, K, K, lds, zp);
    TREFRESH(); int zE = 0; asm volatile("" : "+v"(zE));
#pragma unroll
    for (int m = 0; m < 8; ++m) {
      const int row = mt * 256 + (m >> 2) * 128 + wr * 64 + (m & 3) * 16 + lr + zE;
      float ss0 = 0.f, ss1 = 0.f;
#pragma unroll
      for (int n = 0; n < 4; ++n) {
        const int col = nt * 256 + (n >> 1) * 128 + wc * 32 + (n & 1) * 16 + lq * 4 + zE;
        const uint2 u = *(const uint2*)(xb + (size_t)row * 1024 + col);
        uint2 o; o.x = pack2(lo2f(u.x) + acc[m][n][0], hi2f(u.x) + acc[m][n][1]); o.y = pack2(lo2f(u.y) + acc[m][n][2], hi2f(u.y) + acc[m][n][3]);
        *(uint2*)(xb + (size_t)row * 1024 + col) = o;
        const float y0 = lo2f(o.x), y1 = hi2f(o.x), y2 = lo2f(o.y), y3 = hi2f(o.y);
        const float q = y0 * y0 + y1 * y1 + y2 * y2 + y3 * y3;
        if (n < 2) ss0 += q; else ss1 += q;
      }
      float ssw = ss0 + ss1;
      ssw += __shfl_xor(ssw, 16); ssw += __shfl_xor(ssw, 32);
      if (lq == 0) ((float*)lds)[((m >> 2) * 128 + wr * 64 + (m & 3) * 16 + lr) * 4 + wc] = ssw;
      asm volatile("" ::: "memory");
    }
    __syncthreads();
    if (tid < 256) { const float4 q4 = *(const float4*)((const float*)lds + tid * 4); ssq[(size_t)nt * NR + mt * 256 + tid] = (q4.x + q4.y) + (q4.z + q4.w); }
    __syncthreads();
  }
  if (isunit) {
    const int nt = unt;
    if (tid == 0) {
      XB_SPIN(xb_ld(&tick[nt]) < (unsigned)ks, (unsigned*)(p.ws + WS_BAR));
      __builtin_amdgcn_fence(__ATOMIC_ACQUIRE, "agent");
      asm volatile("s_waitcnt vmcnt(0)" ::: "memory");
    }
    __syncthreads();
    const int rpb = (256 + ks - 1) / ks, r0 = uksi * rpb, r1 = r0 + rpb < 256 ? r0 + rpb : 256;
    const float* sl = (const float*)(p.ws + WS_SLAB) + (size_t)(nt * ks) * 65536;
    for (int rr = r0 + (tid >> 6); rr < r1; rr += 8) {
      const int c4 = tid & 63, row = 16384 + rr, col = nt * 256 + c4 * 4;
      const float* s4 = sl + rr * 256 + c4 * 4;
      float4 sum = make_float4(0.f, 0.f, 0.f, 0.f);
      for (int q = 0; q < ks; ++q) { const float4 v = *(const float4*)(s4 + (size_t)q * 65536); sum.x += v.x; sum.y += v.y; sum.z += v.z; sum.w += v.w; }
      const uint2 u2 = *(const uint2*)(xb + (size_t)row * 1024 + col);
      uint2 o;
      o.x = pack2(lo2f(u2.x) + sum.x, hi2f(u2.x) + sum.y);
      o.y = pack2(lo2f(u2.y) + sum.z, hi2f(u2.y) + sum.w);
      *(uint2*)(xb + (size_t)row * 1024 + col) = o;
      const float y0 = lo2f(o.x), y1 = hi2f(o.x), y2 = lo2f(o.y), y3 = hi2f(o.y);
      float ss = wave_sum(y0 * y0 + y1 * y1 + y2 * y2 + y3 * y3);
      if (c4 == 0) ssq[(size_t)nt * NR + row] = ss;
    }
  }
}

__device__ __forceinline__ void phase_ffn_up(const Params& p, char* lds, int layer, int site) {
  int tid, lane, w, wr, wc, lr, lq; TREFRESH();
  const bf16_t* zp = (const bf16_t*)(p.ws + WS_ZERO);
  const bf16_t* xb = (const bf16_t*)(p.ws + WS_XB);
  const bf16_t* W = (const bf16_t*)p.out + W_UP + (size_t)layer * 5632 * 1024;
  const float* ssq = (const float*)(p.ws + WS_SSQ2) + (size_t)site * 4 * NR;
  bf16_t* act = (bf16_t*)(p.ws + WS_SCR + SCR_ACT);
  const float* cw = p.in[37] + (size_t)layer * 3 * 2816;
  const float* cb = p.in[38] + (size_t)layer * 2816;
  const float* cache = p.in[7] + (size_t)layer * 128 * 2 * 2816;
  float* srs = (float*)(lds + LDS_SRS);
  TileSched ts; ts.init_even(67, 22);
  for (int ti = ts.local; ti < ts.ntiles; ti += ts.nloc) {
    int mt, nt; ts.get_even(ti, mt, nt);
    const bool smp = mt == 66;
    const int gbase = 254 * mt - 2;
    auto growf = [&](int i) -> int { if (smp) return i < 128 ? NPR + i : -1; const int g = gbase + i; return (g >= 0 && g < NPR) ? g : -1; };
    if (tid < 256) { const int gr = growf(tid); srs[tid] = gr >= 0 ? row_rstd(ssq, gr) : 0.f; }
    f32x4 acc[8][4];
    gemm_tile256(acc, xb, [&](int i) -> int { int gr = smp ? NPR + (i < 128 ? i : 127) : gbase + i; gr = gr < 0 ? 0 : (gr > NR - 1 ? NR - 1 : gr); return gr * 1024; }, W + (size_t)nt * 256 * 1024, 1024, 1024, lds, zp);
    TREFRESH(); int zE = 0; asm volatile("" : "+v"(zE));
    {
      int z0 = 0; asm volatile("" : "+v"(z0));
      bf16_t* gl = (bf16_t*)lds + z0; bf16_t* vl = gl + 256 * 136;
#pragma unroll
      for (int m = 0; m < 8; ++m) {
        const int r = (m >> 2) * 128 + wr * 64 + (m & 3) * 16 + lr + zE;
        const float rs = srs[r];
#pragma unroll
        for (int n = 0; n < 2; ++n) {
          const int ch = wc * 32 + n * 16 + lq * 4;
          uint2 og, ov;
          og.x = pack2(acc[m][n][0] * rs, acc[m][n][1] * rs); og.y = pack2(acc[m][n][2] * rs, acc[m][n][3] * rs);
          ov.x = pack2(acc[m][n + 2][0] * rs, acc[m][n + 2][1] * rs); ov.y = pack2(acc[m][n + 2][2] * rs, acc[m][n + 2][3] * rs);
          *(uint2*)(gl + r * 136 + ch) = og;
          *(uint2*)(vl + r * 136 + ch) = ov;
        }
        asm volatile("" ::: "memory");
      }
      __syncthreads();
      float wv[4][8];
      {
        const int gch0 = nt * 128 + (tid & 15) * 8;
#pragma unroll
        for (int q = 0; q < 4; ++q) {
          const float* sp = (q < 3 ? cw + q * 2816 : cb) + gch0;
          const float4 x0 = *(const float4*)sp, x1 = *(const float4*)(sp + 4);
          wv[q][0] = x0.x; wv[q][1] = x0.y; wv[q][2] = x0.z; wv[q][3] = x0.w; wv[q][4] = x1.x; wv[q][5] = x1.y; wv[q][6] = x1.z; wv[q][7] = x1.w;
        }
      }
#pragma unroll 1
      for (int it = 0; it < 8; ++it) {
        const int idx = tid + 512 * it, r = idx >> 4, c8 = (idx & 15) * 8, gch = nt * 128 + c8;
        const int g = gbase + r;
        const bool valid = smp ? (r < 128) : (r >= 2 && g < NPR);
        if (valid) {
          const int grow = smp ? NPR + r : g;
          const int b = smp ? 0 : g / TP, t = smp ? 2 : g - b * TP;
          float g0[8], g1[8], g2[8], vv[8];
          {
            const uint4 u = *(const uint4*)(gl + r * 136 + c8);
            g2[0] = lo2f(u.x); g2[1] = hi2f(u.x); g2[2] = lo2f(u.y); g2[3] = hi2f(u.y); g2[4] = lo2f(u.z); g2[5] = hi2f(u.z); g2[6] = lo2f(u.w); g2[7] = hi2f(u.w);
            const uint4 v4 = *(const uint4*)(vl + r * 136 + c8);
            vv[0] = lo2f(v4.x); vv[1] = hi2f(v4.x); vv[2] = lo2f(v4.y); vv[3] = hi2f(v4.y); vv[4] = lo2f(v4.z); vv[5] = hi2f(v4.z); vv[6] = lo2f(v4.w); vv[7] = hi2f(v4.w);
          }
          if (smp) {
            const float4 a0 = *(const float4*)(cache + (size_t)(r * 2 + 0) * 2816 + gch), a1 = *(const float4*)(cache + (size_t)(r * 2 + 0) * 2816 + gch + 4);
            const float4 b0 = *(const float4*)(cache + (size_t)(r * 2 + 1) * 2816 + gch), b1 = *(const float4*)(cache + (size_t)(r * 2 + 1) * 2816 + gch + 4);
            g0[0] = a0.x; g0[1] = a0.y; g0[2] = a0.z; g0[3] = a0.w; g0[4] = a1.x; g0[5] = a1.y; g0[6] = a1.z; g0[7] = a1.w;
            g1[0] = b0.x; g1[1] = b0.y; g1[2] = b0.z; g1[3] = b0.w; g1[4] = b1.x; g1[5] = b1.y; g1[6] = b1.z; g1[7] = b1.w;
          } else {
            uint4 u0 = make_uint4(0, 0, 0, 0), u1 = make_uint4(0, 0, 0, 0);
            if (t >= 2) u0 = *(const uint4*)(gl + (r - 2) * 136 + c8);
            if (t >= 1) u1 = *(const uint4*)(gl + (r - 1) * 136 + c8);
            g0[0] = lo2f(u0.x); g0[1] = hi2f(u0.x); g0[2] = lo2f(u0.y); g0[3] = hi2f(u0.y); g0[4] = lo2f(u0.z); g0[5] = hi2f(u0.z); g0[6] = lo2f(u0.w); g0[7] = hi2f(u0.w);
            g1[0] = lo2f(u1.x); g1[1] = hi2f(u1.x); g1[2] = lo2f(u1.y); g1[3] = hi2f(u1.y); g1[4] = lo2f(u1.z); g1[5] = hi2f(u1.z); g1[6] = lo2f(u1.w); g1[7] = hi2f(u1.w);
          }
          float ov[8];
#pragma unroll
          for (int e = 0; e < 8; ++e) ov[e] = gelu_t(wv[3][e] + wv[0][e] * g0[e] + wv[1][e] * g1[e] + wv[2][e] * g2[e]) * vv[e];
          *(uint4*)(act + (size_t)grow * 2816 + gch) = make_uint4(pack2(ov[0], ov[1]), pack2(ov[2], ov[3]), pack2(ov[4], ov[5]), pack2(ov[6], ov[7]));
          if (smp) {
            float* oc = p.out + O_FCS + (size_t)((layer * 128 + r) * 2) * 2816 + gch;
            *(float4*)oc = make_float4(g1[0], g1[1], g1[2], g1[3]); *(float4*)(oc + 4) = make_float4(g1[4], g1[5], g1[6], g1[7]);
            *(float4*)(oc + 2816) = make_float4(g2[0], g2[1], g2[2], g2[3]); *(float4*)(oc + 2820) = make_float4(g2[4], g2[5], g2[6], g2[7]);
          } else if (t >= TP - 2) {
            float* oc = p.out + O_FCP + (size_t)((layer * 8 + b) * 2 + (t - (TP - 2))) * 2816 + gch;
            *(float4*)oc = make_float4(g2[0], g2[1], g2[2], g2[3]); *(float4*)(oc + 4) = make_float4(g2[4], g2[5], g2[6], g2[7]);
          }
        }
      }
    }
    __syncthreads();
  }
}

__device__ __forceinline__ void phase_g5(const Params& p, char* lds) {
  int tid, lane, w, wr, wc, lr, lq; TREFRESH();
  const bf16_t* zp = (const bf16_t*)(p.ws + WS_ZERO);
  const bf16_t* xb = (const bf16_t*)(p.ws + WS_XB);
  const bf16_t* W = (const bf16_t*)p.out + W_IN1;
  const float* ssq = (const float*)(p.ws + WS_SSQ2) + (size_t)2 * 4 * NR;
  bf16_t* xr = (bf16_t*)(p.ws + WS_SCR + SCR_XR);
  bf16_t* gg = (bf16_t*)(p.ws + WS_SCR + SCR_GG);
  float* srs = (float*)(lds + LDS_SRS);
  if (blockIdx.x < 48) {
    const int u = blockIdx.x, nt = u >> 2, ksi = u & 3, k0 = ksi * 256;
    f32x4 acc[8][4];
    gemm_tile256(acc, xb + k0, [&](int i) { return (16384 + i) * 1024; }, W + (size_t)nt * 256 * 1024 + k0, 1024, 256, lds, zp);
    TREFRESH(); int zE = 0; asm volatile("" : "+v"(zE));
    float* slab = (float*)(p.ws + WS_SLAB) + (size_t)(nt * 4 + ksi) * 65536;
#pragma unroll
    for (int m = 0; m < 8; ++m)
#pragma unroll
      for (int n = 0; n < 4; ++n)
        *(float4*)(slab + ((m >> 2) * 128 + wr * 64 + (m & 3) * 16 + lr + zE) * 256 + (n >> 1) * 128 + wc * 32 + (n & 1) * 16 + lq * 4 + zE) = make_float4(acc[m][n][0], acc[m][n][1], acc[m][n][2], acc[m][n][3]);
    asm volatile("s_waitcnt vmcnt(0)" ::: "memory");
    __syncthreads();
    if (tid == 0) {
      __builtin_amdgcn_fence(__ATOMIC_RELEASE, "agent");
      asm volatile("s_waitcnt vmcnt(0)" ::: "memory");
      (void)xb_add((unsigned*)(p.ws + WS_FLAG) + 4416 + nt, 1u);
    }
  }
  TileSched ts; ts.init(64, 12);
  for (int ti = ts.local; ti < ts.ntiles; ti += ts.nloc) {
    int mt, nt; ts.get(ti, mt, nt);
    if (tid < 256) srs[tid] = row_rstd(ssq, mt * 256 + tid);
    f32x4 acc[8][4];
    gemm_tile256(acc, xb, [&](int i) { return (mt * 256 + i) * 1024; }, W + (size_t)nt * 256 * 1024, 1024, 1024, lds, zp);
    TREFRESH(); int zE = 0; asm volatile("" : "+v"(zE));
#pragma unroll
    for (int m = 0; m < 8; ++m) {
      const int r = (m >> 2) * 128 + wr * 64 + (m & 3) * 16 + lr + zE, row = mt * 256 + r;
      const float rs = srs[r];
#pragma unroll
      for (int n = 0; n < 4; ++n) {
        const int col = nt * 256 + (n >> 1) * 128 + wc * 32 + (n & 1) * 16 + lq * 4 + zE;
        const f32x4 v = acc[m][n] * rs;
        uint2 o;
        if (nt < 6) {
          o.x = pack2(gelu_t(v[0]), gelu_t(v[1])); o.y = pack2(gelu_t(v[2]), gelu_t(v[3]));
          *(uint2*)(gg + (size_t)row * 1536 + col) = o;
        } else {
          o.x = pack2(v[0], v[1]); o.y = pack2(v[2], v[3]);
          *(uint2*)(xr + (size_t)row * 1536 + (col - 1536)) = o;
        }
      }
    }
    __syncthreads();
  }
  if (blockIdx.x < 48) {
    const int u = blockIdx.x, nt = u >> 2, ksi = u & 3;
    if (tid == 0) {
      XB_SPIN(xb_ld((unsigned*)(p.ws + WS_FLAG) + 4416 + nt) < 4u, (unsigned*)(p.ws + WS_BAR));
      __builtin_amdgcn_fence(__ATOMIC_ACQUIRE, "agent");
      asm volatile("s_waitcnt vmcnt(0)" ::: "memory");
    }
    __syncthreads();
    const float* sl = (const float*)(p.ws + WS_SLAB) + (size_t)(nt * 4) * 65536;
    for (int rr = ksi * 64 + (tid >> 6); rr < ksi * 64 + 64; rr += 8) {
      const int c4 = tid & 63, row = 16384 + rr, col = nt * 256 + c4 * 4;
      const float* s4 = sl + rr * 256 + c4 * 4;
      const float4 s0 = *(const float4*)s4, s1 = *(const float4*)(s4 + 65536), s2 = *(const float4*)(s4 + 131072), s3 = *(const float4*)(s4 + 196608);
      const float rs = row_rstd(ssq, row);
      const float v0 = ((s0.x + s1.x) + (s2.x + s3.x)) * rs, v1 = ((s0.y + s1.y) + (s2.y + s3.y)) * rs;
      const float v2 = ((s0.z + s1.z) + (s2.z + s3.z)) * rs, v3 = ((s0.w + s1.w) + (s2.w + s3.w)) * rs;
      uint2 o;
      if (nt < 6) {
        o.x = pack2(gelu_t(v0), gelu_t(v1)); o.y = pack2(gelu_t(v2), gelu_t(v3));
        *(uint2*)(gg + (size_t)row * 1536 + col) = o;
      } else {
        o.x = pack2(v0, v1); o.y = pack2(v2, v3);
        *(uint2*)(xr + (size_t)row * 1536 + (col - 1536)) = o;
      }
    }
  }
}

__device__ __forceinline__ void rglru_item(const Params& p, int item, char* lds) {
  const int tid = threadIdx.x & 255, lane = tid & 63, w = tid >> 6, lr = lane & 15, lq = lane >> 4;
  const bool smp = item >= 4352;
  const int pass = 1;
  int b, tl, n, half;
  if (smp) { const int it = item - 4352; b = 0; tl = 0; n = it >> 1; half = it & 1; }
  else { tl = item >> 8; const int chain = item & 255; b = chain >> 5; n = (chain >> 1) & 15; half = chain & 1; }
  unsigned* flags = (unsigned*)(p.ws + WS_FLAG);
  unsigned* barw = (unsigned*)(p.ws + WS_BAR);
  const bf16_t* xr = (const bf16_t*)(p.ws + WS_SCR + SCR_XR);
  bf16_t* gg = (bf16_t*)(p.ws + WS_SCR + SCR_GG);
  const bf16_t* Wg = (const bf16_t*)p.out + W_GATE;
  const bf16_t* zp = (const bf16_t*)(p.ws + WS_ZERO);
  float* carr = (float*)(p.ws + WS_XLOC);
  char* At = lds; char* Ba = lds + 26624; char* Bx = lds + 36608;
  char* xs = lds + 46592;
  float* sa = (float*)lds; float* sbx = (float*)(lds + 24576);
  float* segA = (float*)(lds + 49152); float* segH = (float*)(lds + 49920); float* carry = (float*)(lds + 50688);
  char* ggl = lds + 51200;
  float* par = (float*)(lds + 71744);
  const int t0 = tl * 128;
  const int nvalid = smp ? 128 : (TP - t0 < 128 ? TP - t0 : 128);
  if (tid < 156) {
    const float* src;
    const int q = tid;
    if (q < 96) { const int wt = q / 24; src = p.in[27] + wt * 1536 + n * 96 + (q - wt * 24) * 4; }
    else if (q < 120) src = p.in[28] + n * 96 + (q - 96) * 4;
    else if (q < 132) src = p.in[30] + n * 96 + half * 48 + (q - 120) * 4;
    else if (q < 144) src = p.in[32] + n * 96 + half * 48 + (q - 132) * 4;
    else src = (const float*)(p.ws + WS_NSP) + n * 96 + half * 48 + (q - 144) * 4;
    __builtin_amdgcn_global_load_lds((const unsigned*)src, (unsigned*)((char*)par + q * 16), 16, 0, 0);
  }
  for (int q = tid; q < 1248; q += 256) {
    const int mat = q >= 624 ? 1 : 0, q2 = q - mat * 624, d = q2 / 13, ch = q2 - d * 13;
    const bf16_t* src = Wg + (size_t)((mat * 16 + n) * 96 + half * 48 + d) * 96 + (ch < 12 ? ch : 0) * 8;
    __builtin_amdgcn_global_load_lds((const unsigned*)src, (unsigned*)(Ba + q * 16), 16, 0, 0);
  }
  if (!smp) {
    for (int q = tid; q < 1572; q += 256) {
      const int r = q / 12, ch = q - r * 12, t = t0 + r - 3;
      const bf16_t* src = (t >= 0 && t < TP) ? xr + (size_t)(b * TP + t) * 1536 + n * 96 + ch * 8 : zp;
      __builtin_amdgcn_global_load_lds((const unsigned*)src, (unsigned*)(xs + q * 16), 16, 0, 0);
    }
  }
  asm volatile("s_waitcnt vmcnt(0)" ::: "memory");
  __syncthreads();
#pragma unroll 2
  for (int i = 0; i < 6; ++i) {
    const int idx = tid + 256 * i, r = idx / 12, ch8 = idx - r * 12, c0 = n * 96 + ch8 * 8;
    float xc[8];
    if (r < nvalid) {
      const float4 b0 = *(const float4*)(par + 384 + ch8 * 8), b1 = *(const float4*)(par + 384 + ch8 * 8 + 4);
      xc[0] = b0.x; xc[1] = b0.y; xc[2] = b0.z; xc[3] = b0.w; xc[4] = b1.x; xc[5] = b1.y; xc[6] = b1.z; xc[7] = b1.w;
#pragma unroll
      for (int wt = 0; wt < 4; ++wt) {
        float xv[8];
        if (smp && wt < 3) {
          const float4 a0 = *(const float4*)(p.in[6] + (size_t)(r * 3 + wt) * 1536 + c0), a1 = *(const float4*)(p.in[6] + (size_t)(r * 3 + wt) * 1536 + c0 + 4);
          xv[0] = a0.x; xv[1] = a0.y; xv[2] = a0.z; xv[3] = a0.w; xv[4] = a1.x; xv[5] = a1.y; xv[6] = a1.z; xv[7] = a1.w;
        } else {
          uint4 u;
          if (smp) u = *(const uint4*)(xr + (size_t)(NPR + r) * 1536 + c0);
          else u = *(const uint4*)(xs + (r + wt) * 192 + ch8 * 16);
          xv[0] = lo2f(u.x); xv[1] = hi2f(u.x); xv[2] = lo2f(u.y); xv[3] = hi2f(u.y); xv[4] = lo2f(u.z); xv[5] = hi2f(u.z); xv[6] = lo2f(u.w); xv[7] = hi2f(u.w);
        }
        const float4 w0 = *(const float4*)(par + wt * 96 + ch8 * 8), w1 = *(const float4*)(par + wt * 96 + ch8 * 8 + 4);
        xc[0] += w0.x * xv[0]; xc[1] += w0.y * xv[1]; xc[2] += w0.z * xv[2]; xc[3] += w0.w * xv[3];
        xc[4] += w1.x * xv[4]; xc[5] += w1.y * xv[5]; xc[6] += w1.z * xv[6]; xc[7] += w1.w * xv[7];
      }
    } else {
#pragma unroll
      for (int e = 0; e < 8; ++e) xc[e] = 0.f;
    }
    *(uint4*)(At + r * 208 + ch8 * 16) = make_uint4(pack2(xc[0], xc[1]), pack2(xc[2], xc[3]), pack2(xc[4], xc[5]), pack2(xc[6], xc[7]));
  }
  __syncthreads();
  if (pass == 1 && !smp) {
    for (int q = tid; q < 768; q += 256) {
      const int r = q / 6, c = q - r * 6;
      const bf16_t* src = r < nvalid ? gg + (size_t)(b * TP + t0 + r) * 1536 + n * 96 + half * 48 + c * 8 : zp;
      __builtin_amdgcn_global_load_lds((const unsigned*)src, (unsigned*)(ggl + q * 16), 16, 0, 0);
    }
  }
  f32x4 aa[2][3], ax[2][3];
#pragma unroll
  for (int m = 0; m < 2; ++m)
#pragma unroll
    for (int q = 0; q < 3; ++q) { aa[m][q] = (f32x4){0.f, 0.f, 0.f, 0.f}; ax[m][q] = (f32x4){0.f, 0.f, 0.f, 0.f}; }
#pragma unroll
  for (int s2 = 0; s2 < 3; ++s2) {
    bf16x8 a[2];
#pragma unroll
    for (int m = 0; m < 2; ++m) a[m] = *(const bf16x8*)(At + (32 * w + 16 * m + lr) * 208 + (s2 * 4 + lq) * 16);
#pragma unroll
    for (int q = 0; q < 3; ++q) {
      const bf16x8 ba = *(const bf16x8*)(Ba + (16 * q + lr) * 208 + (s2 * 4 + lq) * 16);
      const bf16x8 bx = *(const bf16x8*)(Bx + (16 * q + lr) * 208 + (s2 * 4 + lq) * 16);
#pragma unroll
      for (int m = 0; m < 2; ++m) { aa[m][q] = mfma16(ba, a[m], aa[m][q]); ax[m][q] = mfma16(bx, a[m], ax[m][q]); }
    }
  }
  uint2 xcv[2][3];
#pragma unroll
  for (int m = 0; m < 2; ++m)
#pragma unroll
    for (int q = 0; q < 3; ++q) xcv[m][q] = *(const uint2*)(At + (32 * w + 16 * m + lr) * 208 + (half * 48 + 16 * q + lq * 4) * 2);
  float4 pba[3], pbx[3], plm[3];
#pragma unroll
  for (int q = 0; q < 3; ++q) {
    pba[q] = *(const float4*)(par + 480 + 16 * q + lq * 4);
    pbx[q] = *(const float4*)(par + 528 + 16 * q + lq * 4);
    plm[q] = *(const float4*)(par + 576 + 16 * q + lq * 4);
  }
  __syncthreads();
#pragma unroll
  for (int m = 0; m < 2; ++m) {
    const int row = 32 * w + 16 * m + lr;
#pragma unroll
    for (int q = 0; q < 3; ++q) {
      const int d0 = 16 * q + lq * 4;
      const float bav[4] = {pba[q].x, pba[q].y, pba[q].z, pba[q].w}, bxv[4] = {pbx[q].x, pbx[q].y, pbx[q].z, pbx[q].w}, lmv[4] = {plm[q].x, plm[q].y, plm[q].z, plm[q].w};
      const float xcf[4] = {lo2f(xcv[m][q].x), hi2f(xcv[m][q].x), lo2f(xcv[m][q].y), hi2f(xcv[m][q].y)};
      float av[4], bv[4];
#pragma unroll
      for (int e = 0; e < 4; ++e) {
        const float r_ = sigm(aa[m][q][e] + bav[e]);
        const float i_ = sigm(ax[m][q][e] + bxv[e]);
        const float la = r_ * lmv[e];
        float a = __expf(la);
        float bxx = __builtin_sqrtf(fmaxf(1.f - a * a, 0.f)) * (i_ * xcf[e]);
        if (row >= nvalid) { a = 1.f; bxx = 0.f; }
        av[e] = a; bv[e] = bxx;
      }
      *(float4*)(sa + row * 48 + d0) = make_float4(av[0], av[1], av[2], av[3]);
      *(float4*)(sbx + row * 48 + d0) = make_float4(bv[0], bv[1], bv[2], bv[3]);
    }
  }
  __syncthreads();
  if (smp) {
    for (int idx = tid; idx < 128 * 48; idx += 256) {
      const int row = idx / 48, ch = idx - row * 48, cgl = n * 96 + half * 48 + ch;
      const float hh = sa[idx] * p.in[5][row * 1536 + cgl] + sbx[idx];
      p.out[O_HS + row * 1536 + cgl] = hh;
      const size_t go = (size_t)(NPR + row) * 1536 + cgl;
      gg[go] = f2bf(hh * bf2f(gg[go]));
    }
  } else {
    const int ch = tid % 48, seg = tid / 48;
    if (tid < 192) {
      float A = 1.f, H = 0.f;
#pragma unroll 8
      for (int r = seg * 32; r < seg * 32 + 32; ++r) { const float a = sa[r * 48 + ch]; H = a * H + sbx[r * 48 + ch]; A *= a; }
      segA[seg * 48 + ch] = A; segH[seg * 48 + ch] = H;
    }
    asm volatile("s_waitcnt vmcnt(0)" ::: "memory");
    __syncthreads();
    {
      float At_ = 1.f, Ht_ = 0.f;
      if (tid < 48) {
#pragma unroll
        for (int s2 = 0; s2 < 4; ++s2) { Ht_ = segA[s2 * 48 + tid] * Ht_ + segH[s2 * 48 + tid]; At_ *= segA[s2 * 48 + tid]; }
      }
      if (tl > 0 && tid == 0) XB_SPIN(xb_ld(&flags[item - 256]) == 0u, barw);
      __syncthreads();
      if (tid < 48) {
        const int cgl = n * 96 + half * 48 + tid;
        float h0 = 0.f;
        if (tl > 0) h0 = __hip_atomic_load(&carr[(size_t)((b * 17 + tl - 1) * 32 + n * 2 + half) * 64 + tid], __ATOMIC_RELAXED, __HIP_MEMORY_SCOPE_AGENT);
        carry[tid] = h0;
        const float hend = At_ * h0 + Ht_;
        if (tl < 16) __hip_atomic_store(&carr[(size_t)((b * 17 + tl) * 32 + n * 2 + half) * 64 + tid], hend, __ATOMIC_RELAXED, __HIP_MEMORY_SCOPE_AGENT);
        else p.out[O_HP + b * 1536 + cgl] = hend;
      }
      asm volatile("s_waitcnt vmcnt(0)" ::: "memory");
      __syncthreads();
      if (tid == 0 && tl < 16) (void)xb_add(&flags[item], 1u);
    }
    if (tid < 192) {
      float hin = carry[ch];
      for (int s2 = 0; s2 < seg; ++s2) hin = segA[s2 * 48 + ch] * hin + segH[s2 * 48 + ch];
      const int cgl = n * 96 + half * 48 + ch;
#pragma unroll 8
      for (int r = seg * 32; r < seg * 32 + 32; ++r) {
        hin = sa[r * 48 + ch] * hin + sbx[r * 48 + ch];
        if (r < nvalid) gg[(size_t)(b * TP + t0 + r) * 1536 + cgl] = f2bf(hin * bf2f(*(const bf16_t*)(ggl + r * 96 + ch * 2)));
      }
    }
  }
  if (pass == 1) {
    if (!smp) {
      if (tl == 16 && half == 0 && tid < 96) {
#pragma unroll
        for (int wv = 0; wv < 3; ++wv) p.out[O_RCP + (b * 3 + wv) * 1536 + n * 96 + tid] = bf2f(xr[(size_t)(b * TP + TP - 3 + wv) * 1536 + n * 96 + tid]);
      }
    } else if (half == 0) {
      for (int idx = tid; idx < 128 * 96; idx += 256) {
        const int s2 = idx / 96, cc_ = idx - s2 * 96, cgl = n * 96 + cc_;
        p.out[O_RCS + (size_t)(s2 * 3 + 0) * 1536 + cgl] = p.in[6][(size_t)(s2 * 3 + 1) * 1536 + cgl];
        p.out[O_RCS + (size_t)(s2 * 3 + 1) * 1536 + cgl] = p.in[6][(size_t)(s2 * 3 + 2) * 1536 + cgl];
        p.out[O_RCS + (size_t)(s2 * 3 + 2) * 1536 + cgl] = bf2f(xr[(size_t)(NPR + s2) * 1536 + cgl]);
      }
    }
  }
  __syncthreads();
}

__device__ __forceinline__ void phase_final(const Params& p) {
  const int tid = threadIdx.x, lane = tid & 63;
  const bf16_t* xres = (const bf16_t*)(p.ws + WS_XB);
  const float* ssq = (const float*)(p.ws + WS_SSQ2);
  const int gw = blockIdx.x * 8 + (tid >> 6), nw = gridDim.x * 8;
  for (int r = gw; r < NR; r += nw) {
    float* dst;
    if (r >= NPR) dst = p.out + O_YS + (size_t)(r - NPR) * 1024;
    else { const int b = r / TP, t = r - b * TP; if (t < 16) continue; dst = p.out + O_YP + ((size_t)b * 2048 + (t - 16)) * 1024; }
    float s = lane < 4 ? ssq[(size_t)lane * NR + r] : 0.f;
    s = wave_sum(s);
    const float rstd = rsqrtf(s * (1.f / 1024.f) + EPSN);
    const uint2* src = (const uint2*)(xres + (size_t)r * 1024);
    const float4* nf = (const float4*)p.in[40];
#pragma unroll
    for (int j = 0; j < 4; ++j) {
      const uint2 u = src[lane + 64 * j];
      const float4 v = make_float4(lo2f(u.x), hi2f(u.x), lo2f(u.y), hi2f(u.y)), g = nf[lane + 64 * j];
      ((float4*)dst)[lane + 64 * j] = make_float4(v.x * rstd * g.x, v.y * rstd * g.y, v.z * rstd * g.z, v.w * rstd * g.w);
    }
  }
}

__global__ void __launch_bounds__(512, 2) mega_kernel(Params p) {
  extern __shared__ __attribute__((aligned(16))) char lds[];
  cg::grid_group grid = cg::this_grid();
  const bf16_t* wb = (const bf16_t*)p.out;
  volatile LAS unsigned* xst_ = (volatile LAS unsigned*)(lds + LDS_ST);
  if (threadIdx.x < 4) xst_[threadIdx.x] = 0u;
  __syncthreads();
  XcdBarrier xbar = xcd_barrier_post((unsigned*)(p.ws + WS_BAR), xst_);
  if (p.ph_hi > 1000) grid.sync();
#define PH(k, body) if (p.ph_lo <= (k) && (k) < p.ph_hi) { body; } if (p.ph_lo <= (k) && (k) + 1 < p.ph_hi) xcd_barrier(xbar);
  PH(0, phase_prep(p, lds))
  PH(1, phase_g1(p, lds))
  PH(2, phase_mix_a(p, lds))
  PH(3, phase_mix_b(p))
  PH(4, phase_mix_c(p, lds))
  PH(5, phase_glu(p, lds))
  PH(6, phase_resid(p, lds, (const bf16_t*)(p.ws + WS_SCR + SCR_ZB) + 512, 2048, wb + W_OUT0, 1024, 0, 1))
  PH(7, phase_ffn_up(p, lds, 0, 1))
  PH(8, phase_resid(p, lds, (const bf16_t*)(p.ws + WS_SCR + SCR_ACT), 2816, wb + W_DOWN, 2816, 16, 2))
  PH(9, phase_g5(p, lds))
  PH(10, for (int pr = blockIdx.x; pr < 2192; pr += gridDim.x) rglru_item(p, pr * 2 + (threadIdx.x >> 8), lds + (threadIdx.x >> 8) * HALF_LDS))
  PH(11, phase_resid(p, lds, (const bf16_t*)(p.ws + WS_SCR + SCR_GG), 1536, wb + W_OUT1, 1536, 32, 3))
  PH(12, phase_ffn_up(p, lds, 1, 3))
  PH(13, phase_resid(p, lds, (const bf16_t*)(p.ws + WS_SCR + SCR_ACT), 2816, wb + W_DOWN + (size_t)1024 * 2816, 2816, 48, 0))
  PH(14, phase_final(p))
}

extern "C" void kernel_launch(void* const* d_in, const int* in_sizes, int n_in, void* d_out, int out_size, void* d_ws, size_t ws_size, hipStream_t stream) {
  static int grid_blocks = 0;
  if (!grid_blocks) {
    int dev = 0, cus = 0, per_cu = 0;
    hipGetDevice(&dev);
    hipDeviceGetAttribute(&cus, hipDeviceAttributeMultiprocessorCount, dev);
    hipFuncSetAttribute((const void*)mega_kernel, hipFuncAttributeMaxDynamicSharedMemorySize, LDS_BYTES);
    hipOccupancyMaxActiveBlocksPerMultiprocessor(&per_cu, (const void*)mega_kernel, NTHR, LDS_BYTES);
    if (per_cu > 1) per_cu = 1;
    if (per_cu < 1) per_cu = 1;
    grid_blocks = cus * per_cu;
    if (n_in != 41 || ws_size < WS_NEED) fprintf(stderr, "kernel_launch: unexpected n_in %d or ws_size %zu (need %llu)\n", n_in, ws_size, (unsigned long long)WS_NEED);
  }
  Params p{};
  for (int i = 0; i < 41; ++i) p.in[i] = (const float*)d_in[i];
  p.out = (float*)d_out;
  p.ws = (char*)d_ws;
  (void)hipMemsetAsync((char*)d_ws + WS_BAR, 0, 16384, stream);
  (void)hipMemsetAsync((char*)d_ws + WS_FLAG, 0, 20480, stream);
#if MK_MULTI
  for (int ph = 0; ph < NPHASE; ++ph) {
    p.ph_lo = ph; p.ph_hi = ph + 1;
    hipLaunchKernelGGL(mega_kernel, dim3(grid_blocks), dim3(NTHR), LDS_BYTES, stream, p);
  }
#else
  p.ph_lo = 0; p.ph_hi = NPHASE;
  void* args[] = {&p};
  hipError_t e = hipLaunchCooperativeKernel((const void*)mega_kernel, dim3(grid_blocks), dim3(NTHR), args, LDS_BYTES, stream);
  if (e != hipSuccess) fprintf(stderr, "cooperative launch failed: %s (grid %d)\n", hipGetErrorString(e), grid_blocks);
#endif
}
```

```cpp
#include <hip/hip_runtime.h>
#include <hip/hip_cooperative_groups.h>
#include <stdint.h>
#include <stdio.h>
namespace cg = cooperative_groups;

#ifndef MK_MULTI
#define MK_MULTI 0
#endif

#define LAS __attribute__((address_space(3)))
typedef unsigned short bf16_t;
typedef __attribute__((ext_vector_type(8))) short bf16x8;
typedef __attribute__((ext_vector_type(4))) float f32x4;

#define TP 2064
#define NPR 16512
#define NR 16640
#define EPSN 1e-6f
#define NPHASE 15
#define LDS_BYTES 153600
#define HALF_LDS 75776
#define LDS_SRS 151552
#define LDS_ST 152576
#define LDS_TKL 152592
#define NTHR 512

#define O_YP 0
#define O_YS 16777216
#define O_GLAP 16908288
#define O_GLAS 17170432
#define O_S5RP 21364736
#define O_S5RS 21381120
#define O_S5IP 21643264
#define O_S5IS 21659648
#define O_HP 21921792
#define O_HS 21934080
#define O_RCP 22130688
#define O_RCS 22167552
#define O_FCP 22757376
#define O_FCS 22847488

#define W_IN0 0
#define W_GLU 2359296
#define W_OUT0 2621440
#define W_UP 3670016
#define W_DOWN 15204352
#define W_IN1 20971520
#define W_OUT1 24117248
#define W_GATE 25690112

#define WS_XB 0ull
#define WS_XRES 34078720ull
#define WS_SSQ 102236160ull
#define WS_S5AB 106496000ull
#define WS_S5BB 106545152ull
#define WS_S5CC 106807296ull
#define WS_XLOC 106938368ull
#define WS_XST 111263744ull
#define WS_DEC 115589120ull
#define WS_SCR 115859456ull
#define SCR_ZB 0ull
#define SCR_ALOG 68157440ull
#define SCR_SLOC 85196800ull
#define SCR_ACT 0ull
#define SCR_XR 0ull
#define SCR_GG 51118080ull
#define WS_BAR (WS_SCR + 119799808ull)
#define WS_ZERO (WS_BAR + 15360ull)
#define WS_NSP (WS_BAR + 16384ull)
#define WS_SLAB (WS_NSP + 8192ull)
#define WS_FLAG (WS_SLAB + 12582912ull)
#define WS_SSQ2 (WS_FLAG + 20480ull)
#define WS_NEED (WS_SSQ2 + 8519680ull)

struct Params {
  const float* in[41];
  float* out;
  char* ws;
  int ph_lo, ph_hi;
};

__device__ __forceinline__ bf16_t f2bf(float f) { uint32_t u = __float_as_uint(f); u += 0x7fffu + ((u >> 16) & 1u); return (bf16_t)(u >> 16); }
__device__ __forceinline__ float bf2f(bf16_t h) { return __uint_as_float(((uint32_t)h) << 16); }
__device__ __forceinline__ uint32_t pack2(float a, float b) { return (uint32_t)f2bf(a) | ((uint32_t)f2bf(b) << 16); }
__device__ __forceinline__ float lo2f(uint32_t u) { return __uint_as_float(u << 16); }
__device__ __forceinline__ float hi2f(uint32_t u) { return __uint_as_float(u & 0xffff0000u); }
__device__ __forceinline__ float sigm(float x) { return __builtin_amdgcn_rcpf(1.f + __expf(-x)); }
__device__ __forceinline__ float gelu_t(float x) { const float u = x * (1.5957691216f + 0.0713548162726f * x * x); return x * __builtin_amdgcn_rcpf(1.f + __expf(-u)); }
__device__ __forceinline__ float softplusf_(float x) { return fmaxf(x, 0.f) + log1pf(__expf(-fabsf(x))); }
__device__ __forceinline__ float wave_sum(float v) {
#pragma unroll
  for (int o = 1; o < 64; o <<= 1) v += __shfl_xor(v, o);
  return v;
}
__device__ __forceinline__ int toff(int row, int chunk) { return row * 128 + ((chunk ^ (row & 7)) << 4); }
__device__ __forceinline__ f32x4 mfma16(bf16x8 a, bf16x8 b, f32x4 c) { return __builtin_amdgcn_mfma_f32_16x16x32_bf16(a, b, c, 0, 0, 0); }

__device__ __forceinline__ const float* xrow_src(const Params& p, int r) {
  if (r >= NPR) return p.in[1] + (size_t)(r - NPR) * 1024;
  int b = r / TP, t = r - b * TP;
  return t < 16 ? p.in[8] + t * 1024 : p.in[0] + ((size_t)b * 2048 + (t - 16)) * 1024;
}

#define TREFRESH() do { tid = threadIdx.x; asm volatile("" : "+v"(tid)); lane = tid & 63; w = tid >> 6; wr = w >> 2; wc = w & 3; lr = lane & 15; lq = lane >> 4; (void)w; (void)lane; } while (0)
__device__ __forceinline__ int lds_byte8(int r, int c) { const int st = (r >> 4) * 2 + (c >> 5), rr = r & 15, cc = c & 31, ob = rr * 64 + cc * 2; return st * 1024 + (ob ^ (((ob >> 9) & 1) << 5)); }
__device__ __forceinline__ void stage_rc8(int b, int& R, int& C) { const int st = b / 1024, sb = b % 1024, swz = sb ^ (((sb >> 9) & 1) << 5); R = (st >> 1) * 16 + swz / 64; C = (st & 1) * 32 + (swz % 64) / 2; }
template <class AF>
__device__ __forceinline__ void gemm_tile256(f32x4 (&acc)[8][4], const bf16_t* Ab, AF arow, const bf16_t* Bt, int ldb, int K, char* lds, const bf16_t* zpage) {
  const int wid = threadIdx.x >> 6, lane = threadIdx.x & 63, wr = wid >> 2, wc = wid & 3, fr = lane & 15, fq = lane >> 4;
#pragma unroll
  for (int m = 0; m < 8; ++m)
#pragma unroll
    for (int n = 0; n < 4; ++n) acc[m][n] = (f32x4){0.f, 0.f, 0.f, 0.f};
  int ao[2][2], bo[2][2];
#pragma unroll
  for (int i = 0; i < 2; ++i) {
    int r_, c_; stage_rc8(threadIdx.x * 16 + i * 8192, r_, c_);
#pragma unroll
    for (int h = 0; h < 2; ++h) {
      const int a = arow(h * 128 + r_);
      ao[h][i] = (a + c_) * 2;
      bo[h][i] = ((h * 128 + r_) * ldb + c_) * 2;
      asm volatile("" : "+v"(ao[h][i]), "+v"(bo[h][i]));
    }
  }
  char* lth = lds + threadIdx.x * 16;
  const __amdgpu_buffer_rsrc_t rA = __builtin_amdgcn_make_buffer_rsrc((void*)const_cast<bf16_t*>(Ab), (short)0, 0x7fffffff, 0x00020000);
  const __amdgpu_buffer_rsrc_t rB = __builtin_amdgcn_make_buffer_rsrc((void*)const_cast<bf16_t*>(Bt), (short)0, 0x7fffffff, 0x00020000);
#define SA8(b, h) (((b) * 2 + (h)) * 16384)
#define SB8(b, h) ((4 + (b) * 2 + (h)) * 16384)
#define STG_A(P, h, kt) do { _Pragma("unroll") for (int i_ = 0; i_ < 2; ++i_) \
    __builtin_amdgcn_raw_ptr_buffer_load_lds(rA, (LAS void*)(lth + (P) + i_ * 8192), 16, ao[h][i_], (kt) * 128, 0, 0); } while (0)
#define STG_B(P, h, kt) do { _Pragma("unroll") for (int i_ = 0; i_ < 2; ++i_) \
    __builtin_amdgcn_raw_ptr_buffer_load_lds(rB, (LAS void*)(lth + (P) + i_ * 8192), 16, bo[h][i_], (kt) * 128, 0, 0); } while (0)
#define LDA8(dst, b, h) do { _Pragma("unroll") for (int m = 0; m < 4; ++m) _Pragma("unroll") for (int k = 0; k < 2; ++k) \
    dst[m][k] = *(const bf16x8*)(lds + SA8(b, h) + lds_byte8(wr * 64 + m * 16 + fr, k * 32 + fq * 8)); } while (0)
#define LDB8(dst, b, h) do { _Pragma("unroll") for (int n = 0; n < 2; ++n) _Pragma("unroll") for (int k = 0; k < 2; ++k) \
    dst[n][k] = *(const bf16x8*)(lds + SB8(b, h) + lds_byte8(wc * 32 + n * 16 + fr, k * 32 + fq * 8)); } while (0)
#define MMA8(ai, bj, Ax, Bx) do { __builtin_amdgcn_s_setprio(1); \
    _Pragma("unroll") for (int m = 0; m < 4; ++m) _Pragma("unroll") for (int n = 0; n < 2; ++n) _Pragma("unroll") for (int k = 0; k < 2; ++k) \
      acc[(ai) * 4 + m][(bj) * 2 + n] = mfma16(Bx[n][k], Ax[m][k], acc[(ai) * 4 + m][(bj) * 2 + n]); \
    __builtin_amdgcn_s_setprio(0); } while (0)
#define WAIT_V(n) asm volatile("s_waitcnt vmcnt(" #n ")" ::: "memory")
#define WAIT_L(n) asm volatile("s_waitcnt lgkmcnt(" #n ")" ::: "memory")
#define BAR8 __builtin_amdgcn_s_barrier()
#define SCHED8 __builtin_amdgcn_sched_barrier(0)
  bf16x8 At[4][2], B0[2][2], B1[2][2];
  const int nt = K >> 6;
  STG_B(SB8(0, 0), 0, 0); STG_A(SA8(0, 0), 0, 0);
  STG_B(SB8(0, 1), 1, 0); STG_A(SA8(0, 1), 1, 0);
  if (wr == 1) BAR8;
  WAIT_V(4); BAR8;
  STG_B(SB8(1, 0), 0, 1); STG_A(SA8(1, 0), 0, 1); STG_B(SB8(1, 1), 1, 1);
  WAIT_V(6); BAR8;
  for (int t = 0; t < nt - 2; t += 2) {
    LDB8(B0, 0, 0); SCHED8; LDA8(At, 0, 0); STG_A(SA8(1, 1), 1, t + 1);
    WAIT_L(8); BAR8; WAIT_L(0); MMA8(0, 0, At, B0); BAR8; SCHED8;
    LDB8(B1, 0, 1); STG_B(SB8(0, 0), 0, t + 2);
    BAR8; WAIT_L(0); MMA8(0, 1, At, B1); BAR8;
    LDA8(At, 0, 1); STG_A(SA8(0, 0), 0, t + 2);
    BAR8; WAIT_L(0); MMA8(1, 0, At, B0); BAR8; SCHED8;
    STG_B(SB8(0, 1), 1, t + 2);
    WAIT_V(6); BAR8; MMA8(1, 1, At, B1); BAR8;
    LDB8(B0, 1, 0); SCHED8; LDA8(At, 1, 0); STG_A(SA8(0, 1), 1, t + 2);
    WAIT_L(8); BAR8; WAIT_L(0); MMA8(0, 0, At, B0); BAR8; SCHED8;
    LDB8(B1, 1, 1); STG_B(SB8(1, 0), 0, t + 3);
    BAR8; WAIT_L(0); MMA8(0, 1, At, B1); BAR8;
    LDA8(At, 1, 1); STG_A(SA8(1, 0), 0, t + 3);
    BAR8; WAIT_L(0); MMA8(1, 0, At, B0); BAR8; SCHED8;
    STG_B(SB8(1, 1), 1, t + 3);
    WAIT_V(6); BAR8; MMA8(1, 1, At, B1); BAR8;
  }
  { LDB8(B0, 0, 0); LDA8(At, 0, 0); STG_A(SA8(1, 1), 1, nt - 1);
    BAR8; WAIT_L(0); MMA8(0, 0, At, B0); BAR8;
    LDB8(B1, 0, 1); BAR8; WAIT_L(0); MMA8(0, 1, At, B1); BAR8;
    LDA8(At, 0, 1); WAIT_V(4); BAR8; WAIT_L(0); MMA8(1, 0, At, B0); MMA8(1, 1, At, B1); BAR8; }
  { LDB8(B0, 1, 0); LDA8(At, 1, 0); WAIT_V(2); BAR8; WAIT_L(0); MMA8(0, 0, At, B0); BAR8;
    LDB8(B1, 1, 1); WAIT_V(0); BAR8; WAIT_L(0); MMA8(0, 1, At, B1); BAR8;
    LDA8(At, 1, 1); BAR8; WAIT_L(0); MMA8(1, 0, At, B0); MMA8(1, 1, At, B1); BAR8; }
  if (wr == 0) BAR8;
#undef SA8
#undef SB8
#undef STG_A
#undef STG_B
#undef LDA8
#undef LDB8
#undef MMA8
  __syncthreads();
}

#define XB_TMO      128
#define XB_XCNT(j)  (256  + 64 * (j))
#define XB_XSUB(j)  (1280 + 64 * (j))
#define XB_XGEN(j)  (2304 + 64 * (j))
#define XB_TOP      3328
#define XB_TOPGEN   3392
#define XCD_BAR_WORDS 3456
#define XB_SPIN_CAP (1u << 22)
__device__ __forceinline__ unsigned xb_ld(unsigned* p)              { return __hip_atomic_load(p, __ATOMIC_RELAXED, __HIP_MEMORY_SCOPE_AGENT); }
__device__ __forceinline__ unsigned xb_add(unsigned* p, unsigned v) { return __hip_atomic_fetch_add(p, v, __ATOMIC_RELAXED, __HIP_MEMORY_SCOPE_AGENT); }
__device__ __forceinline__ unsigned xb_xcc_id() { return (unsigned)__builtin_amdgcn_s_getreg((3 << 11) | 20) & 0xFu; }
#define XB_SPIN(cond, bar) do { unsigned _sp = 0; while (cond) { __builtin_amdgcn_s_sleep(1); \
    if ((++_sp & 255u) == 0u) { if (xb_ld(&(bar)[XB_TMO])) break; if (_sp > XB_SPIN_CAP) { atomicAdd(&(bar)[XB_TMO], 1u); break; } } } } while (0)
struct XcdBarrier { unsigned* bar; unsigned x; volatile LAS unsigned* st; };
__device__ __forceinline__ XcdBarrier xcd_barrier_post(unsigned* bar, volatile LAS unsigned* st) {
    XcdBarrier b; b.bar = bar; b.x = xb_xcc_id(); b.st = st;
    if (threadIdx.x == 0) (void)xb_add(&bar[XB_XCNT(b.x)], 1u);
    return b;
}
__device__ __forceinline__ void xcd_barrier_complete(unsigned* bar, unsigned x, unsigned& nloc, unsigned& nx) {
    const unsigned G = gridDim.x * gridDim.y * gridDim.z;
    unsigned sum, cnt, mine, sp = 0u;
    for (;;) {
        sum = 0u; cnt = 0u; mine = 0u;
#pragma unroll
        for (unsigned j = 0; j < 16; ++j) { const unsigned c = xb_ld(&bar[XB_XCNT(j)]); sum += c; cnt += (c > 0u) ? 1u : 0u; mine = (j == x) ? c : mine; }
        if (sum == G) break;
        __builtin_amdgcn_s_sleep(1);
        if ((++sp & 255u) == 0u) { if (xb_ld(&bar[XB_TMO])) break; if (sp > XB_SPIN_CAP) { atomicAdd(&bar[XB_TMO], 1u); break; } }
    }
    nloc = mine > 0u ? mine : 1u; nx = cnt > 0u ? cnt : 1u;
}
__device__ __forceinline__ void xcd_barrier(const XcdBarrier& b) {
    asm volatile("s_waitcnt vmcnt(0)" ::: "memory");
    __syncthreads();
    if (threadIdx.x == 0) {
        unsigned* bar = b.bar;
        __builtin_amdgcn_s_waitcnt(0);
        unsigned nloc = b.st[0], nx = b.st[1];
        if (nloc == 0u) { xcd_barrier_complete(bar, b.x, nloc, nx); b.st[0] = nloc; b.st[1] = nx; }
        const unsigned old = xb_add(&bar[XB_XSUB(b.x)], 1u);
        const unsigned gen = old / nloc;
        if (old + 1u == (gen + 1u) * nloc) {
            __builtin_amdgcn_fence(__ATOMIC_RELEASE, "agent");
            asm volatile("s_waitcnt vmcnt(0)" ::: "memory");
            const unsigned og = xb_add(&bar[XB_TOP], 1u);
            const unsigned tg = og / nx;
            if (og + 1u == (tg + 1u) * nx) xb_add(&bar[XB_TOPGEN], 1u);
            else XB_SPIN(xb_ld(&bar[XB_TOPGEN]) == tg, bar);
            __builtin_amdgcn_fence(__ATOMIC_ACQUIRE, "agent");
            xb_add(&bar[XB_XGEN(b.x)], 1u);
            asm volatile("s_waitcnt vmcnt(0)" ::: "memory");
        } else {
            XB_SPIN(xb_ld(&bar[XB_XGEN(b.x)]) == gen, bar);
            __builtin_amdgcn_fence(__ATOMIC_ACQUIRE, "agent");
            asm volatile("s_waitcnt vmcnt(0)" ::: "memory");
        }
    }
    __syncthreads();
}


struct TileSched {
  int NT, m0, cnt, ntiles, nfull, local, nloc;
  __device__ __forceinline__ void init(int MT, int NT_) {
    NT = NT_;
    const int x = blockIdx.x & 7; local = blockIdx.x >> 3; nloc = gridDim.x >> 3;
    const int q = MT >> 3, r = MT & 7;
    cnt = q + (x < r ? 1 : 0); m0 = x * q + (x < r ? x : r);
    ntiles = cnt * NT; nfull = cnt >> 3;
  }
  int MTe, lin0;
  __device__ __forceinline__ void init_even(int MT, int NT_) {
    NT = NT_; MTe = MT;
    const int x = blockIdx.x & 7; local = blockIdx.x >> 3; nloc = gridDim.x >> 3;
    const int T = MT * NT_;
    lin0 = (int)(((long)T * x) >> 3);
    ntiles = (int)(((long)T * (x + 1)) >> 3) - lin0;
  }
  __device__ __forceinline__ void get_even(int i, int& mt, int& nt) const {
    const int L = lin0 + i, nfullg = MTe >> 3, full = nfullg * 8 * NT;
    if (L < full) { const int grp = L / (8 * NT), rem = L - grp * 8 * NT; nt = rem >> 3; mt = grp * 8 + (rem & 7); }
    else { const int i2 = L - full, gs = MTe - nfullg * 8; nt = i2 / gs; mt = nfullg * 8 + (i2 - nt * gs); }
  }
  __device__ __forceinline__ void get(int i, int& mt, int& nt) const {
    const int full = nfull * 8 * NT;
    if (i < full) { const int grp = i / (8 * NT), rem = i - grp * 8 * NT; nt = rem >> 3; mt = m0 + grp * 8 + (rem & 7); }
    else { const int i2 = i - full, gs = cnt - nfull * 8; nt = i2 / gs; mt = m0 + nfull * 8 + (i2 - nt * gs); }
  }
};

__device__ __forceinline__ float row_rstd(const float* ssq, int row) {
  float s = 0.f;
#pragma unroll
  for (int q = 0; q < 4; ++q) s += ssq[(size_t)q * NR + row];
  return rsqrtf(s * (1.f / 1024.f) + EPSN);
}

__device__ __forceinline__ void transpose_mat(const float* src, int ldsrc, int K, int N, bf16_t* dst, const float* scale, int kind, float* sm) {
  const int tid = threadIdx.x & 255;
  sm += (threadIdx.x >> 8) * 8448;
  const int nnb = N >> 7, ntile = (K >> 6) * nnb;
  for (int tile2 = blockIdx.x; tile2 < (ntile >> 1); tile2 += gridDim.x) {
    const int tile = tile2 * 2 + (threadIdx.x >> 8);
    const int kb = tile / nnb, nb4 = tile - kb * nnb;
    const int i = tid >> 3, j4 = tid & 7;
    float4 v[4][2];
#pragma unroll
    for (int sub = 0; sub < 4; ++sub) {
      const int nb = nb4 * 4 + sub;
      int scol;
      if (kind == 0) scol = nb * 32;
      else if (kind == 1) scol = nb * 32 < 1536 ? nb * 32 : nb * 32 + 16;
      else { int j = nb >> 3, half = (nb >> 2) & 1; scol = half * 2816 + j * 128 + (nb & 3) * 32; }
#pragma unroll
      for (int r = 0; r < 2; ++r) v[sub][r] = *(const float4*)(src + (size_t)(kb * 64 + i + 32 * r) * ldsrc + scol + j4 * 4);
    }
    const float sc0 = scale ? scale[kb * 64 + i] : 1.f, sc1 = scale ? scale[kb * 64 + i + 32] : 1.f;
#pragma unroll
    for (int sub = 0; sub < 4; ++sub) {
#pragma unroll
      for (int r = 0; r < 2; ++r) {
        const float sc = r ? sc1 : sc0;
        float* d = sm + sub * 2112 + (i + 32 * r) * 33 + j4 * 4;
        d[0] = v[sub][r].x * sc; d[1] = v[sub][r].y * sc; d[2] = v[sub][r].z * sc; d[3] = v[sub][r].w * sc;
      }
    }
    __syncthreads();
    {
      const int n = tid >> 3, kq = tid & 7;
#pragma unroll
      for (int sub = 0; sub < 4; ++sub) {
        const float* s2 = sm + sub * 2112 + (kq * 8) * 33 + n;
        uint4 o;
        o.x = pack2(s2[0], s2[33]); o.y = pack2(s2[66], s2[99]); o.z = pack2(s2[132], s2[165]); o.w = pack2(s2[198], s2[231]);
        *(uint4*)(dst + (size_t)((nb4 * 4 + sub) * 32 + n) * K + kb * 64 + kq * 8) = o;
      }
    }
    __syncthreads();
  }
}

__device__ __forceinline__ void phase_prep(const Params& p, char* lds) {
  const int tid = threadIdx.x, lane = tid & 63;
  bf16_t* wb = (bf16_t*)p.out;
  {
    bf16_t* xb = (bf16_t*)(p.ws + WS_XB);
    float* ssq = (float*)(p.ws + WS_SSQ2);
    const int gw = blockIdx.x * 8 + (tid >> 6), nw = gridDim.x * 8;
    for (int r = gw; r < NR; r += nw) {
      const float4* src = (const float4*)xrow_src(p, r);
      float s = 0.f;
#pragma unroll
      for (int j = 0; j < 4; ++j) {
        float4 v = src[lane + 64 * j];
        s += v.x * v.x + v.y * v.y + v.z * v.z + v.w * v.w;
        uint2 o; o.x = pack2(v.x, v.y); o.y = pack2(v.z, v.w);
        *(uint2*)(xb + (size_t)r * 1024 + (lane + 64 * j) * 4) = o;
      }
      s = wave_sum(s);
      if (lane < 4) ssq[(size_t)lane * NR + r] = lane == 0 ? s : 0.f;
    }
  }
  float* sm = (float*)lds;
  transpose_mat(p.in[10], 2064, 1024, 2048, wb + W_IN0, p.in[9], 1, sm);
  transpose_mat(p.in[22], 512, 512, 512, wb + W_GLU, nullptr, 0, sm);
  transpose_mat(p.in[24], 1024, 1024, 1024, wb + W_OUT0, nullptr, 0, sm);
  transpose_mat(p.in[36], 5632, 1024, 5632, wb + W_UP, p.in[35], 2, sm);
  transpose_mat(p.in[36] + (size_t)1024 * 5632, 5632, 1024, 5632, wb + W_UP + (size_t)5632 * 1024, p.in[35] + 1024, 2, sm);
  transpose_mat(p.in[39], 1024, 2816, 1024, wb + W_DOWN, nullptr, 0, sm);
  transpose_mat(p.in[39] + (size_t)2816 * 1024, 1024, 2816, 1024, wb + W_DOWN + (size_t)1024 * 2816, nullptr, 0, sm);
  transpose_mat(p.in[26], 3072, 1024, 3072, wb + W_IN1, p.in[25], 0, sm);
  transpose_mat(p.in[34], 1024, 1536, 1024, wb + W_OUT1, nullptr, 0, sm);
  const int gt = blockIdx.x * 512 + tid, ngt = gridDim.x * 512;
  for (int idx = gt; idx < 256 * 1024; idx += ngt) {
    const int c = idx >> 10, k = idx & 1023;
    const float* wi = p.in[10] + (size_t)k * 2064 + 1536;
    float s = 0.f;
#pragma unroll
    for (int r = 0; r < 16; ++r) s += wi[r] * p.in[11][r * 256 + c];
    wb[W_IN0 + (size_t)(2048 + c) * 1024 + k] = f2bf(s * p.in[9][k]);
  }
  for (int idx = gt; idx < 2 * 16 * 96 * 96; idx += ngt) {
    const int mat = idx / 147456, rem = idx - mat * 147456;
    const int nb = rem / 9216, r2 = rem - nb * 9216, d = r2 / 96, c = r2 - d * 96;
    const float* src = mat ? p.in[31] : p.in[29];
    wb[W_GATE + idx] = f2bf(src[nb * 9216 + c * 96 + d]);
  }
  for (int idx = gt; idx < 1536; idx += ngt) ((float*)(p.ws + WS_NSP))[idx] = -8.f * softplusf_(-p.in[33][idx]);
  for (int idx = gt; idx < 2048; idx += ngt) {
    const int g = idx >> 6;
    const float dt = expf(p.in[16][g]);
    const float lr = p.in[14][idx], li = p.in[15][idx];
    const float y = li * dt;
    const float kk = rintf(y * 0.15915494309189535f);
    float yr = fmaf(-kk, 6.2831854820251465f, y);
    yr = fmaf(-kk, -1.7484555e-7f, yr);
    const float sn = sinf(yr), cs = cosf(yr);
    const float mag = expf(lr * dt);
    const float abr = mag * cs, abi = mag * sn;
    const float sh = sinf(0.5f * yr);
    const float nr = expm1f(lr * dt) * cs - 2.f * sh * sh, ni = abi;
    const float den = lr * lr + li * li;
    const float fr = (nr * lr + ni * li) / den, fi = (ni * lr - nr * li) / den;
    float* ab = (float*)(p.ws + WS_S5AB);
    ab[idx] = abr; ab[2048 + idx] = abi;
    float pr = abr, pi = abi;
#pragma unroll
    for (int q = 0; q < 4; ++q) { float t = pr * pr - pi * pi; pi = 2.f * pr * pi; pr = t; }
    ab[4096 + idx] = pr; ab[6144 + idx] = pi;
#pragma unroll
    for (int q = 0; q < 2; ++q) { float t = pr * pr - pi * pi; pi = 2.f * pr * pi; pr = t; }
    ab[8192 + idx] = pr; ab[10240 + idx] = pi;
    float* bbr = (float*)(p.ws + WS_S5BB);
    float* bbi = bbr + 2048 * 16;
#pragma unroll
    for (int h = 0; h < 16; ++h) {
      const float br = p.in[17][idx * 16 + h], bi = p.in[18][idx * 16 + h];
      bbr[idx * 16 + h] = fr * br - fi * bi;
      bbi[idx * 16 + h] = fr * bi + fi * br;
    }
    bf16_t* cc = (bf16_t*)(p.ws + WS_S5CC);
    const int pp = idx & 63;
#pragma unroll
    for (int h = 0; h < 16; ++h) {
      cc[(g * 16 + h) * 128 + 2 * pp] = f2bf(p.in[19][(g * 16 + h) * 64 + pp]);
      cc[(g * 16 + h) * 128 + 2 * pp + 1] = f2bf(-p.in[20][(g * 16 + h) * 64 + pp]);
    }
  }
}

__device__ __forceinline__ void g1_store(const Params& p, bf16_t* zb, float* alog, int row, int col, float v0, float v1, float v2, float v3) {
  if (col < 2048) {
    if (col < 256) { v0 *= 0.125f; v1 *= 0.125f; v2 *= 0.125f; v3 *= 0.125f; }
    uint2 o; o.x = pack2(v0, v1); o.y = pack2(v2, v3);
    *(uint2*)(zb + (size_t)row * 2048 + col) = o;
  } else {
    const int c = col - 2048;
    const float4 ba = *(const float4*)(p.in[12] + c);
    float4 o;
    o.x = -softplusf_(-(v0 + ba.x)) * 0.0625f; o.y = -softplusf_(-(v1 + ba.y)) * 0.0625f;
    o.z = -softplusf_(-(v2 + ba.z)) * 0.0625f; o.w = -softplusf_(-(v3 + ba.w)) * 0.0625f;
    *(float4*)(alog + (size_t)row * 256 + c) = o;
  }
}
__device__ __forceinline__ void phase_g1(const Params& p, char* lds) {
  int tid, lane, w, wr, wc, lr, lq; TREFRESH();
  const bf16_t* zp = (const bf16_t*)(p.ws + WS_ZERO);
  const bf16_t* xb = (const bf16_t*)(p.ws + WS_XB);
  const bf16_t* W = (const bf16_t*)p.out + W_IN0;
  const float* ssq = (const float*)(p.ws + WS_SSQ2);
  bf16_t* zb = (bf16_t*)(p.ws + WS_SCR + SCR_ZB);
  float* alog = (float*)(p.ws + WS_SCR + SCR_ALOG);
  float* srs = (float*)(lds + LDS_SRS);
  unsigned* flg = (unsigned*)(p.ws + WS_FLAG);
  const int u = blockIdx.x;
  const bool unitA = u < 128, unitB = u >= 128 && u < 164;
  const int umt = unitA ? (u >> 1) : 64, unt = unitA ? 8 : ((u - 128) >> 2), uks = unitA ? (u & 1) : ((u - 128) & 3);
  const int uK = unitA ? 512 : 256, nsl = unitA ? 2 : 4;
  float* slab0 = unitA ? (float*)(p.ws + WS_SCR + SCR_SLOC) + (size_t)(u >> 1) * 2 * 65536 : (float*)(p.ws + WS_SLAB) + (size_t)unt * 4 * 65536;
  unsigned* tick = unitA ? flg + 4432 + (u >> 1) : flg + 4496 + unt;
  if (unitA || unitB) {
    const int k0 = uks * uK;
    f32x4 acc[8][4];
    gemm_tile256(acc, xb + k0, [&](int i) { return (umt * 256 + i) * 1024; }, W + (size_t)unt * 256 * 1024 + k0, 1024, uK, lds, zp);
    TREFRESH(); int zE = 0; asm volatile("" : "+v"(zE));
    float* slab = slab0 + (size_t)uks * 65536;
#pragma unroll
    for (int m = 0; m < 8; ++m)
#pragma unroll
      for (int n = 0; n < 4; ++n)
        *(float4*)(slab + ((m >> 2) * 128 + wr * 64 + (m & 3) * 16 + lr + zE) * 256 + (n >> 1) * 128 + wc * 32 + (n & 1) * 16 + lq * 4 + zE) = make_float4(acc[m][n][0], acc[m][n][1], acc[m][n][2], acc[m][n][3]);
    asm volatile("s_waitcnt vmcnt(0)" ::: "memory");
    __syncthreads();
    if (tid == 0) {
      __builtin_amdgcn_fence(__ATOMIC_RELEASE, "agent");
      asm volatile("s_waitcnt vmcnt(0)" ::: "memory");
      (void)xb_add(tick, 1u);
    }
  }
  TileSched ts; ts.init(64, 8);
  for (int ti = ts.local; ti < ts.ntiles; ti += ts.nloc) {
    int mt, nt; ts.get(ti, mt, nt);
    if (tid < 256) srs[tid] = row_rstd(ssq, mt * 256 + tid);
    f32x4 acc[8][4];
    gemm_tile256(acc, xb, [&](int i) { return (mt * 256 + i) * 1024; }, W + (size_t)nt * 256 * 1024, 1024, 1024, lds, zp);
    TREFRESH(); int zE = 0; asm volatile("" : "+v"(zE));
#pragma unroll
    for (int m = 0; m < 8; ++m) {
      const int r = (m >> 2) * 128 + wr * 64 + (m & 3) * 16 + lr + zE, row = mt * 256 + r;
      const float rs = srs[r];
#pragma unroll
      for (int n = 0; n < 4; ++n) {
        const int col = nt * 256 + (n >> 1) * 128 + wc * 32 + (n & 1) * 16 + lq * 4 + zE;
        f32x4 v = acc[m][n] * rs;
        if (col < 256) v = v * 0.125f;
        uint2 o; o.x = pack2(v[0], v[1]); o.y = pack2(v[2], v[3]);
        *(uint2*)(zb + (size_t)row * 2048 + col) = o;
      }
    }
    __syncthreads();
  }
  if (unitA || unitB) {
    if (tid == 0) {
      XB_SPIN(xb_ld(tick) < (unsigned)nsl, (unsigned*)(p.ws + WS_BAR));
      __builtin_amdgcn_fence(__ATOMIC_ACQUIRE, "agent");
      asm volatile("s_waitcnt vmcnt(0)" ::: "memory");
    }
    __syncthreads();
    const int rpb = 256 / nsl, r0 = uks * rpb;
    for (int rr = r0 + (tid >> 6); rr < r0 + rpb; rr += 8) {
      const int c4 = tid & 63, row = umt * 256 + rr, col = unt * 256 + c4 * 4;
      const float* s4 = slab0 + rr * 256 + c4 * 4;
      float4 sum = make_float4(0.f, 0.f, 0.f, 0.f);
      for (int q = 0; q < nsl; ++q) { const float4 v = *(const float4*)(s4 + (size_t)q * 65536); sum.x += v.x; sum.y += v.y; sum.z += v.z; sum.w += v.w; }
      const float rs = row_rstd(ssq, row);
      g1_store(p, zb, alog, row, col, sum.x * rs, sum.y * rs, sum.z * rs, sum.w * rs);
    }
  }
}

__device__ __forceinline__ void gla_chunk(const Params& p, int item, int mode, char* lds) {
  const int tid = threadIdx.x & 255, lane = tid & 63, w = tid >> 6, lr = lane & 15, lq = lane >> 4;
  const int bh = item / 33, c = item - bh * 33, b = bh >> 2, h = bh & 3;
  const int row0 = b * TP + (c == 0 ? 0 : 16 + 64 * (c - 1));
  const int len = c == 0 ? 16 : 64;
  bf16_t* zb = (bf16_t*)(p.ws + WS_SCR + SCR_ZB);
  const float* alog = (const float*)(p.ws + WS_SCR + SCR_ALOG);
  float* sloc = (float*)(p.ws + WS_SCR + SCR_SLOC) + (size_t)(bh * 33 + c) * 8192;
  float* sb = (float*)lds;
  char* Qs = lds + 16384; char* Ks = lds + 24576; char* VT = lds + 32768; char* ST = lds + 49152;
#pragma unroll
  for (int i = 0; i < 4; ++i) {
    const int idx = tid + 256 * i, r = idx >> 4, c4 = idx & 15;
    float4 v = make_float4(0.f, 0.f, 0.f, 0.f);
    if (r < len) v = *(const float4*)(alog + (size_t)(row0 + r) * 256 + h * 64 + c4 * 4);
    *(float4*)(sb + r * 64 + c4 * 4) = v;
  }
  __syncthreads();
  {
    float run = 0.f;
#pragma unroll
    for (int t = 0; t < 16; ++t) { run += sb[(16 * w + t) * 64 + lane]; sb[(16 * w + t) * 64 + lane] = run; }
  }
  __syncthreads();
  float off = 0.f;
#pragma unroll
  for (int s = 0; s < 3; ++s) if (s < w) off += sb[(16 * s + 15) * 64 + lane];
  __syncthreads();
#pragma unroll
  for (int t = 0; t < 16; ++t) sb[(16 * w + t) * 64 + lane] += off;
  __syncthreads();
#pragma unroll
  for (int i = 0; i < 2; ++i) {
    const int idx = tid + 256 * i, r = idx & 63, ch = idx >> 6;
    uint4 qv = make_uint4(0, 0, 0, 0), kv = make_uint4(0, 0, 0, 0);
    if (r < len) {
      const bf16_t* zr = zb + (size_t)(row0 + r) * 2048 + h * 64 + ch * 8;
      qv = *(const uint4*)zr; kv = *(const uint4*)(zr + 256);
    }
    float bv[8];
#pragma unroll
    for (int e = 0; e < 8; ++e) bv[e] = sb[r * 64 + ch * 8 + e];
    const uint32_t qq[4] = {qv.x, qv.y, qv.z, qv.w}, kq[4] = {kv.x, kv.y, kv.z, kv.w};
    if (mode == 1) {
      uint32_t oq[4], ok[4];
#pragma unroll
      for (int e = 0; e < 4; ++e) {
        const float e0 = __expf(bv[2 * e]), e1 = __expf(bv[2 * e + 1]);
        oq[e] = pack2(lo2f(qq[e]) * e0, hi2f(qq[e]) * e1);
        ok[e] = pack2(lo2f(kq[e]) / e0, hi2f(kq[e]) / e1);
      }
      *(uint4*)(Qs + toff(r, ch)) = make_uint4(oq[0], oq[1], oq[2], oq[3]);
      *(uint4*)(Ks + toff(r, ch)) = make_uint4(ok[0], ok[1], ok[2], ok[3]);
    } else {
#pragma unroll
      for (int e = 0; e < 8; ++e) {
        const int d = ch * 8 + e;
        const float kf = (e & 1) ? hi2f(kq[e >> 1]) : lo2f(kq[e >> 1]);
        const float kh = kf * __expf(sb[63 * 64 + d] - bv[e]);
        *(bf16_t*)(Qs + d * 128 + ((((r >> 3) ^ (d & 7))) << 4) + (r & 7) * 2) = f2bf(kh);
      }
    }
  }
#pragma unroll
  for (int i = 0; i < 4; ++i) {
    const int idx = tid + 256 * i, r = idx & 63, ch = idx >> 6;
    uint4 vv = make_uint4(0, 0, 0, 0);
    if (r < len) vv = *(const uint4*)(zb + (size_t)(row0 + r) * 2048 + 512 + h * 128 + ch * 8);
    const uint32_t vq[4] = {vv.x, vv.y, vv.z, vv.w};
#pragma unroll
    for (int e = 0; e < 8; ++e) {
      const int ee = ch * 8 + e;
      const bf16_t val = (bf16_t)((e & 1) ? (vq[e >> 1] >> 16) : (vq[e >> 1] & 0xffffu));
      *(bf16_t*)(VT + ee * 128 + ((((r >> 3) ^ (ee & 7))) << 4) + (r & 7) * 2) = val;
    }
  }
  if (mode == 1) {
#pragma unroll
    for (int i = 0; i < 4; ++i) {
      const int idx = tid + 256 * i, e = idx >> 3, ch = idx & 7;
      const float4 a = *(const float4*)(sloc + e * 64 + ch * 8);
      const float4 bq = *(const float4*)(sloc + e * 64 + ch * 8 + 4);
      *(uint4*)(ST + toff(e, ch)) = make_uint4(pack2(a.x, a.y), pack2(a.z, a.w), pack2(bq.x, bq.y), pack2(bq.z, bq.w));
    }
  }
  __syncthreads();
  if (mode == 1) {
    f32x4 at[4];
#pragma unroll
    for (int n = 0; n < 4; ++n) at[n] = (f32x4){0.f, 0.f, 0.f, 0.f};
#pragma unroll
    for (int s = 0; s < 2; ++s) {
      const bf16x8 a = *(const bf16x8*)(Qs + toff(16 * w + lr, s * 4 + lq));
#pragma unroll
      for (int n = 0; n < 4; ++n) {
        const bf16x8 bk = *(const bf16x8*)(Ks + toff(16 * n + lr, s * 4 + lq));
        at[n] = mfma16(bk, a, at[n]);
      }
    }
    char* P = lds;
    const int i = 16 * w + lr;
#pragma unroll
    for (int n = 0; n < 4; ++n) {
      const int j0 = 16 * n + lq * 4;
      float v0 = (j0 + 0 <= i) ? at[n][0] : 0.f, v1 = (j0 + 1 <= i) ? at[n][1] : 0.f;
      float v2 = (j0 + 2 <= i) ? at[n][2] : 0.f, v3 = (j0 + 3 <= i) ? at[n][3] : 0.f;
      uint2 o; o.x = pack2(v0, v1); o.y = pack2(v2, v3);
      *(uint2*)(P + i * 128 + ((((j0 >> 3) ^ (i & 7))) << 4) + (j0 & 7) * 2) = o;
    }
    __syncthreads();
    f32x4 o[8];
#pragma unroll
    for (int n = 0; n < 8; ++n) o[n] = (f32x4){0.f, 0.f, 0.f, 0.f};
#pragma unroll
    for (int s = 0; s < 2; ++s) {
      const bf16x8 aP = *(const bf16x8*)(P + toff(16 * w + lr, s * 4 + lq));
      const bf16x8 aQ = *(const bf16x8*)(Qs + toff(16 * w + lr, s * 4 + lq));
#pragma unroll
      for (int n = 0; n < 8; ++n) {
        const bf16x8 bV = *(const bf16x8*)(VT + toff(16 * n + lr, s * 4 + lq));
        const bf16x8 bS = *(const bf16x8*)(ST + toff(16 * n + lr, s * 4 + lq));
        o[n] = mfma16(bV, aP, o[n]);
        o[n] = mfma16(bS, aQ, o[n]);
      }
    }
    float ss = 0.f;
#pragma unroll
    for (int n = 0; n < 8; ++n) ss += o[n][0] * o[n][0] + o[n][1] * o[n][1] + o[n][2] * o[n][2] + o[n][3] * o[n][3];
    ss += __shfl_xor(ss, 16); ss += __shfl_xor(ss, 32);
    const float rstd = rsqrtf(ss * (1.f / 128.f) + EPSN);
    if (i < len) {
      bf16_t* zr = zb + (size_t)(row0 + i) * 2048;
#pragma unroll
      for (int n = 0; n < 8; ++n) {
        const int e0 = 16 * n + lq * 4;
        const uint2 g2 = *(const uint2*)(zr + 1024 + h * 128 + e0);
        const float4 gn = *(const float4*)(p.in[13] + h * 128 + e0);
        const float g0 = lo2f(g2.x), g1 = hi2f(g2.x), g2f = lo2f(g2.y), g3 = hi2f(g2.y);
        uint2 ov;
        ov.x = pack2(o[n][0] * rstd * gn.x * g0 * sigm(g0), o[n][1] * rstd * gn.y * g1 * sigm(g1));
        ov.y = pack2(o[n][2] * rstd * gn.z * g2f * sigm(g2f), o[n][3] * rstd * gn.w * g3 * sigm(g3));
        *(uint2*)(zr + 512 + h * 128 + e0) = ov;
      }
    }
  } else {
    f32x4 sl[8];
#pragma unroll
    for (int n = 0; n < 8; ++n) sl[n] = (f32x4){0.f, 0.f, 0.f, 0.f};
#pragma unroll
    for (int s = 0; s < 2; ++s) {
      const bf16x8 aK = *(const bf16x8*)(Qs + toff(16 * w + lr, s * 4 + lq));
#pragma unroll
      for (int n = 0; n < 8; ++n) {
        const bf16x8 bV = *(const bf16x8*)(VT + toff(16 * n + lr, s * 4 + lq));
        sl[n] = mfma16(aK, bV, sl[n]);
      }
    }
#pragma unroll
    for (int n = 0; n < 8; ++n) {
      const int e = 16 * n + lr, d0 = 16 * w + lq * 4;
      *(float4*)(sloc + e * 64 + d0) = make_float4(sl[n][0], sl[n][1], sl[n][2], sl[n][3]);
    }
    if (tid < 64) ((float*)(p.ws + WS_DEC))[(bh * 33 + c) * 64 + tid] = __expf(sb[63 * 64 + tid]);
  }
  __syncthreads();
}

__device__ __forceinline__ void gla_sample(const Params& p, int item, char* lds) {
  const int tid = threadIdx.x & 255;
  const int s = item >> 2, h = item & 3, row = NPR + s;
  bf16_t* zb = (bf16_t*)(p.ws + WS_SCR + SCR_ZB);
  const float* alog = (const float*)(p.ws + WS_SCR + SCR_ALOG);
  float* sq = (float*)lds; float* sk = sq + 64; float* sa = sk + 64; float* part = sa + 64; float* red = part + 256;
  if (tid < 64) {
    sq[tid] = bf2f(zb[(size_t)row * 2048 + h * 64 + tid]);
    sk[tid] = bf2f(zb[(size_t)row * 2048 + 256 + h * 64 + tid]);
    sa[tid] = __expf(alog[(size_t)row * 256 + h * 64 + tid]);
  }
  __syncthreads();
  const int e = tid & 127, half = tid >> 7;
  const float v = bf2f(zb[(size_t)row * 2048 + 512 + h * 128 + e]);
  const float* S0 = p.in[2] + (size_t)(s * 4 + h) * 8192;
  float* So = p.out + O_GLAS + (size_t)(s * 4 + h) * 8192;
  float acc = 0.f;
#pragma unroll 8
  for (int dd = 0; dd < 32; ++dd) {
    const int d = half * 32 + dd;
    const float sn = sa[d] * S0[d * 128 + e] + sk[d] * v;
    So[d * 128 + e] = sn;
    acc += sq[d] * sn;
  }
  part[tid] = acc;
  __syncthreads();
  float o = 0.f;
  if (tid < 128) { o = part[tid] + part[tid + 128]; }
  float ssv = wave_sum(tid < 128 ? o * o : 0.f);
  if ((tid & 63) == 0) red[tid >> 6] = ssv;
  __syncthreads();
  if (tid < 128) {
    const float rstd = rsqrtf((red[0] + red[1]) * (1.f / 128.f) + EPSN);
    const float g = bf2f(zb[(size_t)row * 2048 + 1024 + h * 128 + e]);
    zb[(size_t)row * 2048 + 512 + h * 128 + e] = f2bf(o * rstd * p.in[13][h * 128 + e] * g * sigm(g));
  }
  __syncthreads();
}

typedef __attribute__((ext_vector_type(2))) float f32x2;
__device__ __forceinline__ void s5_load_u(const bf16_t* zb, int row0, int len, int g, int lane, char* ul) {
  uint4 a = make_uint4(0, 0, 0, 0), b = a;
  if (lane < len) {
    const uint4* s = (const uint4*)(zb + (size_t)(row0 + lane) * 2048 + 1536 + g * 16);
    a = s[0]; b = s[1];
  }
  float4* d = (float4*)(ul + lane * 64);
  d[0] = make_float4(lo2f(a.x), hi2f(a.x), lo2f(a.y), hi2f(a.y));
  d[1] = make_float4(lo2f(a.z), hi2f(a.z), lo2f(a.w), hi2f(a.w));
  d[2] = make_float4(lo2f(b.x), hi2f(b.x), lo2f(b.y), hi2f(b.y));
  d[3] = make_float4(lo2f(b.z), hi2f(b.z), lo2f(b.w), hi2f(b.w));
}
__device__ __forceinline__ void s5_load_bb(const float* bbrp, int idx, f32x2 (&bb)[16]) {
#pragma unroll
  for (int q = 0; q < 4; ++q) {
    const float4 x = *(const float4*)(bbrp + idx * 16 + q * 4), y = *(const float4*)(bbrp + 32768 + idx * 16 + q * 4);
    bb[4 * q] = (f32x2){x.x, y.x}; bb[4 * q + 1] = (f32x2){x.y, y.y}; bb[4 * q + 2] = (f32x2){x.z, y.z}; bb[4 * q + 3] = (f32x2){x.w, y.w};
  }
}
__device__ __forceinline__ void s5_step(const char* ul, int t, const f32x2 (&bb)[16], float ar, float ai, float& xr, float& xi) {
  const float4* u = (const float4*)(ul + t * 64);
  const float4 u0 = u[0], u1 = u[1], u2 = u[2], u3 = u[3];
  f32x2 acc = bb[0] * u0.x;
  acc += bb[1] * u0.y; acc += bb[2] * u0.z; acc += bb[3] * u0.w;
  acc += bb[4] * u1.x; acc += bb[5] * u1.y; acc += bb[6] * u1.z; acc += bb[7] * u1.w;
  acc += bb[8] * u2.x; acc += bb[9] * u2.y; acc += bb[10] * u2.z; acc += bb[11] * u2.w;
  acc += bb[12] * u3.x; acc += bb[13] * u3.y; acc += bb[14] * u3.z; acc += bb[15] * u3.w;
  const float nr = ar * xr - ai * xi + acc[0], ni = ar * xi + ai * xr + acc[1];
  xr = nr; xi = ni;
}

__device__ __forceinline__ void s5_pass1(const Params& p, char* lds) {
  const int tid = threadIdx.x, lane = tid & 63, w = tid >> 6;
  const bf16_t* zb = (const bf16_t*)(p.ws + WS_SCR + SCR_ZB);
  const float* ab = (const float*)(p.ws + WS_S5AB);
  const float* bbrp = (const float*)(p.ws + WS_S5BB);
  float* xloc = (float*)(p.ws + WS_XLOC);
  char* ul = lds + w * 4096;
  const int nitem = 8 * 32 * 32;
  for (int base = blockIdx.x * 8; base < nitem; base += gridDim.x * 8) {
    const int item = base + w;
    const bool valid = item < nitem;
    const int it = valid ? item : 0;
    const int bg = it >> 5, c = it & 31, b = bg >> 5, g = bg & 31;
    const int row0 = b * TP + (c == 0 ? 0 : 16 + 64 * (c - 1));
    const int len = c == 0 ? 16 : 64;
    const int idx = g * 64 + lane;
    f32x2 bb[16];
    s5_load_bb(bbrp, idx, bb);
    const float ar = ab[idx], ai = ab[2048 + idx];
    __syncthreads();
    s5_load_u(zb, row0, len, g, lane, ul);
    __syncthreads();
    float xr = 0.f, xi = 0.f;
    for (int t = 0; t < len; ++t) s5_step(ul, t, bb, ar, ai, xr, xi);
    if (valid) {
      xloc[(size_t)(bg * 33 + c) * 64 + lane] = xr;
      xloc[540672 + (size_t)(bg * 33 + c) * 64 + lane] = xi;
    }
  }
}

__device__ __forceinline__ void s5_pass2(const Params& p) {
  const int gt = blockIdx.x * 512 + threadIdx.x;
  if (gt >= 16384) return;
  const int bg = gt >> 6, pp = gt & 63, g = bg & 31, idx = g * 64 + pp;
  const float* ab = (const float*)(p.ws + WS_S5AB);
  const float* xloc = (const float*)(p.ws + WS_XLOC);
  float* xst = (float*)(p.ws + WS_XST);
  const float a16r = ab[4096 + idx], a16i = ab[6144 + idx], a64r = ab[8192 + idx], a64i = ab[10240 + idx];
  float xr = 0.f, xi = 0.f;
  const size_t o0 = (size_t)bg * 33 * 64 + pp;
  xst[o0] = 0.f; xst[540672 + o0] = 0.f;
#pragma unroll 1
  for (int c0 = 0; c0 < 32; c0 += 8) {
    float lr_[8], li_[8];
#pragma unroll
    for (int q = 0; q < 8; ++q) { lr_[q] = xloc[o0 + (c0 + q) * 64]; li_[q] = xloc[540672 + o0 + (c0 + q) * 64]; }
#pragma unroll
    for (int q = 0; q < 8; ++q) {
      const int c = c0 + q;
      const float Ar = c == 0 ? a16r : a64r, Ai = c == 0 ? a16i : a64i;
      const float nr = Ar * xr - Ai * xi + lr_[q], ni = Ar * xi + Ai * xr + li_[q];
      xr = nr; xi = ni;
      xst[o0 + (c + 1) * 64] = xr; xst[540672 + o0 + (c + 1) * 64] = xi;
    }
  }
}

__device__ __forceinline__ void s5_pass3(const Params& p, char* lds) {
  const int tid = threadIdx.x, lane = tid & 63, w = tid >> 6, lr = lane & 15, lq = lane >> 4;
  bf16_t* zb = (bf16_t*)(p.ws + WS_SCR + SCR_ZB);
  const float* ab = (const float*)(p.ws + WS_S5AB);
  const float* bbrp = (const float*)(p.ws + WS_S5BB);
  const float* xst = (const float*)(p.ws + WS_XST);
  const bf16_t* cc = (const bf16_t*)(p.ws + WS_S5CC);
  char* ul = lds + w * 4096;
  char* X = lds + 32768 + w * 8192;
  const int nprompt = 8 * 32 * 33, nitem = nprompt + 128 * 32;
  for (int base = blockIdx.x * 8; base < nitem; base += gridDim.x * 8) {
    const int item = base + w;
    const bool valid = item < nitem;
    const int it = valid ? item : 0;
    int b, g, c, row0, len; bool last, smp;
    float xr, xi;
    if (it < nprompt) {
      const int bg = it / 33; c = it - bg * 33; b = bg >> 5; g = bg & 31; smp = false;
      row0 = b * TP + (c == 0 ? 0 : 16 + 64 * (c - 1)); len = c == 0 ? 16 : 64; last = c == 32;
      xr = xst[(size_t)it * 64 + lane]; xi = xst[540672 + (size_t)it * 64 + lane];
    } else {
      const int i2 = it - nprompt; b = i2 >> 5; g = i2 & 31; c = 0; smp = true;
      row0 = NPR + b; len = 1; last = true;
      xr = p.in[3][(b * 32 + g) * 64 + lane]; xi = p.in[4][(b * 32 + g) * 64 + lane];
    }
    const int idx = g * 64 + lane;
    f32x2 bb[16];
    s5_load_bb(bbrp, idx, bb);
    const float ar = ab[idx], ai = ab[2048 + idx];
    bf16x8 bC[4];
#pragma unroll
    for (int s = 0; s < 4; ++s) bC[s] = *(const bf16x8*)(cc + (g * 16 + lr) * 128 + 32 * s + 8 * lq);
    const float4 dd = *(const float4*)(p.in[21] + g * 16 + lq * 4);
    __syncthreads();
    s5_load_u(zb, row0, len, g, lane, ul);
    __syncthreads();
#pragma unroll 1
    for (int half = 0; half < 2; ++half) {
      const int tl = len - 32 * half < 32 ? len - 32 * half : 32;
      for (int tt = 0; tt < tl; ++tt) {
        s5_step(ul, 32 * half + tt, bb, ar, ai, xr, xi);
        *(uint32_t*)(X + tt * 256 + ((((lane >> 2) ^ (tt & 15))) << 4) + (lane & 3) * 4) = pack2(xr, xi);
      }
      __syncthreads();
      f32x4 y[2];
#pragma unroll
      for (int m = 0; m < 2; ++m) {
        y[m] = (f32x4){0.f, 0.f, 0.f, 0.f};
        const int row = 16 * m + lr;
#pragma unroll
        for (int s = 0; s < 4; ++s) {
          const bf16x8 a = *(const bf16x8*)(X + row * 256 + ((((s * 4 + lq) ^ (row & 15))) << 4));
          y[m] = mfma16(bC[s], a, y[m]);
        }
      }
#pragma unroll
      for (int m = 0; m < 2; ++m) {
        const int t = 32 * half + 16 * m + lr;
        if (valid && t < len) {
          const float4 u4 = *(const float4*)(ul + t * 64 + lq * 16);
          const float y0 = gelu_t(y[m][0] + dd.x * u4.x), y1 = gelu_t(y[m][1] + dd.y * u4.y);
          const float y2 = gelu_t(y[m][2] + dd.z * u4.z), y3 = gelu_t(y[m][3] + dd.w * u4.w);
          uint2 o; o.x = pack2(y0, y1); o.y = pack2(y2, y3);
          *(uint2*)(zb + (size_t)(row0 + t) * 2048 + 1536 + g * 16 + lq * 4) = o;
        }
      }
      __syncthreads();
    }
    if (valid && last) {
      if (smp) { p.out[O_S5RS + (b * 32 + g) * 64 + lane] = xr; p.out[O_S5IS + (b * 32 + g) * 64 + lane] = xi; }
      else { p.out[O_S5RP + (b * 32 + g) * 64 + lane] = xr; p.out[O_S5IP + (b * 32 + g) * 64 + lane] = xi; }
    }
  }
}

__device__ __forceinline__ void phase_mix_a(const Params& p, char* lds) {
  { const int hf = threadIdx.x >> 8; for (int pr = blockIdx.x; pr < 16 * 33; pr += gridDim.x) gla_chunk(p, pr * 2 + hf, 0, lds + hf * HALF_LDS); }
  __syncthreads();
  s5_pass1(p, lds);
}
__device__ __forceinline__ void phase_mix_b(const Params& p) {
  float* slocb = (float*)(p.ws + WS_SCR + SCR_SLOC);
  const float* dec = (const float*)(p.ws + WS_DEC);
  const int gt = blockIdx.x * 512 + threadIdx.x, ngt = gridDim.x * 512;
#pragma unroll 1
  for (int idx = gt; idx < 32 * 8192; idx += ngt) {
    const int bh = idx >> 13, ed = idx & 8191, e = ed >> 6, d = ed & 63;
    float S = 0.f;
#pragma unroll 1
    for (int c0 = 0; c0 < 33; c0 += 11) {
      float tmp[11], dc[11];
#pragma unroll
      for (int q = 0; q < 11; ++q) { tmp[q] = slocb[(size_t)(bh * 33 + c0 + q) * 8192 + ed]; dc[q] = dec[(bh * 33 + c0 + q) * 64 + d]; }
#pragma unroll
      for (int q = 0; q < 11; ++q) { slocb[(size_t)(bh * 33 + c0 + q) * 8192 + ed] = S; S = dc[q] * S + tmp[q]; }
    }
    p.out[O_GLAP + (size_t)(bh * 64 + d) * 128 + e] = S;
  }
  s5_pass2(p);
}
__device__ __forceinline__ void phase_mix_c(const Params& p, char* lds) {
  const int hf = threadIdx.x >> 8;
  for (int pr = blockIdx.x; pr < 16 * 33; pr += gridDim.x) gla_chunk(p, pr * 2 + hf, 1, lds + hf * HALF_LDS);
  __syncthreads();
  for (int pr = blockIdx.x; pr < 256; pr += gridDim.x) gla_sample(p, pr * 2 + hf, lds + hf * HALF_LDS);
  __syncthreads();
  s5_pass3(p, lds);
}

__device__ __forceinline__ void phase_glu(const Params& p, char* lds) {
  int tid, lane, w, wr, wc, lr, lq; TREFRESH();
  const bf16_t* zp = (const bf16_t*)(p.ws + WS_ZERO);
  bf16_t* zb = (bf16_t*)(p.ws + WS_SCR + SCR_ZB);
  const bf16_t* W = (const bf16_t*)p.out + W_GLU;
  TileSched ts; ts.init(65, 2);
  for (int ti = ts.local; ti < ts.ntiles; ti += ts.nloc) {
    int mt, nt; ts.get(ti, mt, nt);
    f32x4 acc[8][4];
    gemm_tile256(acc, (const bf16_t*)zb + 1536, [&](int i) { return (mt * 256 + i) * 2048; }, W + (size_t)nt * 256 * 512, 512, 512, lds, zp);
    TREFRESH(); int zE = 0; asm volatile("" : "+v"(zE));
#pragma unroll
    for (int m = 0; m < 8; ++m) {
      const int row = mt * 256 + (m >> 2) * 128 + wr * 64 + (m & 3) * 16 + lr + zE;
#pragma unroll
      for (int n = 0; n < 4; ++n) {
        const int col = nt * 256 + (n >> 1) * 128 + wc * 32 + (n & 1) * 16 + lq * 4 + zE;
        const uint2 y2 = *(const uint2*)(zb + (size_t)row * 2048 + 1536 + col);
        const float4 bg = *(const float4*)(p.in[23] + col);
        uint2 o;
        o.x = pack2(lo2f(y2.x) * sigm(acc[m][n][0] + bg.x), hi2f(y2.x) * sigm(acc[m][n][1] + bg.y));
        o.y = pack2(lo2f(y2.y) * sigm(acc[m][n][2] + bg.z), hi2f(y2.y) * sigm(acc[m][n][3] + bg.w));
        *(uint2*)(zb + (size_t)row * 2048 + 1024 + col) = o;
      }
      asm volatile("" ::: "memory");
    }
  }
}

__device__ __forceinline__ void phase_resid(const Params& p, char* lds, const bf16_t* A, int lda, const bf16_t* W, int K, int tkbase, int site) {
  int tid, lane, w, wr, wc, lr, lq; TREFRESH();
  const bf16_t* zp = (const bf16_t*)(p.ws + WS_ZERO);
  bf16_t* xb = (bf16_t*)(p.ws + WS_XB);
  float* ssq = (float*)(p.ws + WS_SSQ2) + (size_t)site * 4 * NR;
  const int ks = K >> 8;
  const bool isunit = (int)blockIdx.x < 4 * ks;
  const int unt = (int)blockIdx.x / ks, uksi = (int)blockIdx.x - unt * ks;
  unsigned* tick = (unsigned*)(p.ws + WS_FLAG) + 4352 + tkbase;
  if (isunit) {
    const int nt = unt, k0 = uksi * 256;
    f32x4 acc[8][4];
    gemm_tile256(acc, A + k0, [&](int i) { return (16384 + i) * lda; }, W + (size_t)nt * 256 * K + k0, K, 256, lds, zp);
    TREFRESH(); int zE = 0; asm volatile("" : "+v"(zE));
    float* slab = (float*)(p.ws + WS_SLAB) + (size_t)(nt * ks + uksi) * 65536;
#pragma unroll
    for (int m = 0; m < 8; ++m)
#pragma unroll
      for (int n = 0; n < 4; ++n)
        *(float4*)(slab + ((m >> 2) * 128 + wr * 64 + (m & 3) * 16 + lr + zE) * 256 + (n >> 1) * 128 + wc * 32 + (n & 1) * 16 + lq * 4 + zE) = make_float4(acc[m][n][0], acc[m][n][1], acc[m][n][2], acc[m][n][3]);
    asm volatile("s_waitcnt vmcnt(0)" ::: "memory");
    __syncthreads();
    if (tid == 0) {
      __builtin_amdgcn_fence(__ATOMIC_RELEASE, "agent");
      asm volatile("s_waitcnt vmcnt(0)" ::: "memory");
      (void)xb_add(&tick[nt], 1u);
    }
  }
  TileSched ts; ts.init(64, 4);
  for (int ti = ts.local; ti < ts.ntiles; ti += ts.nloc) {
    int mt, nt; ts.get(ti, mt, nt);
    f32x4 acc[8][4];
    gemm_tile256(acc, A, [&](int i) { return (mt * 256 + i) * lda; }, W + (size_t)nt * 256 * K, K, K, lds, zp);
    TREFRESH(); int zE = 0; asm volatile("" : "+v"(zE));
#pragma unroll
    for (int m = 0; m < 8; ++m) {
      const int row = mt * 256 + (m >> 2) * 128 + wr * 64 + (m & 3) * 16 + lr + zE;
      float ss0 = 0.f, ss1 = 0.f;
#pragma unroll
      for (int n = 0; n < 4; ++n) {
        const int col = nt * 256 + (n >> 1) * 128 + wc * 32 + (n & 1) * 16 + lq * 4 + zE;
        const uint2 u = *(const uint2*)(xb + (size_t)row * 1024 + col);
        uint2 o; o.x = pack2(lo2f(u.x) + acc[m][n][0], hi2f(u.x) + acc[m][n][1]); o.y = pack2(lo2f(u.y) + acc[m][n][2], hi2f(u.y) + acc[m][n][3]);
        *(uint2*)(xb + (size_t)row * 1024 + col) = o;
        const float y0 = lo2f(o.x), y1 = hi2f(o.x), y2 = lo2f(o.y), y3 = hi2f(o.y);
        const float q = y0 * y0 + y1 * y1 + y2 * y2 + y3 * y3;
        if (n < 2) ss0 += q; else ss1 += q;
      }
      float ssw = ss0 + ss1;
      ssw += __shfl_xor(ssw, 16); ssw += __shfl_xor(ssw, 32);
      if (lq == 0) ((float*)lds)[((m >> 2) * 128 + wr * 64 + (m & 3) * 16 + lr) * 4 + wc] = ssw;
      asm volatile("" ::: "memory");
    }
    __syncthreads();
    if (tid < 256) { const float4 q4 = *(const float4*)((const float*)lds + tid * 4); ssq[(size_t)nt * NR + mt * 256 + tid] = (q4.x + q4.y) + (q4.z + q4.w); }
    __syncthreads();
  }
  if (isunit) {
    const int nt = unt;
    if (tid == 0) {
      XB_SPIN(xb_ld(&tick[nt]) < (unsigned)ks, (unsigned*)(p.ws + WS_BAR));
      __builtin_amdgcn_fence(__ATOMIC_ACQUIRE, "agent");
      asm volatile("s_waitcnt vmcnt(0)" ::: "memory");
    }
    __syncthreads();
    const int rpb = (256 + ks - 1) / ks, r0 = uksi * rpb, r1 = r0 + rpb < 256 ? r0 + rpb : 256;
    const float* sl = (const float*)(p.ws + WS_SLAB) + (size_t)(nt * ks) * 65536;
    for (int rr = r0 + (tid >> 6); rr < r1; rr += 8) {
      const int c4 = tid & 63, row = 16384 + rr, col = nt * 256 + c4 * 4;
      const float* s4 = sl + rr * 256 + c4 * 4;
      float4 sum = make_float4(0.f, 0.f, 0.f, 0.f);
      for (int q = 0; q < ks; ++q) { const float4 v = *(const float4*)(s4 + (size_t)q * 65536); sum.x += v.x; sum.y += v.y; sum.z += v.z; sum.w += v.w; }
      const uint2 u2 = *(const uint2*)(xb + (size_t)row * 1024 + col);
      uint2 o;
      o.x = pack2(lo2f(u2.x) + sum.x, hi2f(u2.x) + sum.y);
      o.y = pack2(lo2f(u2.y) + sum.z, hi2f(u2.y) + sum.w);
      *(uint2*)(xb + (size_t)row * 1024 + col) = o;
      const float y0 = lo2f(o.x), y1 = hi2f(o.x), y2 = lo2f(o.y), y3 = hi2f(o.y);
      float ss = wave_sum(y0 * y0 + y1 * y1 + y2 * y2 + y3 * y3);
      if (c4 == 0) ssq[(size_t)nt * NR + row] = ss;
    }
  }
}

__device__ __forceinline__ void phase_ffn_up(const Params& p, char* lds, int layer, int site) {
  int tid, lane, w, wr, wc, lr, lq; TREFRESH();
  const bf16_t* zp = (const bf16_t*)(p.ws + WS_ZERO);
  const bf16_t* xb = (const bf16_t*)(p.ws + WS_XB);
  const bf16_t* W = (const bf16_t*)p.out + W_UP + (size_t)layer * 5632 * 1024;
  const float* ssq = (const float*)(p.ws + WS_SSQ2) + (size_t)site * 4 * NR;
  bf16_t* act = (bf16_t*)(p.ws + WS_SCR + SCR_ACT);
  const float* cw = p.in[37] + (size_t)layer * 3 * 2816;
  const float* cb = p.in[38] + (size_t)layer * 2816;
  const float* cache = p.in[7] + (size_t)layer * 128 * 2 * 2816;
  float* srs = (float*)(lds + LDS_SRS);
  TileSched ts; ts.init_even(67, 22);
  for (int ti = ts.local; ti < ts.ntiles; ti += ts.nloc) {
    int mt, nt; ts.get_even(ti, mt, nt);
    const bool smp = mt == 66;
    const int gbase = 254 * mt - 2;
    auto growf = [&](int i) -> int { if (smp) return i < 128 ? NPR + i : -1; const int g = gbase + i; return (g >= 0 && g < NPR) ? g : -1; };
    if (tid < 256) { const int gr = growf(tid); srs[tid] = gr >= 0 ? row_rstd(ssq, gr) : 0.f; }
    f32x4 acc[8][4];
    gemm_tile256(acc, xb, [&](int i) -> int { int gr = smp ? NPR + (i < 128 ? i : 127) : gbase + i; gr = gr < 0 ? 0 : (gr > NR - 1 ? NR - 1 : gr); return gr * 1024; }, W + (size_t)nt * 256 * 1024, 1024, 1024, lds, zp);
    TREFRESH(); int zE = 0; asm volatile("" : "+v"(zE));
    {
      int z0 = 0; asm volatile("" : "+v"(z0));
      bf16_t* gl = (bf16_t*)lds + z0; bf16_t* vl = gl + 256 * 136;
#pragma unroll
      for (int m = 0; m < 8; ++m) {
        const int r = (m >> 2) * 128 + wr * 64 + (m & 3) * 16 + lr + zE;
        const float rs = srs[r];
#pragma unroll
        for (int n = 0; n < 2; ++n) {
          const int ch = wc * 32 + n * 16 + lq * 4;
          uint2 og, ov;
          og.x = pack2(acc[m][n][0] * rs, acc[m][n][1] * rs); og.y = pack2(acc[m][n][2] * rs, acc[m][n][3] * rs);
          ov.x = pack2(acc[m][n + 2][0] * rs, acc[m][n + 2][1] * rs); ov.y = pack2(acc[m][n + 2][2] * rs, acc[m][n + 2][3] * rs);
          *(uint2*)(gl + r * 136 + ch) = og;
          *(uint2*)(vl + r * 136 + ch) = ov;
        }
        asm volatile("" ::: "memory");
      }
      __syncthreads();
      float wv[4][8];
      {
        const int gch0 = nt * 128 + (tid & 15) * 8;
#pragma unroll
        for (int q = 0; q < 4; ++q) {
          const float* sp = (q < 3 ? cw + q * 2816 : cb) + gch0;
          const float4 x0 = *(const float4*)sp, x1 = *(const float4*)(sp + 4);
          wv[q][0] = x0.x; wv[q][1] = x0.y; wv[q][2] = x0.z; wv[q][3] = x0.w; wv[q][4] = x1.x; wv[q][5] = x1.y; wv[q][6] = x1.z; wv[q][7] = x1.w;
        }
      }
#pragma unroll 1
      for (int it = 0; it < 8; ++it) {
        const int idx = tid + 512 * it, r = idx >> 4, c8 = (idx & 15) * 8, gch = nt * 128 + c8;
        const int g = gbase + r;
        const bool valid = smp ? (r < 128) : (r >= 2 && g < NPR);
        if (valid) {
          const int grow = smp ? NPR + r : g;
          const int b = smp ? 0 : g / TP, t = smp ? 2 : g - b * TP;
          float g0[8], g1[8], g2[8], vv[8];
          {
            const uint4 u = *(const uint4*)(gl + r * 136 + c8);
            g2[0] = lo2f(u.x); g2[1] = hi2f(u.x); g2[2] = lo2f(u.y); g2[3] = hi2f(u.y); g2[4] = lo2f(u.z); g2[5] = hi2f(u.z); g2[6] = lo2f(u.w); g2[7] = hi2f(u.w);
            const uint4 v4 = *(const uint4*)(vl + r * 136 + c8);
            vv[0] = lo2f(v4.x); vv[1] = hi2f(v4.x); vv[2] = lo2f(v4.y); vv[3] = hi2f(v4.y); vv[4] = lo2f(v4.z); vv[5] = hi2f(v4.z); vv[6] = lo2f(v4.w); vv[7] = hi2f(v4.w);
          }
          if (smp) {
            const float4 a0 = *(const float4*)(cache + (size_t)(r * 2 + 0) * 2816 + gch), a1 = *(const float4*)(cache + (size_t)(r * 2 + 0) * 2816 + gch + 4);
            const float4 b0 = *(const float4*)(cache + (size_t)(r * 2 + 1) * 2816 + gch), b1 = *(const float4*)(cache + (size_t)(r * 2 + 1) * 2816 + gch + 4);
            g0[0] = a0.x; g0[1] = a0.y; g0[2] = a0.z; g0[3] = a0.w; g0[4] = a1.x; g0[5] = a1.y; g0[6] = a1.z; g0[7] = a1.w;
            g1[0] = b0.x; g1[1] = b0.y; g1[2] = b0.z; g1[3] = b0.w; g1[4] = b1.x; g1[5] = b1.y; g1[6] = b1.z; g1[7] = b1.w;
          } else {
            uint4 u0 = make_uint4(0, 0, 0, 0), u1 = make_uint4(0, 0, 0, 0);
            if (t >= 2) u0 = *(const uint4*)(gl + (r - 2) * 136 + c8);
            if (t >= 1) u1 = *(const uint4*)(gl + (r - 1) * 136 + c8);
            g0[0] = lo2f(u0.x); g0[1] = hi2f(u0.x); g0[2] = lo2f(u0.y); g0[3] = hi2f(u0.y); g0[4] = lo2f(u0.z); g0[5] = hi2f(u0.z); g0[6] = lo2f(u0.w); g0[7] = hi2f(u0.w);
            g1[0] = lo2f(u1.x); g1[1] = hi2f(u1.x); g1[2] = lo2f(u1.y); g1[3] = hi2f(u1.y); g1[4] = lo2f(u1.z); g1[5] = hi2f(u1.z); g1[6] = lo2f(u1.w); g1[7] = hi2f(u1.w);
          }
          float ov[8];
#pragma unroll
          for (int e = 0; e < 8; ++e) ov[e] = gelu_t(wv[3][e] + wv[0][e] * g0[e] + wv[1][e] * g1[e] + wv[2][e] * g2[e]) * vv[e];
          *(uint4*)(act + (size_t)grow * 2816 + gch) = make_uint4(pack2(ov[0], ov[1]), pack2(ov[2], ov[3]), pack2(ov[4], ov[5]), pack2(ov[6], ov[7]));
          if (smp) {
            float* oc = p.out + O_FCS + (size_t)((layer * 128 + r) * 2) * 2816 + gch;
            *(float4*)oc = make_float4(g1[0], g1[1], g1[2], g1[3]); *(float4*)(oc + 4) = make_float4(g1[4], g1[5], g1[6], g1[7]);
            *(float4*)(oc + 2816) = make_float4(g2[0], g2[1], g2[2], g2[3]); *(float4*)(oc + 2820) = make_float4(g2[4], g2[5], g2[6], g2[7]);
          } else if (t >= TP - 2) {
            float* oc = p.out + O_FCP + (size_t)((layer * 8 + b) * 2 + (t - (TP - 2))) * 2816 + gch;
            *(float4*)oc = make_float4(g2[0], g2[1], g2[2], g2[3]); *(float4*)(oc + 4) = make_float4(g2[4], g2[5], g2[6], g2[7]);
          }
        }
      }
    }
    __syncthreads();
  }
}

__device__ __forceinline__ void phase_g5(const Params& p, char* lds) {
  int tid, lane, w, wr, wc, lr, lq; TREFRESH();
  const bf16_t* zp = (const bf16_t*)(p.ws + WS_ZERO);
  const bf16_t* xb = (const bf16_t*)(p.ws + WS_XB);
  const bf16_t* W = (const bf16_t*)p.out + W_IN1;
  const float* ssq = (const float*)(p.ws + WS_SSQ2) + (size_t)2 * 4 * NR;
  bf16_t* xr = (bf16_t*)(p.ws + WS_SCR + SCR_XR);
  bf16_t* gg = (bf16_t*)(p.ws + WS_SCR + SCR_GG);
  float* srs = (float*)(lds + LDS_SRS);
  if (blockIdx.x < 48) {
    const int u = blockIdx.x, nt = u >> 2, ksi = u & 3, k0 = ksi * 256;
    f32x4 acc[8][4];
    gemm_tile256(acc, xb + k0, [&](int i) { return (16384 + i) * 1024; }, W + (size_t)nt * 256 * 1024 + k0, 1024, 256, lds, zp);
    TREFRESH(); int zE = 0; asm volatile("" : "+v"(zE));
    float* slab = (float*)(p.ws + WS_SLAB) + (size_t)(nt * 4 + ksi) * 65536;
#pragma unroll
    for (int m = 0; m < 8; ++m)
#pragma unroll
      for (int n = 0; n < 4; ++n)
        *(float4*)(slab + ((m >> 2) * 128 + wr * 64 + (m & 3) * 16 + lr + zE) * 256 + (n >> 1) * 128 + wc * 32 + (n & 1) * 16 + lq * 4 + zE) = make_float4(acc[m][n][0], acc[m][n][1], acc[m][n][2], acc[m][n][3]);
    asm volatile("s_waitcnt vmcnt(0)" ::: "memory");
    __syncthreads();
    if (tid == 0) {
      __builtin_amdgcn_fence(__ATOMIC_RELEASE, "agent");
      asm volatile("s_waitcnt vmcnt(0)" ::: "memory");
      (void)xb_add((unsigned*)(p.ws + WS_FLAG) + 4416 + nt, 1u);
    }
  }
  TileSched ts; ts.init(64, 12);
  for (int ti = ts.local; ti < ts.ntiles; ti += ts.nloc) {
    int mt, nt; ts.get(ti, mt, nt);
    if (tid < 256) srs[tid] = row_rstd(ssq, mt * 256 + tid);
    f32x4 acc[8][4];
    gemm_tile256(acc, xb, [&](int i) { return (mt * 256 + i) * 1024; }, W + (size_t)nt * 256 * 1024, 1024, 1024, lds, zp);
    TREFRESH(); int zE = 0; asm volatile("" : "+v"(zE));
#pragma unroll
    for (int m = 0; m < 8; ++m) {
      const int r = (m >> 2) * 128 + wr * 64 + (m & 3) * 16 + lr + zE, row = mt * 256 + r;
      const float rs = srs[r];
#pragma unroll
      for (int n = 0; n < 4; ++n) {
        const int col = nt * 256 + (n >> 1) * 128 + wc * 32 + (n & 1) * 16 + lq * 4 + zE;
        const f32x4 v = acc[m][n] * rs;
        uint2 o;
        if (nt < 6) {
          o.x = pack2(gelu_t(v[0]), gelu_t(v[1])); o.y = pack2(gelu_t(v[2]), gelu_t(v[3]));
          *(uint2*)(gg + (size_t)row * 1536 + col) = o;
        } else {
          o.x = pack2(v[0], v[1]); o.y = pack2(v[2], v[3]);
          *(uint2*)(xr + (size_t)row * 1536 + (col - 1536)) = o;
        }
      }
    }
    __syncthreads();
  }
  if (blockIdx.x < 48) {
    const int u = blockIdx.x, nt = u >> 2, ksi = u & 3;
    if (tid == 0) {
      XB_SPIN(xb_ld((unsigned*)(p.ws + WS_FLAG) + 4416 + nt) < 4u, (unsigned*)(p.ws + WS_BAR));
      __builtin_amdgcn_fence(__ATOMIC_ACQUIRE, "agent");
      asm volatile("s_waitcnt vmcnt(0)" ::: "memory");
    }
    __syncthreads();
    const float* sl = (const float*)(p.ws + WS_SLAB) + (size_t)(nt * 4) * 65536;
    for (int rr = ksi * 64 + (tid >> 6); rr < ksi * 64 + 64; rr += 8) {
      const int c4 = tid & 63, row = 16384 + rr, col = nt * 256 + c4 * 4;
      const float* s4 = sl + rr * 256 + c4 * 4;
      const float4 s0 = *(const float4*)s4, s1 = *(const float4*)(s4 + 65536), s2 = *(const float4*)(s4 + 131072), s3 = *(const float4*)(s4 + 196608);
      const float rs = row_rstd(ssq, row);
      const float v0 = ((s0.x + s1.x) + (s2.x + s3.x)) * rs, v1 = ((s0.y + s1.y) + (s2.y + s3.y)) * rs;
      const float v2 = ((s0.z + s1.z) + (s2.z + s3.z)) * rs, v3 = ((s0.w + s1.w) + (s2.w + s3.w)) * rs;
      uint2 o;
      if (nt < 6) {
        o.x = pack2(gelu_t(v0), gelu_t(v1)); o.y = pack2(gelu_t(v2), gelu_t(v3));
        *(uint2*)(gg + (size_t)row * 1536 + col) = o;
      } else {
        o.x = pack2(v0, v1); o.y = pack2(v2, v3);
        *(uint2*)(xr + (size_t)row * 1536 + (col - 1536)) = o;
      }
    }
  }
}

__device__ __forceinline__ void rglru_item(const Params& p, int item, char* lds) {
  const int tid = threadIdx.x & 255, lane = tid & 63, w = tid >> 6, lr = lane & 15, lq = lane >> 4;
  const bool smp = item >= 4352;
  const int pass = 1;
  int b, tl, n, half;
  if (smp) { const int it = item - 4352; b = 0; tl = 0; n = it >> 1; half = it & 1; }
  else { tl = item >> 8; const int chain = item & 255; b = chain >> 5; n = (chain >> 1) & 15; half = chain & 1; }
  unsigned* flags = (unsigned*)(p.ws + WS_FLAG);
  unsigned* barw = (unsigned*)(p.ws + WS_BAR);
  const bf16_t* xr = (const bf16_t*)(p.ws + WS_SCR + SCR_XR);
  bf16_t* gg = (bf16_t*)(p.ws + WS_SCR + SCR_GG);
  const bf16_t* Wg = (const bf16_t*)p.out + W_GATE;
  const bf16_t* zp = (const bf16_t*)(p.ws + WS_ZERO);
  float* carr = (float*)(p.ws + WS_XLOC);
  char* At = lds; char* Ba = lds + 26624; char* Bx = lds + 36608;
  char* xs = lds + 46592;
  float* sa = (float*)lds; float* sbx = (float*)(lds + 24576);
  float* segA = (float*)(lds + 49152); float* segH = (float*)(lds + 49920); float* carry = (float*)(lds + 50688);
  char* ggl = lds + 51200;
  float* par = (float*)(lds + 71744);
  const int t0 = tl * 128;
  const int nvalid = smp ? 128 : (TP - t0 < 128 ? TP - t0 : 128);
  if (tid < 156) {
    const float* src;
    const int q = tid;
    if (q < 96) { const int wt = q / 24; src = p.in[27] + wt * 1536 + n * 96 + (q - wt * 24) * 4; }
    else if (q < 120) src = p.in[28] + n * 96 + (q - 96) * 4;
    else if (q < 132) src = p.in[30] + n * 96 + half * 48 + (q - 120) * 4;
    else if (q < 144) src = p.in[32] + n * 96 + half * 48 + (q - 132) * 4;
    else src = (const float*)(p.ws + WS_NSP) + n * 96 + half * 48 + (q - 144) * 4;
    __builtin_amdgcn_global_load_lds((const unsigned*)src, (unsigned*)((char*)par + q * 16), 16, 0, 0);
  }
  for (int q = tid; q < 1248; q += 256) {
    const int mat = q >= 624 ? 1 : 0, q2 = q - mat * 624, d = q2 / 13, ch = q2 - d * 13;
    const bf16_t* src = Wg + (size_t)((mat * 16 + n) * 96 + half * 48 + d) * 96 + (ch < 12 ? ch : 0) * 8;
    __builtin_amdgcn_global_load_lds((const unsigned*)src, (unsigned*)(Ba + q * 16), 16, 0, 0);
  }
  if (!smp) {
    for (int q = tid; q < 1572; q += 256) {
      const int r = q / 12, ch = q - r * 12, t = t0 + r - 3;
      const bf16_t* src = (t >= 0 && t < TP) ? xr + (size_t)(b * TP + t) * 1536 + n * 96 + ch * 8 : zp;
      __builtin_amdgcn_global_load_lds((const unsigned*)src, (unsigned*)(xs + q * 16), 16, 0, 0);
    }
  }
  asm volatile("s_waitcnt vmcnt(0)" ::: "memory");
  __syncthreads();
#pragma unroll 2
  for (int i = 0; i < 6; ++i) {
    const int idx = tid + 256 * i, r = idx / 12, ch8 = idx - r * 12, c0 = n * 96 + ch8 * 8;
    float xc[8];
    if (r < nvalid) {
      const float4 b0 = *(const float4*)(par + 384 + ch8 * 8), b1 = *(const float4*)(par + 384 + ch8 * 8 + 4);
      xc[0] = b0.x; xc[1] = b0.y; xc[2] = b0.z; xc[3] = b0.w; xc[4] = b1.x; xc[5] = b1.y; xc[6] = b1.z; xc[7] = b1.w;
#pragma unroll
      for (int wt = 0; wt < 4; ++wt) {
        float xv[8];
        if (smp && wt < 3) {
          const float4 a0 = *(const float4*)(p.in[6] + (size_t)(r * 3 + wt) * 1536 + c0), a1 = *(const float4*)(p.in[6] + (size_t)(r * 3 + wt) * 1536 + c0 + 4);
          xv[0] = a0.x; xv[1] = a0.y; xv[2] = a0.z; xv[3] = a0.w; xv[4] = a1.x; xv[5] = a1.y; xv[6] = a1.z; xv[7] = a1.w;
        } else {
          uint4 u;
          if (smp) u = *(const uint4*)(xr + (size_t)(NPR + r) * 1536 + c0);
          else u = *(const uint4*)(xs + (r + wt) * 192 + ch8 * 16);
          xv[0] = lo2f(u.x); xv[1] = hi2f(u.x); xv[2] = lo2f(u.y); xv[3] = hi2f(u.y); xv[4] = lo2f(u.z); xv[5] = hi2f(u.z); xv[6] = lo2f(u.w); xv[7] = hi2f(u.w);
        }
        const float4 w0 = *(const float4*)(par + wt * 96 + ch8 * 8), w1 = *(const float4*)(par + wt * 96 + ch8 * 8 + 4);
        xc[0] += w0.x * xv[0]; xc[1] += w0.y * xv[1]; xc[2] += w0.z * xv[2]; xc[3] += w0.w * xv[3];
        xc[4] += w1.x * xv[4]; xc[5] += w1.y * xv[5]; xc[6] += w1.z * xv[6]; xc[7] += w1.w * xv[7];
      }
    } else {
#pragma unroll
      for (int e = 0; e < 8; ++e) xc[e] = 0.f;
    }
    *(uint4*)(At + r * 208 + ch8 * 16) = make_uint4(pack2(xc[0], xc[1]), pack2(xc[2], xc[3]), pack2(xc[4], xc[5]), pack2(xc[6], xc[7]));
  }
  __syncthreads();
  if (pass == 1 && !smp) {
    for (int q = tid; q < 768; q += 256) {
      const int r = q / 6, c = q - r * 6;
      const bf16_t* src = r < nvalid ? gg + (size_t)(b * TP + t0 + r) * 1536 + n * 96 + half * 48 + c * 8 : zp;
      __builtin_amdgcn_global_load_lds((const unsigned*)src, (unsigned*)(ggl + q * 16), 16, 0, 0);
    }
  }
  f32x4 aa[2][3], ax[2][3];
#pragma unroll
  for (int m = 0; m < 2; ++m)
#pragma unroll
    for (int q = 0; q < 3; ++q) { aa[m][q] = (f32x4){0.f, 0.f, 0.f, 0.f}; ax[m][q] = (f32x4){0.f, 0.f, 0.f, 0.f}; }
#pragma unroll
  for (int s2 = 0; s2 < 3; ++s2) {
    bf16x8 a[2];
#pragma unroll
    for (int m = 0; m < 2; ++m) a[m] = *(const bf16x8*)(At + (32 * w + 16 * m + lr) * 208 + (s2 * 4 + lq) * 16);
#pragma unroll
    for (int q = 0; q < 3; ++q) {
      const bf16x8 ba = *(const bf16x8*)(Ba + (16 * q + lr) * 208 + (s2 * 4 + lq) * 16);
      const bf16x8 bx = *(const bf16x8*)(Bx + (16 * q + lr) * 208 + (s2 * 4 + lq) * 16);
#pragma unroll
      for (int m = 0; m < 2; ++m) { aa[m][q] = mfma16(ba, a[m], aa[m][q]); ax[m][q] = mfma16(bx, a[m], ax[m][q]); }
    }
  }
  uint2 xcv[2][3];
#pragma unroll
  for (int m = 0; m < 2; ++m)
#pragma unroll
    for (int q = 0; q < 3; ++q) xcv[m][q] = *(const uint2*)(At + (32 * w + 16 * m + lr) * 208 + (half * 48 + 16 * q + lq * 4) * 2);
  float4 pba[3], pbx[3], plm[3];
#pragma unroll
  for (int q = 0; q < 3; ++q) {
    pba[q] = *(const float4*)(par + 480 + 16 * q + lq * 4);
    pbx[q] = *(const float4*)(par + 528 + 16 * q + lq * 4);
    plm[q] = *(const float4*)(par + 576 + 16 * q + lq * 4);
  }
  __syncthreads();
#pragma unroll
  for (int m = 0; m < 2; ++m) {
    const int row = 32 * w + 16 * m + lr;
#pragma unroll
    for (int q = 0; q < 3; ++q) {
      const int d0 = 16 * q + lq * 4;
      const float bav[4] = {pba[q].x, pba[q].y, pba[q].z, pba[q].w}, bxv[4] = {pbx[q].x, pbx[q].y, pbx[q].z, pbx[q].w}, lmv[4] = {plm[q].x, plm[q].y, plm[q].z, plm[q].w};
      const float xcf[4] = {lo2f(xcv[m][q].x), hi2f(xcv[m][q].x), lo2f(xcv[m][q].y), hi2f(xcv[m][q].y)};
      float av[4], bv[4];
#pragma unroll
      for (int e = 0; e < 4; ++e) {
        const float r_ = sigm(aa[m][q][e] + bav[e]);
        const float i_ = sigm(ax[m][q][e] + bxv[e]);
        const float la = r_ * lmv[e];
        float a = __expf(la);
        float bxx = __builtin_sqrtf(fmaxf(1.f - a * a, 0.f)) * (i_ * xcf[e]);
        if (row >= nvalid) { a = 1.f; bxx = 0.f; }
        av[e] = a; bv[e] = bxx;
      }
      *(float4*)(sa + row * 48 + d0) = make_float4(av[0], av[1], av[2], av[3]);
      *(float4*)(sbx + row * 48 + d0) = make_float4(bv[0], bv[1], bv[2], bv[3]);
    }
  }
  __syncthreads();
  if (smp) {
    for (int idx = tid; idx < 128 * 48; idx += 256) {
      const int row = idx / 48, ch = idx - row * 48, cgl = n * 96 + half * 48 + ch;
      const float hh = sa[idx] * p.in[5][row * 1536 + cgl] + sbx[idx];
      p.out[O_HS + row * 1536 + cgl] = hh;
      const size_t go = (size_t)(NPR + row) * 1536 + cgl;
      gg[go] = f2bf(hh * bf2f(gg[go]));
    }
  } else {
    const int ch = tid % 48, seg = tid / 48;
    if (tid < 192) {
      float A = 1.f, H = 0.f;
#pragma unroll 8
      for (int r = seg * 32; r < seg * 32 + 32; ++r) { const float a = sa[r * 48 + ch]; H = a * H + sbx[r * 48 + ch]; A *= a; }
      segA[seg * 48 + ch] = A; segH[seg * 48 + ch] = H;
    }
    asm volatile("s_waitcnt vmcnt(0)" ::: "memory");
    __syncthreads();
    {
      float At_ = 1.f, Ht_ = 0.f;
      if (tid < 48) {
#pragma unroll
        for (int s2 = 0; s2 < 4; ++s2) { Ht_ = segA[s2 * 48 + tid] * Ht_ + segH[s2 * 48 + tid]; At_ *= segA[s2 * 48 + tid]; }
      }
      if (tl > 0 && tid == 0) XB_SPIN(xb_ld(&flags[item - 256]) == 0u, barw);
      __syncthreads();
      if (tid < 48) {
        const int cgl = n * 96 + half * 48 + tid;
        float h0 = 0.f;
        if (tl > 0) h0 = __hip_atomic_load(&carr[(size_t)((b * 17 + tl - 1) * 32 + n * 2 + half) * 64 + tid], __ATOMIC_RELAXED, __HIP_MEMORY_SCOPE_AGENT);
        carry[tid] = h0;
        const float hend = At_ * h0 + Ht_;
        if (tl < 16) __hip_atomic_store(&carr[(size_t)((b * 17 + tl) * 32 + n * 2 + half) * 64 + tid], hend, __ATOMIC_RELAXED, __HIP_MEMORY_SCOPE_AGENT);
        else p.out[O_HP + b * 1536 + cgl] = hend;
      }
      asm volatile("s_waitcnt vmcnt(0)" ::: "memory");
      __syncthreads();
      if (tid == 0 && tl < 16) (void)xb_add(&flags[item], 1u);
    }
    if (tid < 192) {
      float hin = carry[ch];
      for (int s2 = 0; s2 < seg; ++s2) hin = segA[s2 * 48 + ch] * hin + segH[s2 * 48 + ch];
      const int cgl = n * 96 + half * 48 + ch;
#pragma unroll 8
      for (int r = seg * 32; r < seg * 32 + 32; ++r) {
        hin = sa[r * 48 + ch] * hin + sbx[r * 48 + ch];
        if (r < nvalid) gg[(size_t)(b * TP + t0 + r) * 1536 + cgl] = f2bf(hin * bf2f(*(const bf16_t*)(ggl + r * 96 + ch * 2)));
      }
    }
  }
  if (pass == 1) {
    if (!smp) {
      if (tl == 16 && half == 0 && tid < 96) {
#pragma unroll
        for (int wv = 0; wv < 3; ++wv) p.out[O_RCP + (b * 3 + wv) * 1536 + n * 96 + tid] = bf2f(xr[(size_t)(b * TP + TP - 3 + wv) * 1536 + n * 96 + tid]);
      }
    } else if (half == 0) {
      for (int idx = tid; idx < 128 * 96; idx += 256) {
        const int s2 = idx / 96, cc_ = idx - s2 * 96, cgl = n * 96 + cc_;
        p.out[O_RCS + (size_t)(s2 * 3 + 0) * 1536 + cgl] = p.in[6][(size_t)(s2 * 3 + 1) * 1536 + cgl];
        p.out[O_RCS + (size_t)(s2 * 3 + 1) * 1536 + cgl] = p.in[6][(size_t)(s2 * 3 + 2) * 1536 + cgl];
        p.out[O_RCS + (size_t)(s2 * 3 + 2) * 1536 + cgl] = bf2f(xr[(size_t)(NPR + s2) * 1536 + cgl]);
      }
    }
  }
  __syncthreads();
}

__device__ __forceinline__ void phase_final(const Params& p) {
  const int tid = threadIdx.x, lane = tid & 63;
  const bf16_t* xres = (const bf16_t*)(p.ws + WS_XB);
  const float* ssq = (const float*)(p.ws + WS_SSQ2);
  const int gw = blockIdx.x * 8 + (tid >> 6), nw = gridDim.x * 8;
  for (int r = gw; r < NR; r += nw) {
    float* dst;
    if (r >= NPR) dst = p.out + O_YS + (size_t)(r - NPR) * 1024;
    else { const int b = r / TP, t = r - b * TP; if (t < 16) continue; dst = p.out + O_YP + ((size_t)b * 2048 + (t - 16)) * 1024; }
    float s = lane < 4 ? ssq[(size_t)lane * NR + r] : 0.f;
    s = wave_sum(s);
    const float rstd = rsqrtf(s * (1.f / 1024.f) + EPSN);
    const uint2* src = (const uint2*)(xres + (size_t)r * 1024);
    const float4* nf = (const float4*)p.in[40];
#pragma unroll
    for (int j = 0; j < 4; ++j) {
      const uint2 u = src[lane + 64 * j];
      const float4 v = make_float4(lo2f(u.x), hi2f(u.x), lo2f(u.y), hi2f(u.y)), g = nf[lane + 64 * j];
      ((float4*)dst)[lane + 64 * j] = make_float4(v.x * rstd * g.x, v.y * rstd * g.y, v.z * rstd * g.z, v.w * rstd * g.w);
    }
  }
}

__global__ void __launch_bounds__(512, 2) mega_kernel(Params p) {
  extern __shared__ __attribute__((aligned(16))) char lds[];
  cg::grid_group grid = cg::this_grid();
  const bf16_t* wb = (const bf16_t*)p.out;
  volatile LAS unsigned* xst_ = (volatile LAS unsigned*)(lds + LDS_ST);
  if (threadIdx.x < 4) xst_[threadIdx.x] = 0u;
  __syncthreads();
  XcdBarrier xbar = xcd_barrier_post((unsigned*)(p.ws + WS_BAR), xst_);
  if (p.ph_hi > 1000) grid.sync();
#define PH(k, body) if (p.ph_lo <= (k) && (k) < p.ph_hi) { body; } if (p.ph_lo <= (k) && (k) + 1 < p.ph_hi) xcd_barrier(xbar);
  PH(0, phase_prep(p, lds))
  PH(1, phase_g1(p, lds))
  PH(2, phase_mix_a(p, lds))
  PH(3, phase_mix_b(p))
  PH(4, phase_mix_c(p, lds))
  PH(5, phase_glu(p, lds))
  PH(6, phase_resid(p, lds, (const bf16_t*)(p.ws + WS_SCR + SCR_ZB) + 512, 2048, wb + W_OUT0, 1024, 0, 1))
  PH(7, phase_ffn_up(p, lds, 0, 1))
  PH(8, phase_resid(p, lds, (const bf16_t*)(p.ws + WS_SCR + SCR_ACT), 2816, wb + W_DOWN, 2816, 16, 2))
  PH(9, phase_g5(p, lds))
  PH(10, for (int pr = blockIdx.x; pr < 2192; pr += gridDim.x) rglru_item(p, pr * 2 + (threadIdx.x >> 8), lds + (threadIdx.x >> 8) * HALF_LDS))
  PH(11, phase_resid(p, lds, (const bf16_t*)(p.ws + WS_SCR + SCR_GG), 1536, wb + W_OUT1, 1536, 32, 3))
  PH(12, phase_ffn_up(p, lds, 1, 3))
  PH(13, phase_resid(p, lds, (const bf16_t*)(p.ws + WS_SCR + SCR_ACT), 2816, wb + W_DOWN + (size_t)1024 * 2816, 2816, 48, 0))
  PH(14, phase_final(p))
}

extern "C" void kernel_launch(void* const* d_in, const int* in_sizes, int n_in, void* d_out, int out_size, void* d_ws, size_t ws_size, hipStream_t stream) {
  static int grid_blocks = 0;
  if (!grid_blocks) {
    int dev = 0, cus = 0, per_cu = 0;
    hipGetDevice(&dev);
    hipDeviceGetAttribute(&cus, hipDeviceAttributeMultiprocessorCount, dev);
    hipFuncSetAttribute((const void*)mega_kernel, hipFuncAttributeMaxDynamicSharedMemorySize, LDS_BYTES);
    hipOccupancyMaxActiveBlocksPerMultiprocessor(&per_cu, (const void*)mega_kernel, NTHR, LDS_BYTES);
    if (per_cu > 1) per_cu = 1;
    if (per_cu < 1) per_cu = 1;
    grid_blocks = cus * per_cu;
    if (n_in != 41 || ws_size < WS_NEED) fprintf(stderr, "kernel_launch: unexpected n_in %d or ws_size %zu (need %llu)\n", n_in, ws_size, (unsigned long long)WS_NEED);
  }
  Params p{};
  for (int i = 0; i < 41; ++i) p.in[i] = (const float*)d_in[i];
  p.out = (float*)d_out;
  p.ws = (char*)d_ws;
  (void)hipMemsetAsync((char*)d_ws + WS_BAR, 0, 16384, stream);
  (void)hipMemsetAsync((char*)d_ws + WS_FLAG, 0, 20480, stream);
#if MK_MULTI
  for (int ph = 0; ph < NPHASE; ++ph) {
    p.ph_lo = ph; p.ph_hi = ph + 1;
    hipLaunchKernelGGL(mega_kernel, dim3(grid_blocks), dim3(NTHR), LDS_BYTES, stream, p);
  }
#else
  p.ph_lo = 0; p.ph_hi = NPHASE;
  void* args[] = {&p};
  hipError_t e = hipLaunchCooperativeKernel((const void*)mega_kernel, dim3(grid_blocks), dim3(NTHR), args, LDS_BYTES, stream);
  if (e != hipSuccess) fprintf(stderr, "cooperative launch failed: %s (grid %d)\n", hipGetErrorString(e), grid_blocks);
#endif
}
```

```cpp
#include <hip/hip_runtime.h>
#include <hip/hip_cooperative_groups.h>
#include <stdint.h>
#include <stdio.h>
namespace cg = cooperative_groups;

#ifndef MK_MULTI
#define MK_MULTI 0
#endif

#define LAS __attribute__((address_space(3)))
typedef unsigned short bf16_t;
typedef __attribute__((ext_vector_type(8))) short bf16x8;
typedef __attribute__((ext_vector_type(4))) float f32x4;

#define TP 2064
#define NPR 16512
#define NR 16640
#define EPSN 1e-6f
#define NPHASE 15
#define LDS_BYTES 153600
#define HALF_LDS 75776
#define LDS_SRS 151552
#define LDS_ST 152576
#define LDS_TKL 152592
#define NTHR 512

#define O_YP 0
#define O_YS 16777216
#define O_GLAP 16908288
#define O_GLAS 17170432
#define O_S5RP 21364736
#define O_S5RS 21381120
#define O_S5IP 21643264
#define O_S5IS 21659648
#define O_HP 21921792
#define O_HS 21934080
#define O_RCP 22130688
#define O_RCS 22167552
#define O_FCP 22757376
#define O_FCS 22847488

#define W_IN0 0
#define W_GLU 2359296
#define W_OUT0 2621440
#define W_UP 3670016
#define W_DOWN 15204352
#define W_IN1 20971520
#define W_OUT1 24117248
#define W_GATE 25690112

#define WS_XB 0ull
#define WS_XRES 34078720ull
#define WS_SSQ 102236160ull
#define WS_S5AB 106496000ull
#define WS_S5BB 106545152ull
#define WS_S5CC 106807296ull
#define WS_XLOC 106938368ull
#define WS_XST 111263744ull
#define WS_DEC 115589120ull
#define WS_SCR 115859456ull
#define SCR_ZB 0ull
#define SCR_ALOG 68157440ull
#define SCR_SLOC 85196800ull
#define SCR_ACT 0ull
#define SCR_XR 0ull
#define SCR_GG 51118080ull
#define WS_BAR (WS_SCR + 119799808ull)
#define WS_ZERO (WS_BAR + 15360ull)
#define WS_NSP (WS_BAR + 16384ull)
#define WS_SLAB (WS_NSP + 8192ull)
#define WS_FLAG (WS_SLAB + 12582912ull)
#define WS_SSQ2 (WS_FLAG + 20480ull)
#define WS_NEED (WS_SSQ2 + 8519680ull)

struct Params {
  const float* in[41];
  float* out;
  char* ws;
  int ph_lo, ph_hi;
};

__device__ __forceinline__ bf16_t f2bf(float f) { uint32_t u = __float_as_uint(f); u += 0x7fffu + ((u >> 16) & 1u); return (bf16_t)(u >> 16); }
__device__ __forceinline__ float bf2f(bf16_t h) { return __uint_as_float(((uint32_t)h) << 16); }
__device__ __forceinline__ uint32_t pack2(float a, float b) { return (uint32_t)f2bf(a) | ((uint32_t)f2bf(b) << 16); }
__device__ __forceinline__ float lo2f(uint32_t u) { return __uint_as_float(u << 16); }
__device__ __forceinline__ float hi2f(uint32_t u) { return __uint_as_float(u & 0xffff0000u); }
__device__ __forceinline__ float sigm(float x) { return __builtin_amdgcn_rcpf(1.f + __expf(-x)); }
__device__ __forceinline__ float gelu_t(float x) { const float u = x * (1.5957691216f + 0.0713548162726f * x * x); return x * __builtin_amdgcn_rcpf(1.f + __expf(-u)); }
__device__ __forceinline__ float softplusf_(float x) { return fmaxf(x, 0.f) + __logf(1.f + __expf(-fabsf(x))); }
__device__ __forceinline__ float wave_sum(float v) {
#pragma unroll
  for (int o = 1; o < 64; o <<= 1) v += __shfl_xor(v, o);
  return v;
}
__device__ __forceinline__ int toff(int row, int chunk) { return row * 128 + ((chunk ^ (row & 7)) << 4); }
__device__ __forceinline__ f32x4 mfma16(bf16x8 a, bf16x8 b, f32x4 c) { return __builtin_amdgcn_mfma_f32_16x16x32_bf16(a, b, c, 0, 0, 0); }

__device__ __forceinline__ const float* xrow_src(const Params& p, int r) {
  if (r >= NPR) return p.in[1] + (size_t)(r - NPR) * 1024;
  int b = r / TP, t = r - b * TP;
  return t < 16 ? p.in[8] + t * 1024 : p.in[0] + ((size_t)b * 2048 + (t - 16)) * 1024;
}

#define TREFRESH() do { tid = threadIdx.x; asm volatile("" : "+v"(tid)); lane = tid & 63; w = tid >> 6; wr = w >> 2; wc = w & 3; lr = lane & 15; lq = lane >> 4; (void)w; (void)lane; } while (0)
__device__ __forceinline__ int lds_byte8(int r, int c) { const int st = (r >> 4) * 2 + (c >> 5), rr = r & 15, cc = c & 31, ob = rr * 64 + cc * 2; return st * 1024 + (ob ^ (((ob >> 9) & 1) << 5)); }
__device__ __forceinline__ void stage_rc8(int b, int& R, int& C) { const int st = b / 1024, sb = b % 1024, swz = sb ^ (((sb >> 9) & 1) << 5); R = (st >> 1) * 16 + swz / 64; C = (st & 1) * 32 + (swz % 64) / 2; }
template <class AF>
__device__ __forceinline__ void gemm_tile256(f32x4 (&acc)[8][4], const bf16_t* Ab, AF arow, const bf16_t* Bt, int ldb, int K, char* lds, const bf16_t* zpage) {
  const int wid = threadIdx.x >> 6, lane = threadIdx.x & 63, wr = wid >> 2, wc = wid & 3, fr = lane & 15, fq = lane >> 4;
#pragma unroll
  for (int m = 0; m < 8; ++m)
#pragma unroll
    for (int n = 0; n < 4; ++n) acc[m][n] = (f32x4){0.f, 0.f, 0.f, 0.f};
  int ao[2][2], bo[2][2];
#pragma unroll
  for (int i = 0; i < 2; ++i) {
    int r_, c_; stage_rc8(threadIdx.x * 16 + i * 8192, r_, c_);
#pragma unroll
    for (int h = 0; h < 2; ++h) {
      const int a = arow(h * 128 + r_);
      ao[h][i] = (a + c_) * 2;
      bo[h][i] = ((h * 128 + r_) * ldb + c_) * 2;
      asm volatile("" : "+v"(ao[h][i]), "+v"(bo[h][i]));
    }
  }
  char* lth = lds + threadIdx.x * 16;
  const __amdgpu_buffer_rsrc_t rA = __builtin_amdgcn_make_buffer_rsrc((void*)const_cast<bf16_t*>(Ab), (short)0, 0x7fffffff, 0x00020000);
  const __amdgpu_buffer_rsrc_t rB = __builtin_amdgcn_make_buffer_rsrc((void*)const_cast<bf16_t*>(Bt), (short)0, 0x7fffffff, 0x00020000);
#define SA8(b, h) (((b) * 2 + (h)) * 16384)
#define SB8(b, h) ((4 + (b) * 2 + (h)) * 16384)
#define STG_A(P, h, kt) do { _Pragma("unroll") for (int i_ = 0; i_ < 2; ++i_) \
    __builtin_amdgcn_raw_ptr_buffer_load_lds(rA, (LAS void*)(lth + (P) + i_ * 8192), 16, ao[h][i_], (kt) * 128, 0, 0); } while (0)
#define STG_B(P, h, kt) do { _Pragma("unroll") for (int i_ = 0; i_ < 2; ++i_) \
    __builtin_amdgcn_raw_ptr_buffer_load_lds(rB, (LAS void*)(lth + (P) + i_ * 8192), 16, bo[h][i_], (kt) * 128, 0, 0); } while (0)
#define LDA8(dst, b, h) do { _Pragma("unroll") for (int m = 0; m < 4; ++m) _Pragma("unroll") for (int k = 0; k < 2; ++k) \
    dst[m][k] = *(const bf16x8*)(lds + SA8(b, h) + lds_byte8(wr * 64 + m * 16 + fr, k * 32 + fq * 8)); } while (0)
#define LDB8(dst, b, h) do { _Pragma("unroll") for (int n = 0; n < 2; ++n) _Pragma("unroll") for (int k = 0; k < 2; ++k) \
    dst[n][k] = *(const bf16x8*)(lds + SB8(b, h) + lds_byte8(wc * 32 + n * 16 + fr, k * 32 + fq * 8)); } while (0)
#define MMA8(ai, bj, Ax, Bx) do { __builtin_amdgcn_s_setprio(1); \
    _Pragma("unroll") for (int m = 0; m < 4; ++m) _Pragma("unroll") for (int n = 0; n < 2; ++n) _Pragma("unroll") for (int k = 0; k < 2; ++k) \
      acc[(ai) * 4 + m][(bj) * 2 + n] = mfma16(Bx[n][k], Ax[m][k], acc[(ai) * 4 + m][(bj) * 2 + n]); \
    __builtin_amdgcn_s_setprio(0); } while (0)
#define WAIT_V(n) asm volatile("s_waitcnt vmcnt(" #n ")" ::: "memory")
#define WAIT_L(n) asm volatile("s_waitcnt lgkmcnt(" #n ")" ::: "memory")
#define BAR8 __builtin_amdgcn_s_barrier()
#define SCHED8 __builtin_amdgcn_sched_barrier(0)
  bf16x8 At[4][2], B0[2][2], B1[2][2];
  const int nt = K >> 6;
  STG_B(SB8(0, 0), 0, 0); STG_A(SA8(0, 0), 0, 0);
  STG_B(SB8(0, 1), 1, 0); STG_A(SA8(0, 1), 1, 0);
  if (wr == 1) BAR8;
  WAIT_V(4); BAR8;
  STG_B(SB8(1, 0), 0, 1); STG_A(SA8(1, 0), 0, 1); STG_B(SB8(1, 1), 1, 1);
  WAIT_V(6); BAR8;
  for (int t = 0; t < nt - 2; t += 2) {
    LDB8(B0, 0, 0); SCHED8; LDA8(At, 0, 0); STG_A(SA8(1, 1), 1, t + 1);
    WAIT_L(8); BAR8; WAIT_L(0); MMA8(0, 0, At, B0); BAR8; SCHED8;
    LDB8(B1, 0, 1); STG_B(SB8(0, 0), 0, t + 2);
    BAR8; WAIT_L(0); MMA8(0, 1, At, B1); BAR8;
    LDA8(At, 0, 1); STG_A(SA8(0, 0), 0, t + 2);
    BAR8; WAIT_L(0); MMA8(1, 0, At, B0); BAR8; SCHED8;
    STG_B(SB8(0, 1), 1, t + 2);
    WAIT_V(6); BAR8; MMA8(1, 1, At, B1); BAR8;
    LDB8(B0, 1, 0); SCHED8; LDA8(At, 1, 0); STG_A(SA8(0, 1), 1, t + 2);
    WAIT_L(8); BAR8; WAIT_L(0); MMA8(0, 0, At, B0); BAR8; SCHED8;
    LDB8(B1, 1, 1); STG_B(SB8(1, 0), 0, t + 3);
    BAR8; WAIT_L(0); MMA8(0, 1, At, B1); BAR8;
    LDA8(At, 1, 1); STG_A(SA8(1, 0), 0, t + 3);
    BAR8; WAIT_L(0); MMA8(1, 0, At, B0); BAR8; SCHED8;
    STG_B(SB8(1, 1), 1, t + 3);
    WAIT_V(6); BAR8; MMA8(1, 1, At, B1); BAR8;
  }
  { LDB8(B0, 0, 0); LDA8(At, 0, 0); STG_A(SA8(1, 1), 1, nt - 1);
    BAR8; WAIT_L(0); MMA8(0, 0, At, B0); BAR8;
    LDB8(B1, 0, 1); BAR8; WAIT_L(0); MMA8(0, 1, At, B1); BAR8;
    LDA8(At, 0, 1); WAIT_V(4); BAR8; WAIT_L(0); MMA8(1, 0, At, B0); MMA8(1, 1, At, B1); BAR8; }
  { LDB8(B0, 1, 0); LDA8(At, 1, 0); WAIT_V(2); BAR8; WAIT_L(0); MMA8(0, 0, At, B0); BAR8;
    LDB8(B1, 1, 1); WAIT_V(0); BAR8; WAIT_L(0); MMA8(0, 1, At, B1); BAR8;
    LDA8(At, 1, 1); BAR8; WAIT_L(0); MMA8(1, 0, At, B0); MMA8(1, 1, At, B1); BAR8; }
  if (wr == 0) BAR8;
#undef SA8
#undef SB8
#undef STG_A
#undef STG_B
#undef LDA8
#undef LDB8
#undef MMA8
  __syncthreads();
}

#define XB_TMO      128
#define XB_XCNT(j)  (256  + 64 * (j))
#define XB_XSUB(j)  (1280 + 64 * (j))
#define XB_XGEN(j)  (2304 + 64 * (j))
#define XB_TOP      3328
#define XB_TOPGEN   3392
#define XCD_BAR_WORDS 3456
#define XB_SPIN_CAP (1u << 22)
__device__ __forceinline__ unsigned xb_ld(unsigned* p)              { return __hip_atomic_load(p, __ATOMIC_RELAXED, __HIP_MEMORY_SCOPE_AGENT); }
__device__ __forceinline__ unsigned xb_add(unsigned* p, unsigned v) { return __hip_atomic_fetch_add(p, v, __ATOMIC_RELAXED, __HIP_MEMORY_SCOPE_AGENT); }
__device__ __forceinline__ unsigned xb_xcc_id() { return (unsigned)__builtin_amdgcn_s_getreg((3 << 11) | 20) & 0xFu; }
#define XB_SPIN(cond, bar) do { unsigned _sp = 0; while (cond) { __builtin_amdgcn_s_sleep(1); \
    if ((++_sp & 255u) == 0u) { if (xb_ld(&(bar)[XB_TMO])) break; if (_sp > XB_SPIN_CAP) { atomicAdd(&(bar)[XB_TMO], 1u); break; } } } } while (0)
struct XcdBarrier { unsigned* bar; unsigned x; volatile LAS unsigned* st; };
__device__ __forceinline__ XcdBarrier xcd_barrier_post(unsigned* bar, volatile LAS unsigned* st) {
    XcdBarrier b; b.bar = bar; b.x = xb_xcc_id(); b.st = st;
    if (threadIdx.x == 0) (void)xb_add(&bar[XB_XCNT(b.x)], 1u);
    return b;
}
__device__ __forceinline__ void xcd_barrier_complete(unsigned* bar, unsigned x, unsigned& nloc, unsigned& nx) {
    const unsigned G = gridDim.x * gridDim.y * gridDim.z;
    unsigned sum, cnt, mine, sp = 0u;
    for (;;) {
        sum = 0u; cnt = 0u; mine = 0u;
#pragma unroll
        for (unsigned j = 0; j < 16; ++j) { const unsigned c = xb_ld(&bar[XB_XCNT(j)]); sum += c; cnt += (c > 0u) ? 1u : 0u; mine = (j == x) ? c : mine; }
        if (sum == G) break;
        __builtin_amdgcn_s_sleep(1);
        if ((++sp & 255u) == 0u) { if (xb_ld(&bar[XB_TMO])) break; if (sp > XB_SPIN_CAP) { atomicAdd(&bar[XB_TMO], 1u); break; } }
    }
    nloc = mine > 0u ? mine : 1u; nx = cnt > 0u ? cnt : 1u;
}
__device__ __forceinline__ void xcd_barrier(const XcdBarrier& b) {
    asm volatile("s_waitcnt vmcnt(0)" ::: "memory");
    __syncthreads();
    if (threadIdx.x == 0) {
        unsigned* bar = b.bar;
        __builtin_amdgcn_s_waitcnt(0);
        unsigned nloc = b.st[0], nx = b.st[1];
        if (nloc == 0u) { xcd_barrier_complete(bar, b.x, nloc, nx); b.st[0] = nloc; b.st[1] = nx; }
        const unsigned old = xb_add(&bar[XB_XSUB(b.x)], 1u);
        const unsigned gen = old / nloc;
        if (old + 1u == (gen + 1u) * nloc) {
            __builtin_amdgcn_fence(__ATOMIC_RELEASE, "agent");
            asm volatile("s_waitcnt vmcnt(0)" ::: "memory");
            const unsigned og = xb_add(&bar[XB_TOP], 1u);
            const unsigned tg = og / nx;
            if (og + 1u == (tg + 1u) * nx) xb_add(&bar[XB_TOPGEN], 1u);
            else XB_SPIN(xb_ld(&bar[XB_TOPGEN]) == tg, bar);
            __builtin_amdgcn_fence(__ATOMIC_ACQUIRE, "agent");
            xb_add(&bar[XB_XGEN(b.x)], 1u);
            asm volatile("s_waitcnt vmcnt(0)" ::: "memory");
        } else {
            XB_SPIN(xb_ld(&bar[XB_XGEN(b.x)]) == gen, bar);
            __builtin_amdgcn_fence(__ATOMIC_ACQUIRE, "agent");
            asm volatile("s_waitcnt vmcnt(0)" ::: "memory");
        }
    }
    __syncthreads();
}


struct TileSched {
  int NT, m0, cnt, ntiles, nfull, local, nloc;
  __device__ __forceinline__ void init(int MT, int NT_) {
    NT = NT_;
    const int x = blockIdx.x & 7; local = blockIdx.x >> 3; nloc = gridDim.x >> 3;
    const int q = MT >> 3, r = MT & 7;
    cnt = q + (x < r ? 1 : 0); m0 = x * q + (x < r ? x : r);
    ntiles = cnt * NT; nfull = cnt >> 3;
  }
  int MTe, lin0;
  __device__ __forceinline__ void init_even(int MT, int NT_) {
    NT = NT_; MTe = MT;
    const int x = blockIdx.x & 7; local = blockIdx.x >> 3; nloc = gridDim.x >> 3;
    const int T = MT * NT_;
    lin0 = (int)(((long)T * x) >> 3);
    ntiles = (int)(((long)T * (x + 1)) >> 3) - lin0;
  }
  __device__ __forceinline__ void get_even(int i, int& mt, int& nt) const {
    const int L = lin0 + i, nfullg = MTe >> 3, full = nfullg * 8 * NT;
    if (L < full) { const int grp = L / (8 * NT), rem = L - grp * 8 * NT; nt = rem >> 3; mt = grp * 8 + (rem & 7); }
    else { const int i2 = L - full, gs = MTe - nfullg * 8; nt = i2 / gs; mt = nfullg * 8 + (i2 - nt * gs); }
  }
  __device__ __forceinline__ void get(int i, int& mt, int& nt) const {
    const int full = nfull * 8 * NT;
    if (i < full) { const int grp = i / (8 * NT), rem = i - grp * 8 * NT; nt = rem >> 3; mt = m0 + grp * 8 + (rem & 7); }
    else { const int i2 = i - full, gs = cnt - nfull * 8; nt = i2 / gs; mt = m0 + nfull * 8 + (i2 - nt * gs); }
  }
};

__device__ __forceinline__ float row_rstd(const float* ssq, int row) {
  float s = 0.f;
#pragma unroll
  for (int q = 0; q < 4; ++q) s += ssq[(size_t)q * NR + row];
  return rsqrtf(s * (1.f / 1024.f) + EPSN);
}

__device__ __forceinline__ void transpose_mat(const float* src, int ldsrc, int K, int N, bf16_t* dst, const float* scale, int kind, float* sm) {
  const int tid = threadIdx.x & 255;
  sm += (threadIdx.x >> 8) * 8448;
  const int nnb = N >> 7, ntile = (K >> 6) * nnb;
  for (int tile2 = blockIdx.x; tile2 < (ntile >> 1); tile2 += gridDim.x) {
    const int tile = tile2 * 2 + (threadIdx.x >> 8);
    const int kb = tile / nnb, nb4 = tile - kb * nnb;
    const int i = tid >> 3, j4 = tid & 7;
    float4 v[4][2];
#pragma unroll
    for (int sub = 0; sub < 4; ++sub) {
      const int nb = nb4 * 4 + sub;
      int scol;
      if (kind == 0) scol = nb * 32;
      else if (kind == 1) scol = nb * 32 < 1536 ? nb * 32 : nb * 32 + 16;
      else { int j = nb >> 3, half = (nb >> 2) & 1; scol = half * 2816 + j * 128 + (nb & 3) * 32; }
#pragma unroll
      for (int r = 0; r < 2; ++r) v[sub][r] = *(const float4*)(src + (size_t)(kb * 64 + i + 32 * r) * ldsrc + scol + j4 * 4);
    }
    const float sc0 = scale ? scale[kb * 64 + i] : 1.f, sc1 = scale ? scale[kb * 64 + i + 32] : 1.f;
#pragma unroll
    for (int sub = 0; sub < 4; ++sub) {
#pragma unroll
      for (int r = 0; r < 2; ++r) {
        const float sc = r ? sc1 : sc0;
        float* d = sm + sub * 2112 + (i + 32 * r) * 33 + j4 * 4;
        d[0] = v[sub][r].x * sc; d[1] = v[sub][r].y * sc; d[2] = v[sub][r].z * sc; d[3] = v[sub][r].w * sc;
      }
    }
    __syncthreads();
    {
      const int n = tid >> 3, kq = tid & 7;
#pragma unroll
      for (int sub = 0; sub < 4; ++sub) {
        const float* s2 = sm + sub * 2112 + (kq * 8) * 33 + n;
        uint4 o;
        o.x = pack2(s2[0], s2[33]); o.y = pack2(s2[66], s2[99]); o.z = pack2(s2[132], s2[165]); o.w = pack2(s2[198], s2[231]);
        *(uint4*)(dst + (size_t)((nb4 * 4 + sub) * 32 + n) * K + kb * 64 + kq * 8) = o;
      }
    }
    __syncthreads();
  }
}

__device__ __forceinline__ void phase_prep(const Params& p, char* lds) {
  const int tid = threadIdx.x, lane = tid & 63;
  bf16_t* wb = (bf16_t*)p.out;
  {
    bf16_t* xb = (bf16_t*)(p.ws + WS_XB);
    float* ssq = (float*)(p.ws + WS_SSQ2);
    const int gw = blockIdx.x * 8 + (tid >> 6), nw = gridDim.x * 8;
    for (int r = gw; r < NR; r += nw) {
      const float4* src = (const float4*)xrow_src(p, r);
      float s = 0.f;
#pragma unroll
      for (int j = 0; j < 4; ++j) {
        float4 v = src[lane + 64 * j];
        s += v.x * v.x + v.y * v.y + v.z * v.z + v.w * v.w;
        uint2 o; o.x = pack2(v.x, v.y); o.y = pack2(v.z, v.w);
        *(uint2*)(xb + (size_t)r * 1024 + (lane + 64 * j) * 4) = o;
      }
      s = wave_sum(s);
      if (lane < 4) ssq[(size_t)lane * NR + r] = lane == 0 ? s : 0.f;
    }
  }
  float* sm = (float*)lds;
  transpose_mat(p.in[10], 2064, 1024, 2048, wb + W_IN0, p.in[9], 1, sm);
  transpose_mat(p.in[22], 512, 512, 512, wb + W_GLU, nullptr, 0, sm);
  transpose_mat(p.in[24], 1024, 1024, 1024, wb + W_OUT0, nullptr, 0, sm);
  transpose_mat(p.in[36], 5632, 1024, 5632, wb + W_UP, p.in[35], 2, sm);
  transpose_mat(p.in[36] + (size_t)1024 * 5632, 5632, 1024, 5632, wb + W_UP + (size_t)5632 * 1024, p.in[35] + 1024, 2, sm);
  transpose_mat(p.in[39], 1024, 2816, 1024, wb + W_DOWN, nullptr, 0, sm);
  transpose_mat(p.in[39] + (size_t)2816 * 1024, 1024, 2816, 1024, wb + W_DOWN + (size_t)1024 * 2816, nullptr, 0, sm);
  transpose_mat(p.in[26], 3072, 1024, 3072, wb + W_IN1, p.in[25], 0, sm);
  transpose_mat(p.in[34], 1024, 1536, 1024, wb + W_OUT1, nullptr, 0, sm);
  const int gt = blockIdx.x * 512 + tid, ngt = gridDim.x * 512;
  for (int idx = gt; idx < 256 * 1024; idx += ngt) {
    const int c = idx >> 10, k = idx & 1023;
    const float* wi = p.in[10] + (size_t)k * 2064 + 1536;
    float s = 0.f;
#pragma unroll
    for (int r = 0; r < 16; ++r) s += wi[r] * p.in[11][r * 256 + c];
    wb[W_IN0 + (size_t)(2048 + c) * 1024 + k] = f2bf(s * p.in[9][k]);
  }
  for (int idx = gt; idx < 2 * 16 * 96 * 96; idx += ngt) {
    const int mat = idx / 147456, rem = idx - mat * 147456;
    const int nb = rem / 9216, r2 = rem - nb * 9216, d = r2 / 96, c = r2 - d * 96;
    const float* src = mat ? p.in[31] : p.in[29];
    wb[W_GATE + idx] = f2bf(src[nb * 9216 + c * 96 + d]);
  }
  for (int idx = gt; idx < 1536; idx += ngt) ((float*)(p.ws + WS_NSP))[idx] = -8.f * softplusf_(-p.in[33][idx]);
  for (int idx = gt; idx < 2048; idx += ngt) {
    const int g = idx >> 6;
    const float dt = expf(p.in[16][g]);
    const float lr = p.in[14][idx], li = p.in[15][idx];
    const float y = li * dt;
    const float kk = rintf(y * 0.15915494309189535f);
    float yr = fmaf(-kk, 6.2831854820251465f, y);
    yr = fmaf(-kk, -1.7484555e-7f, yr);
    const float sn = sinf(yr), cs = cosf(yr);
    const float mag = expf(lr * dt);
    const float abr = mag * cs, abi = mag * sn;
    const float sh = sinf(0.5f * yr);
    const float nr = expm1f(lr * dt) * cs - 2.f * sh * sh, ni = abi;
    const float den = lr * lr + li * li;
    const float fr = (nr * lr + ni * li) / den, fi = (ni * lr - nr * li) / den;
    float* ab = (float*)(p.ws + WS_S5AB);
    ab[idx] = abr; ab[2048 + idx] = abi;
    float pr = abr, pi = abi;
#pragma unroll
    for (int q = 0; q < 4; ++q) { float t = pr * pr - pi * pi; pi = 2.f * pr * pi; pr = t; }
    ab[4096 + idx] = pr; ab[6144 + idx] = pi;
#pragma unroll
    for (int q = 0; q < 2; ++q) { float t = pr * pr - pi * pi; pi = 2.f * pr * pi; pr = t; }
    ab[8192 + idx] = pr; ab[10240 + idx] = pi;
    float* bbr = (float*)(p.ws + WS_S5BB);
    float* bbi = bbr + 2048 * 16;
#pragma unroll
    for (int h = 0; h < 16; ++h) {
      const float br = p.in[17][idx * 16 + h], bi = p.in[18][idx * 16 + h];
      bbr[idx * 16 + h] = fr * br - fi * bi;
      bbi[idx * 16 + h] = fr * bi + fi * br;
    }
    bf16_t* cc = (bf16_t*)(p.ws + WS_S5CC);
    const int pp = idx & 63;
#pragma unroll
    for (int h = 0; h < 16; ++h) {
      cc[(g * 16 + h) * 128 + 2 * pp] = f2bf(p.in[19][(g * 16 + h) * 64 + pp]);
      cc[(g * 16 + h) * 128 + 2 * pp + 1] = f2bf(-p.in[20][(g * 16 + h) * 64 + pp]);
    }
  }
}

__device__ __forceinline__ void g1_store(const Params& p, bf16_t* zb, float* alog, int row, int col, float v0, float v1, float v2, float v3) {
  if (col < 2048) {
    if (col < 256) { v0 *= 0.125f; v1 *= 0.125f; v2 *= 0.125f; v3 *= 0.125f; }
    uint2 o; o.x = pack2(v0, v1); o.y = pack2(v2, v3);
    *(uint2*)(zb + (size_t)row * 2048 + col) = o;
  } else {
    const int c = col - 2048;
    const float4 ba = *(const float4*)(p.in[12] + c);
    float4 o;
    o.x = -softplusf_(-(v0 + ba.x)) * 0.0625f; o.y = -softplusf_(-(v1 + ba.y)) * 0.0625f;
    o.z = -softplusf_(-(v2 + ba.z)) * 0.0625f; o.w = -softplusf_(-(v3 + ba.w)) * 0.0625f;
    *(float4*)(alog + (size_t)row * 256 + c) = o;
  }
}
__device__ __forceinline__ void phase_g1(const Params& p, char* lds) {
  int tid, lane, w, wr, wc, lr, lq; TREFRESH();
  const bf16_t* zp = (const bf16_t*)(p.ws + WS_ZERO);
  const bf16_t* xb = (const bf16_t*)(p.ws + WS_XB);
  const bf16_t* W = (const bf16_t*)p.out + W_IN0;
  const float* ssq = (const float*)(p.ws + WS_SSQ2);
  bf16_t* zb = (bf16_t*)(p.ws + WS_SCR + SCR_ZB);
  float* alog = (float*)(p.ws + WS_SCR + SCR_ALOG);
  float* srs = (float*)(lds + LDS_SRS);
  unsigned* flg = (unsigned*)(p.ws + WS_FLAG);
  const int u = blockIdx.x;
  const bool unitA = u < 128, unitB = u >= 128 && u < 164;
  const int umt = unitA ? (u >> 1) : 64, unt = unitA ? 8 : ((u - 128) >> 2), uks = unitA ? (u & 1) : ((u - 128) & 3);
  const int uK = unitA ? 512 : 256, nsl = unitA ? 2 : 4;
  float* slab0 = unitA ? (float*)(p.ws + WS_SCR + SCR_SLOC) + (size_t)(u >> 1) * 2 * 65536 : (float*)(p.ws + WS_SLAB) + (size_t)unt * 4 * 65536;
  unsigned* tick = unitA ? flg + 4432 + (u >> 1) : flg + 4496 + unt;
  if (unitA || unitB) {
    const int k0 = uks * uK;
    f32x4 acc[8][4];
    gemm_tile256(acc, xb + k0, [&](int i) { return (umt * 256 + i) * 1024; }, W + (size_t)unt * 256 * 1024 + k0, 1024, uK, lds, zp);
    TREFRESH(); int zE = 0; asm volatile("" : "+v"(zE));
    float* slab = slab0 + (size_t)uks * 65536;
#pragma unroll
    for (int m = 0; m < 8; ++m)
#pragma unroll
      for (int n = 0; n < 4; ++n)
        *(float4*)(slab + ((m >> 2) * 128 + wr * 64 + (m & 3) * 16 + lr + zE) * 256 + (n >> 1) * 128 + wc * 32 + (n & 1) * 16 + lq * 4 + zE) = make_float4(acc[m][n][0], acc[m][n][1], acc[m][n][2], acc[m][n][3]);
    asm volatile("s_waitcnt vmcnt(0)" ::: "memory");
    __syncthreads();
    if (tid == 0) {
      __builtin_amdgcn_fence(__ATOMIC_RELEASE, "agent");
      asm volatile("s_waitcnt vmcnt(0)" ::: "memory");
      (void)xb_add(tick, 1u);
    }
  }
  TileSched ts; ts.init(64, 8);
  for (int ti = ts.local; ti < ts.ntiles; ti += ts.nloc) {
    int mt, nt; ts.get(ti, mt, nt);
    if (tid < 256) srs[tid] = row_rstd(ssq, mt * 256 + tid);
    f32x4 acc[8][4];
    gemm_tile256(acc, xb, [&](int i) { return (mt * 256 + i) * 1024; }, W + (size_t)nt * 256 * 1024, 1024, 1024, lds, zp);
    TREFRESH(); int zE = 0; asm volatile("" : "+v"(zE));
#pragma unroll
    for (int m = 0; m < 8; ++m) {
      const int r = (m >> 2) * 128 + wr * 64 + (m & 3) * 16 + lr + zE, row = mt * 256 + r;
      const float rs = srs[r];
#pragma unroll
      for (int n = 0; n < 4; ++n) {
        const int col = nt * 256 + (n >> 1) * 128 + wc * 32 + (n & 1) * 16 + lq * 4 + zE;
        f32x4 v = acc[m][n] * rs;
        if (col < 256) v = v * 0.125f;
        uint2 o; o.x = pack2(v[0], v[1]); o.y = pack2(v[2], v[3]);
        *(uint2*)(zb + (size_t)row * 2048 + col) = o;
      }
    }
    __syncthreads();
  }
  if (unitA || unitB) {
    if (tid == 0) {
      XB_SPIN(xb_ld(tick) < (unsigned)nsl, (unsigned*)(p.ws + WS_BAR));
      __builtin_amdgcn_fence(__ATOMIC_ACQUIRE, "agent");
      asm volatile("s_waitcnt vmcnt(0)" ::: "memory");
    }
    __syncthreads();
    const int rpb = 256 / nsl, r0 = uks * rpb;
    for (int rr = r0 + (tid >> 6); rr < r0 + rpb; rr += 8) {
      const int c4 = tid & 63, row = umt * 256 + rr, col = unt * 256 + c4 * 4;
      const float* s4 = slab0 + rr * 256 + c4 * 4;
      float4 sum = make_float4(0.f, 0.f, 0.f, 0.f);
      for (int q = 0; q < nsl; ++q) { const float4 v = *(const float4*)(s4 + (size_t)q * 65536); sum.x += v.x; sum.y += v.y; sum.z += v.z; sum.w += v.w; }
      const float rs = row_rstd(ssq, row);
      g1_store(p, zb, alog, row, col, sum.x * rs, sum.y * rs, sum.z * rs, sum.w * rs);
    }
  }
}

__device__ __forceinline__ void gla_chunk(const Params& p, int item, int mode, char* lds) {
  const int tid = threadIdx.x & 255, lane = tid & 63, w = tid >> 6, lr = lane & 15, lq = lane >> 4;
  const int bh = item / 33, c = item - bh * 33, b = bh >> 2, h = bh & 3;
  const int row0 = b * TP + (c == 0 ? 0 : 16 + 64 * (c - 1));
  const int len = c == 0 ? 16 : 64;
  bf16_t* zb = (bf16_t*)(p.ws + WS_SCR + SCR_ZB);
  const float* alog = (const float*)(p.ws + WS_SCR + SCR_ALOG);
  float* sloc = (float*)(p.ws + WS_SCR + SCR_SLOC) + (size_t)(bh * 33 + c) * 8192;
  float* sb = (float*)lds;
  char* Qs = lds + 16384; char* Ks = lds + 24576; char* VT = lds + 32768; char* ST = lds + 49152;
#pragma unroll
  for (int i = 0; i < 4; ++i) {
    const int idx = tid + 256 * i, r = idx >> 4, c4 = idx & 15;
    float4 v = make_float4(0.f, 0.f, 0.f, 0.f);
    if (r < len) v = *(const float4*)(alog + (size_t)(row0 + r) * 256 + h * 64 + c4 * 4);
    *(float4*)(sb + r * 64 + c4 * 4) = v;
  }
  __syncthreads();
  {
    float run = 0.f;
#pragma unroll
    for (int t = 0; t < 16; ++t) { run += sb[(16 * w + t) * 64 + lane]; sb[(16 * w + t) * 64 + lane] = run; }
  }
  __syncthreads();
  float off = 0.f;
#pragma unroll
  for (int s = 0; s < 3; ++s) if (s < w) off += sb[(16 * s + 15) * 64 + lane];
  __syncthreads();
#pragma unroll
  for (int t = 0; t < 16; ++t) sb[(16 * w + t) * 64 + lane] += off;
  __syncthreads();
#pragma unroll
  for (int i = 0; i < 2; ++i) {
    const int idx = tid + 256 * i, r = idx & 63, ch = idx >> 6;
    uint4 qv = make_uint4(0, 0, 0, 0), kv = make_uint4(0, 0, 0, 0);
    if (r < len) {
      const bf16_t* zr = zb + (size_t)(row0 + r) * 2048 + h * 64 + ch * 8;
      qv = *(const uint4*)zr; kv = *(const uint4*)(zr + 256);
    }
    float bv[8];
#pragma unroll
    for (int e = 0; e < 8; ++e) bv[e] = sb[r * 64 + ch * 8 + e];
    const uint32_t qq[4] = {qv.x, qv.y, qv.z, qv.w}, kq[4] = {kv.x, kv.y, kv.z, kv.w};
    if (mode == 1) {
      uint32_t oq[4], ok[4];
#pragma unroll
      for (int e = 0; e < 4; ++e) {
        const float e0 = __expf(bv[2 * e]), e1 = __expf(bv[2 * e + 1]);
        oq[e] = pack2(lo2f(qq[e]) * e0, hi2f(qq[e]) * e1);
        ok[e] = pack2(lo2f(kq[e]) * __builtin_amdgcn_rcpf(e0), hi2f(kq[e]) * __builtin_amdgcn_rcpf(e1));
      }
      *(uint4*)(Qs + toff(r, ch)) = make_uint4(oq[0], oq[1], oq[2], oq[3]);
      *(uint4*)(Ks + toff(r, ch)) = make_uint4(ok[0], ok[1], ok[2], ok[3]);
    } else {
#pragma unroll
      for (int e = 0; e < 8; ++e) {
        const int d = ch * 8 + e;
        const float kf = (e & 1) ? hi2f(kq[e >> 1]) : lo2f(kq[e >> 1]);
        const float kh = kf * __expf(sb[63 * 64 + d] - bv[e]);
        *(bf16_t*)(Qs + d * 128 + ((((r >> 3) ^ (d & 7))) << 4) + (r & 7) * 2) = f2bf(kh);
      }
    }
  }
#pragma unroll
  for (int i = 0; i < 4; ++i) {
    const int idx = tid + 256 * i, r = idx & 63, ch = idx >> 6;
    uint4 vv = make_uint4(0, 0, 0, 0);
    if (r < len) vv = *(const uint4*)(zb + (size_t)(row0 + r) * 2048 + 512 + h * 128 + ch * 8);
    const uint32_t vq[4] = {vv.x, vv.y, vv.z, vv.w};
#pragma unroll
    for (int e = 0; e < 8; ++e) {
      const int ee = ch * 8 + e;
      const bf16_t val = (bf16_t)((e & 1) ? (vq[e >> 1] >> 16) : (vq[e >> 1] & 0xffffu));
      *(bf16_t*)(VT + ee * 128 + ((((r >> 3) ^ (ee & 7))) << 4) + (r & 7) * 2) = val;
    }
  }
  if (mode == 1) {
#pragma unroll
    for (int i = 0; i < 4; ++i) {
      const int idx = tid + 256 * i, e = idx >> 3, ch = idx & 7;
      const float4 a = *(const float4*)(sloc + e * 64 + ch * 8);
      const float4 bq = *(const float4*)(sloc + e * 64 + ch * 8 + 4);
      *(uint4*)(ST + toff(e, ch)) = make_uint4(pack2(a.x, a.y), pack2(a.z, a.w), pack2(bq.x, bq.y), pack2(bq.z, bq.w));
    }
  }
  __syncthreads();
  if (mode == 1) {
    f32x4 at[4];
#pragma unroll
    for (int n = 0; n < 4; ++n) at[n] = (f32x4){0.f, 0.f, 0.f, 0.f};
#pragma unroll
    for (int s = 0; s < 2; ++s) {
      const bf16x8 a = *(const bf16x8*)(Qs + toff(16 * w + lr, s * 4 + lq));
#pragma unroll
      for (int n = 0; n < 4; ++n) {
        const bf16x8 bk = *(const bf16x8*)(Ks + toff(16 * n + lr, s * 4 + lq));
        at[n] = mfma16(bk, a, at[n]);
      }
    }
    char* P = lds;
    const int i = 16 * w + lr;
#pragma unroll
    for (int n = 0; n < 4; ++n) {
      const int j0 = 16 * n + lq * 4;
      float v0 = (j0 + 0 <= i) ? at[n][0] : 0.f, v1 = (j0 + 1 <= i) ? at[n][1] : 0.f;
      float v2 = (j0 + 2 <= i) ? at[n][2] : 0.f, v3 = (j0 + 3 <= i) ? at[n][3] : 0.f;
      uint2 o; o.x = pack2(v0, v1); o.y = pack2(v2, v3);
      *(uint2*)(P + i * 128 + ((((j0 >> 3) ^ (i & 7))) << 4) + (j0 & 7) * 2) = o;
    }
    __syncthreads();
    f32x4 o[8];
#pragma unroll
    for (int n = 0; n < 8; ++n) o[n] = (f32x4){0.f, 0.f, 0.f, 0.f};
#pragma unroll
    for (int s = 0; s < 2; ++s) {
      const bf16x8 aP = *(const bf16x8*)(P + toff(16 * w + lr, s * 4 + lq));
      const bf16x8 aQ = *(const bf16x8*)(Qs + toff(16 * w + lr, s * 4 + lq));
#pragma unroll
      for (int n = 0; n < 8; ++n) {
        const bf16x8 bV = *(const bf16x8*)(VT + toff(16 * n + lr, s * 4 + lq));
        const bf16x8 bS = *(const bf16x8*)(ST + toff(16 * n + lr, s * 4 + lq));
        o[n] = mfma16(bV, aP, o[n]);
        o[n] = mfma16(bS, aQ, o[n]);
      }
    }
    float ss = 0.f;
#pragma unroll
    for (int n = 0; n < 8; ++n) ss += o[n][0] * o[n][0] + o[n][1] * o[n][1] + o[n][2] * o[n][2] + o[n][3] * o[n][3];
    ss += __shfl_xor(ss, 16); ss += __shfl_xor(ss, 32);
    const float rstd = rsqrtf(ss * (1.f / 128.f) + EPSN);
    if (i < len) {
      bf16_t* zr = zb + (size_t)(row0 + i) * 2048;
#pragma unroll
      for (int n = 0; n < 8; ++n) {
        const int e0 = 16 * n + lq * 4;
        const uint2 g2 = *(const uint2*)(zr + 1024 + h * 128 + e0);
        const float4 gn = *(const float4*)(p.in[13] + h * 128 + e0);
        const float g0 = lo2f(g2.x), g1 = hi2f(g2.x), g2f = lo2f(g2.y), g3 = hi2f(g2.y);
        uint2 ov;
        ov.x = pack2(o[n][0] * rstd * gn.x * g0 * sigm(g0), o[n][1] * rstd * gn.y * g1 * sigm(g1));
        ov.y = pack2(o[n][2] * rstd * gn.z * g2f * sigm(g2f), o[n][3] * rstd * gn.w * g3 * sigm(g3));
        *(uint2*)(zr + 512 + h * 128 + e0) = ov;
      }
    }
  } else {
    f32x4 sl[8];
#pragma unroll
    for (int n = 0; n < 8; ++n) sl[n] = (f32x4){0.f, 0.f, 0.f, 0.f};
#pragma unroll
    for (int s = 0; s < 2; ++s) {
      const bf16x8 aK = *(const bf16x8*)(Qs + toff(16 * w + lr, s * 4 + lq));
#pragma unroll
      for (int n = 0; n < 8; ++n) {
        const bf16x8 bV = *(const bf16x8*)(VT + toff(16 * n + lr, s * 4 + lq));
        sl[n] = mfma16(aK, bV, sl[n]);
      }
    }
#pragma unroll
    for (int n = 0; n < 8; ++n) {
      const int e = 16 * n + lr, d0 = 16 * w + lq * 4;
      *(float4*)(sloc + e * 64 + d0) = make_float4(sl[n][0], sl[n][1], sl[n][2], sl[n][3]);
    }
    if (tid < 64) ((float*)(p.ws + WS_DEC))[(bh * 33 + c) * 64 + tid] = __expf(sb[63 * 64 + tid]);
  }
  __syncthreads();
}

__device__ __forceinline__ void gla_sample(const Params& p, int item, char* lds) {
  const int tid = threadIdx.x & 255;
  const int s = item >> 2, h = item & 3, row = NPR + s;
  bf16_t* zb = (bf16_t*)(p.ws + WS_SCR + SCR_ZB);
  const float* alog = (const float*)(p.ws + WS_SCR + SCR_ALOG);
  float* sq = (float*)lds; float* sk = sq + 64; float* sa = sk + 64; float* part = sa + 64; float* red = part + 256;
  if (tid < 64) {
    sq[tid] = bf2f(zb[(size_t)row * 2048 + h * 64 + tid]);
    sk[tid] = bf2f(zb[(size_t)row * 2048 + 256 + h * 64 + tid]);
    sa[tid] = __expf(alog[(size_t)row * 256 + h * 64 + tid]);
  }
  __syncthreads();
  const int e = tid & 127, half = tid >> 7;
  const float v = bf2f(zb[(size_t)row * 2048 + 512 + h * 128 + e]);
  const float* S0 = p.in[2] + (size_t)(s * 4 + h) * 8192;
  float* So = p.out + O_GLAS + (size_t)(s * 4 + h) * 8192;
  float acc = 0.f;
#pragma unroll 8
  for (int dd = 0; dd < 32; ++dd) {
    const int d = half * 32 + dd;
    const float sn = sa[d] * S0[d * 128 + e] + sk[d] * v;
    So[d * 128 + e] = sn;
    acc += sq[d] * sn;
  }
  part[tid] = acc;
  __syncthreads();
  float o = 0.f;
  if (tid < 128) { o = part[tid] + part[tid + 128]; }
  float ssv = wave_sum(tid < 128 ? o * o : 0.f);
  if ((tid & 63) == 0) red[tid >> 6] = ssv;
  __syncthreads();
  if (tid < 128) {
    const float rstd = rsqrtf((red[0] + red[1]) * (1.f / 128.f) + EPSN);
    const float g = bf2f(zb[(size_t)row * 2048 + 1024 + h * 128 + e]);
    zb[(size_t)row * 2048 + 512 + h * 128 + e] = f2bf(o * rstd * p.in[13][h * 128 + e] * g * sigm(g));
  }
  __syncthreads();
}

typedef __attribute__((ext_vector_type(2))) float f32x2;
__device__ __forceinline__ void s5_load_u(const bf16_t* zb, int row0, int len, int g, int lane, char* ul) {
  uint4 a = make_uint4(0, 0, 0, 0), b = a;
  if (lane < len) {
    const uint4* s = (const uint4*)(zb + (size_t)(row0 + lane) * 2048 + 1536 + g * 16);
    a = s[0]; b = s[1];
  }
  float4* d = (float4*)(ul + lane * 64);
  d[0] = make_float4(lo2f(a.x), hi2f(a.x), lo2f(a.y), hi2f(a.y));
  d[1] = make_float4(lo2f(a.z), hi2f(a.z), lo2f(a.w), hi2f(a.w));
  d[2] = make_float4(lo2f(b.x), hi2f(b.x), lo2f(b.y), hi2f(b.y));
  d[3] = make_float4(lo2f(b.z), hi2f(b.z), lo2f(b.w), hi2f(b.w));
}
__device__ __forceinline__ void s5_load_bb(const float* bbrp, int idx, f32x2 (&bb)[16]) {
#pragma unroll
  for (int q = 0; q < 4; ++q) {
    const float4 x = *(const float4*)(bbrp + idx * 16 + q * 4), y = *(const float4*)(bbrp + 32768 + idx * 16 + q * 4);
    bb[4 * q] = (f32x2){x.x, y.x}; bb[4 * q + 1] = (f32x2){x.y, y.y}; bb[4 * q + 2] = (f32x2){x.z, y.z}; bb[4 * q + 3] = (f32x2){x.w, y.w};
  }
}
__device__ __forceinline__ void s5_step(const char* ul, int t, const f32x2 (&bb)[16], float ar, float ai, float& xr, float& xi) {
  const float4* u = (const float4*)(ul + t * 64);
  const float4 u0 = u[0], u1 = u[1], u2 = u[2], u3 = u[3];
  f32x2 acc = bb[0] * u0.x;
  acc += bb[1] * u0.y; acc += bb[2] * u0.z; acc += bb[3] * u0.w;
  acc += bb[4] * u1.x; acc += bb[5] * u1.y; acc += bb[6] * u1.z; acc += bb[7] * u1.w;
  acc += bb[8] * u2.x; acc += bb[9] * u2.y; acc += bb[10] * u2.z; acc += bb[11] * u2.w;
  acc += bb[12] * u3.x; acc += bb[13] * u3.y; acc += bb[14] * u3.z; acc += bb[15] * u3.w;
  const float nr = ar * xr - ai * xi + acc[0], ni = ar * xi + ai * xr + acc[1];
  xr = nr; xi = ni;
}

__device__ __forceinline__ void s5_pass1(const Params& p, char* lds) {
  const int tid = threadIdx.x, lane = tid & 63, w = tid >> 6;
  const bf16_t* zb = (const bf16_t*)(p.ws + WS_SCR + SCR_ZB);
  const float* ab = (const float*)(p.ws + WS_S5AB);
  const float* bbrp = (const float*)(p.ws + WS_S5BB);
  float* xloc = (float*)(p.ws + WS_XLOC);
  char* ul = lds + w * 4096;
  const int nitem = 8 * 32 * 32;
  for (int base = blockIdx.x * 8; base < nitem; base += gridDim.x * 8) {
    const int item = base + w;
    const bool valid = item < nitem;
    const int it = valid ? item : 0;
    const int bg = it >> 5, c = it & 31, b = bg >> 5, g = bg & 31;
    const int row0 = b * TP + (c == 0 ? 0 : 16 + 64 * (c - 1));
    const int len = c == 0 ? 16 : 64;
    const int idx = g * 64 + lane;
    f32x2 bb[16];
    s5_load_bb(bbrp, idx, bb);
    const float ar = ab[idx], ai = ab[2048 + idx];
    __syncthreads();
    s5_load_u(zb, row0, len, g, lane, ul);
    __syncthreads();
    float xr = 0.f, xi = 0.f;
    for (int t = 0; t < len; ++t) s5_step(ul, t, bb, ar, ai, xr, xi);
    if (valid) {
      xloc[(size_t)(bg * 33 + c) * 64 + lane] = xr;
      xloc[540672 + (size_t)(bg * 33 + c) * 64 + lane] = xi;
    }
  }
}

__device__ __forceinline__ void s5_pass2(const Params& p) {
  const int gt = blockIdx.x * 512 + threadIdx.x;
  if (gt >= 16384) return;
  const int bg = gt >> 6, pp = gt & 63, g = bg & 31, idx = g * 64 + pp;
  const float* ab = (const float*)(p.ws + WS_S5AB);
  const float* xloc = (const float*)(p.ws + WS_XLOC);
  float* xst = (float*)(p.ws + WS_XST);
  const float a16r = ab[4096 + idx], a16i = ab[6144 + idx], a64r = ab[8192 + idx], a64i = ab[10240 + idx];
  float xr = 0.f, xi = 0.f;
  const size_t o0 = (size_t)bg * 33 * 64 + pp;
  xst[o0] = 0.f; xst[540672 + o0] = 0.f;
#pragma unroll 1
  for (int c0 = 0; c0 < 32; c0 += 8) {
    float lr_[8], li_[8];
#pragma unroll
    for (int q = 0; q < 8; ++q) { lr_[q] = xloc[o0 + (c0 + q) * 64]; li_[q] = xloc[540672 + o0 + (c0 + q) * 64]; }
#pragma unroll
    for (int q = 0; q < 8; ++q) {
      const int c = c0 + q;
      const float Ar = c == 0 ? a16r : a64r, Ai = c == 0 ? a16i : a64i;
      const float nr = Ar * xr - Ai * xi + lr_[q], ni = Ar * xi + Ai * xr + li_[q];
      xr = nr; xi = ni;
      xst[o0 + (c + 1) * 64] = xr; xst[540672 + o0 + (c + 1) * 64] = xi;
    }
  }
}

__device__ __forceinline__ void s5_pass3(const Params& p, char* lds) {
  const int tid = threadIdx.x, lane = tid & 63, w = tid >> 6, lr = lane & 15, lq = lane >> 4;
  bf16_t* zb = (bf16_t*)(p.ws + WS_SCR + SCR_ZB);
  const float* ab = (const float*)(p.ws + WS_S5AB);
  const float* bbrp = (const float*)(p.ws + WS_S5BB);
  const float* xst = (const float*)(p.ws + WS_XST);
  const bf16_t* cc = (const bf16_t*)(p.ws + WS_S5CC);
  char* ul = lds + w * 4096;
  char* X = lds + 32768 + w * 8192;
  const int nprompt = 8 * 32 * 33, nitem = nprompt + 128 * 32;
  for (int base = blockIdx.x * 8; base < nitem; base += gridDim.x * 8) {
    const int item = base + w;
    const bool valid = item < nitem;
    const int it = valid ? item : 0;
    int b, g, c, row0, len; bool last, smp;
    float xr, xi;
    if (it < nprompt) {
      const int bg = it / 33; c = it - bg * 33; b = bg >> 5; g = bg & 31; smp = false;
      row0 = b * TP + (c == 0 ? 0 : 16 + 64 * (c - 1)); len = c == 0 ? 16 : 64; last = c == 32;
      xr = xst[(size_t)it * 64 + lane]; xi = xst[540672 + (size_t)it * 64 + lane];
    } else {
      const int i2 = it - nprompt; b = i2 >> 5; g = i2 & 31; c = 0; smp = true;
      row0 = NPR + b; len = 1; last = true;
      xr = p.in[3][(b * 32 + g) * 64 + lane]; xi = p.in[4][(b * 32 + g) * 64 + lane];
    }
    const int idx = g * 64 + lane;
    f32x2 bb[16];
    s5_load_bb(bbrp, idx, bb);
    const float ar = ab[idx], ai = ab[2048 + idx];
    bf16x8 bC[4];
#pragma unroll
    for (int s = 0; s < 4; ++s) bC[s] = *(const bf16x8*)(cc + (g * 16 + lr) * 128 + 32 * s + 8 * lq);
    const float4 dd = *(const float4*)(p.in[21] + g * 16 + lq * 4);
    __syncthreads();
    s5_load_u(zb, row0, len, g, lane, ul);
    __syncthreads();
#pragma unroll 1
    for (int half = 0; half < 2; ++half) {
      const int tl = len - 32 * half < 32 ? len - 32 * half : 32;
      for (int tt = 0; tt < tl; ++tt) {
        s5_step(ul, 32 * half + tt, bb, ar, ai, xr, xi);
        *(uint32_t*)(X + tt * 256 + ((((lane >> 2) ^ (tt & 15))) << 4) + (lane & 3) * 4) = pack2(xr, xi);
      }
      __syncthreads();
      f32x4 y[2];
#pragma unroll
      for (int m = 0; m < 2; ++m) {
        y[m] = (f32x4){0.f, 0.f, 0.f, 0.f};
        const int row = 16 * m + lr;
#pragma unroll
        for (int s = 0; s < 4; ++s) {
          const bf16x8 a = *(const bf16x8*)(X + row * 256 + ((((s * 4 + lq) ^ (row & 15))) << 4));
          y[m] = mfma16(bC[s], a, y[m]);
        }
      }
#pragma unroll
      for (int m = 0; m < 2; ++m) {
        const int t = 32 * half + 16 * m + lr;
        if (valid && t < len) {
          const float4 u4 = *(const float4*)(ul + t * 64 + lq * 16);
          const float y0 = gelu_t(y[m][0] + dd.x * u4.x), y1 = gelu_t(y[m][1] + dd.y * u4.y);
          const float y2 = gelu_t(y[m][2] + dd.z * u4.z), y3 = gelu_t(y[m][3] + dd.w * u4.w);
          uint2 o; o.x = pack2(y0, y1); o.y = pack2(y2, y3);
          *(uint2*)(zb + (size_t)(row0 + t) * 2048 + 1536 + g * 16 + lq * 4) = o;
        }
      }
      __syncthreads();
    }
    if (valid && last) {
      if (smp) { p.out[O_S5RS + (b * 32 + g) * 64 + lane] = xr; p.out[O_S5IS + (b * 32 + g) * 64 + lane] = xi; }
      else { p.out[O_S5RP + (b * 32 + g) * 64 + lane] = xr; p.out[O_S5IP + (b * 32 + g) * 64 + lane] = xi; }
    }
  }
}

__device__ __forceinline__ void phase_mix_a(const Params& p, char* lds) {
  { const int hf = threadIdx.x >> 8; for (int pr = blockIdx.x; pr < 16 * 33; pr += gridDim.x) gla_chunk(p, pr * 2 + hf, 0, lds + hf * HALF_LDS); }
  __syncthreads();
  s5_pass1(p, lds);
}
__device__ __forceinline__ void phase_mix_b(const Params& p) {
  float* slocb = (float*)(p.ws + WS_SCR + SCR_SLOC);
  const float* dec = (const float*)(p.ws + WS_DEC);
  const int gt = blockIdx.x * 512 + threadIdx.x, ngt = gridDim.x * 512;
#pragma unroll 1
  for (int idx = gt; idx < 32 * 8192; idx += ngt) {
    const int bh = idx >> 13, ed = idx & 8191, e = ed >> 6, d = ed & 63;
    float S = 0.f;
#pragma unroll 1
    for (int c0 = 0; c0 < 33; c0 += 11) {
      float tmp[11], dc[11];
#pragma unroll
      for (int q = 0; q < 11; ++q) { tmp[q] = slocb[(size_t)(bh * 33 + c0 + q) * 8192 + ed]; dc[q] = dec[(bh * 33 + c0 + q) * 64 + d]; }
#pragma unroll
      for (int q = 0; q < 11; ++q) { slocb[(size_t)(bh * 33 + c0 + q) * 8192 + ed] = S; S = dc[q] * S + tmp[q]; }
    }
    p.out[O_GLAP + (size_t)(bh * 64 + d) * 128 + e] = S;
  }
  s5_pass2(p);
}
__device__ __forceinline__ void phase_mix_c(const Params& p, char* lds) {
  const int hf = threadIdx.x >> 8;
  for (int pr = blockIdx.x; pr < 16 * 33; pr += gridDim.x) gla_chunk(p, pr * 2 + hf, 1, lds + hf * HALF_LDS);
  __syncthreads();
  for (int pr = blockIdx.x; pr < 256; pr += gridDim.x) gla_sample(p, pr * 2 + hf, lds + hf * HALF_LDS);
  __syncthreads();
  s5_pass3(p, lds);
}

__device__ __forceinline__ void phase_glu(const Params& p, char* lds) {
  int tid, lane, w, wr, wc, lr, lq; TREFRESH();
  const bf16_t* zp = (const bf16_t*)(p.ws + WS_ZERO);
  bf16_t* zb = (bf16_t*)(p.ws + WS_SCR + SCR_ZB);
  const bf16_t* W = (const bf16_t*)p.out + W_GLU;
  TileSched ts; ts.init(65, 2);
  for (int ti = ts.local; ti < ts.ntiles; ti += ts.nloc) {
    int mt, nt; ts.get(ti, mt, nt);
    f32x4 acc[8][4];
    gemm_tile256(acc, (const bf16_t*)zb + 1536, [&](int i) { return (mt * 256 + i) * 2048; }, W + (size_t)nt * 256 * 512, 512, 512, lds, zp);
    TREFRESH(); int zE = 0; asm volatile("" : "+v"(zE));
#pragma unroll
    for (int m = 0; m < 8; ++m) {
      const int row = mt * 256 + (m >> 2) * 128 + wr * 64 + (m & 3) * 16 + lr + zE;
#pragma unroll
      for (int n = 0; n < 4; ++n) {
        const int col = nt * 256 + (n >> 1) * 128 + wc * 32 + (n & 1) * 16 + lq * 4 + zE;
        const uint2 y2 = *(const uint2*)(zb + (size_t)row * 2048 + 1536 + col);
        const float4 bg = *(const float4*)(p.in[23] + col);
        uint2 o;
        o.x = pack2(lo2f(y2.x) * sigm(acc[m][n][0] + bg.x), hi2f(y2.x) * sigm(acc[m][n][1] + bg.y));
        o.y = pack2(lo2f(y2.y) * sigm(acc[m][n][2] + bg.z), hi2f(y2.y) * sigm(acc[m][n][3] + bg.w));
        *(uint2*)(zb + (size_t)row * 2048 + 1024 + col) = o;
      }
      asm volatile("" ::: "memory");
    }
  }
}

__device__ __forceinline__ void phase_resid(const Params& p, char* lds, const bf16_t* A, int lda, const bf16_t* W, int K, int tkbase, int site) {
  int tid, lane, w, wr, wc, lr, lq; TREFRESH();
  const bf16_t* zp = (const bf16_t*)(p.ws + WS_ZERO);
  bf16_t* xb = (bf16_t*)(p.ws + WS_XB);
  float* ssq = (float*)(p.ws + WS_SSQ2) + (size_t)site * 4 * NR;
  const int ks = K >> 8;
  const bool isunit = (int)blockIdx.x < 4 * ks;
  const int unt = (int)blockIdx.x / ks, uksi = (int)blockIdx.x - unt * ks;
  unsigned* tick = (unsigned*)(p.ws + WS_FLAG) + 4352 + tkbase;
  if (isunit) {
    const int nt = unt, k0 = uksi * 256;
    f32x4 acc[8][4];
    gemm_tile256(acc, A + k0, [&](int i) { return (16384 + i) * lda; }, W + (size_t)nt * 256 * K + k0, K, 256, lds, zp);
    TREFRESH(); int zE = 0; asm volatile("" : "+v"(zE));
    float* slab = (float*)(p.ws + WS_SLAB) + (size_t)(nt * ks + uksi) * 65536;
#pragma unroll
    for (int m = 0; m < 8; ++m)
#pragma unroll
      for (int n = 0; n < 4; ++n)
        *(float4*)(slab + ((m >> 2) * 128 + wr * 64 + (m & 3) * 16 + lr + zE) * 256 + (n >> 1) * 128 + wc * 32 + (n & 1) * 16 + lq * 4 + zE) = make_float4(acc[m][n][0], acc[m][n][1], acc[m][n][2], acc[m][n][3]);
    asm volatile("s_waitcnt vmcnt(0)" ::: "memory");
    __syncthreads();
    if (tid == 0) {
      __builtin_amdgcn_fence(__ATOMIC_RELEASE, "agent");
      asm volatile("s_waitcnt vmcnt(0)" ::: "memory");
      (void)xb_add(&tick[nt], 1u);
    }
  }
  TileSched ts; ts.init(64, 4);
  for (int ti = ts.local; ti < ts.ntiles; ti += ts.nloc) {
    int mt, nt; ts.get(ti, mt, nt);
    f32x4 acc[8][4];
    gemm_tile256(acc, A, [&](int i) { return (mt * 256 + i) * lda; }, W + (size_t)nt * 256 * K, K, K, lds, zp);
    TREFRESH(); int zE = 0; asm volatile("" : "+v"(zE));
#pragma unroll
    for (int m = 0; m < 8; ++m) {
      const int row = mt * 256 + (m >> 2) * 128 + wr * 64 + (m & 3) * 16 + lr + zE;
      float ss0 = 0.f, ss1 = 0.f;
#pragma unroll
      for (int n = 0; n < 4; ++n) {
        const int col = nt * 256 + (n >> 1) * 128 + wc * 32 + (n & 1) * 16 + lq * 4 + zE;
        const uint2 u = *(const uint2*)(xb + (size_t)row * 1024 + col);
        uint2 o; o.x = pack2(lo2f(u.x) + acc[m][n][0], hi2f(u.x) + acc[m][n][1]); o.y = pack2(lo2f(u.y) + acc[m][n][2], hi2f(u.y) + acc[m][n][3]);
        *(uint2*)(xb + (size_t)row * 1024 + col) = o;
        const float y0 = lo2f(o.x), y1 = hi2f(o.x), y2 = lo2f(o.y), y3 = hi2f(o.y);
        const float q = y0 * y0 + y1 * y1 + y2 * y2 + y3 * y3;
        if (n < 2) ss0 += q; else ss1 += q;
      }
      float ssw = ss0 + ss1;
      ssw += __shfl_xor(ssw, 16); ssw += __shfl_xor(ssw, 32);
      if (lq == 0) ((float*)lds)[((m >> 2) * 128 + wr * 64 + (m & 3) * 16 + lr) * 4 + wc] = ssw;
      asm volatile("" ::: "memory");
    }
    __syncthreads();
    if (tid < 256) { const float4 q4 = *(const float4*)((const float*)lds + tid * 4); ssq[(size_t)nt * NR + mt * 256 + tid] = (q4.x + q4.y) + (q4.z + q4.w); }
    __syncthreads();
  }
  if (isunit) {
    const int nt = unt;
    if (tid == 0) {
      XB_SPIN(xb_ld(&tick[nt]) < (unsigned)ks, (unsigned*)(p.ws + WS_BAR));
      __builtin_amdgcn_fence(__ATOMIC_ACQUIRE, "agent");
      asm volatile("s_waitcnt vmcnt(0)" ::: "memory");
    }
    __syncthreads();
    const int rpb = (256 + ks - 1) / ks, r0 = uksi * rpb, r1 = r0 + rpb < 256 ? r0 + rpb : 256;
    const float* sl = (const float*)(p.ws + WS_SLAB) + (size_t)(nt * ks) * 65536;
    for (int rr = r0 + (tid >> 6); rr < r1; rr += 8) {
      const int c4 = tid & 63, row = 16384 + rr, col = nt * 256 + c4 * 4;
      const float* s4 = sl + rr * 256 + c4 * 4;
      float4 sum = make_float4(0.f, 0.f, 0.f, 0.f);
      for (int q = 0; q < ks; ++q) { const float4 v = *(const float4*)(s4 + (size_t)q * 65536); sum.x += v.x; sum.y += v.y; sum.z += v.z; sum.w += v.w; }
      const uint2 u2 = *(const uint2*)(xb + (size_t)row * 1024 + col);
      uint2 o;
      o.x = pack2(lo2f(u2.x) + sum.x, hi2f(u2.x) + sum.y);
      o.y = pack2(lo2f(u2.y) + sum.z, hi2f(u2.y) + sum.w);
      *(uint2*)(xb + (size_t)row * 1024 + col) = o;
      const float y0 = lo2f(o.x), y1 = hi2f(o.x), y2 = lo2f(o.y), y3 = hi2f(o.y);
      float ss = wave_sum(y0 * y0 + y1 * y1 + y2 * y2 + y3 * y3);
      if (c4 == 0) ssq[(size_t)nt * NR + row] = ss;
    }
  }
}

__device__ __forceinline__ void phase_ffn_up(const Params& p, char* lds, int layer, int site) {
  int tid, lane, w, wr, wc, lr, lq; TREFRESH();
  const bf16_t* zp = (const bf16_t*)(p.ws + WS_ZERO);
  const bf16_t* xb = (const bf16_t*)(p.ws + WS_XB);
  const bf16_t* W = (const bf16_t*)p.out + W_UP + (size_t)layer * 5632 * 1024;
  const float* ssq = (const float*)(p.ws + WS_SSQ2) + (size_t)site * 4 * NR;
  bf16_t* act = (bf16_t*)(p.ws + WS_SCR + SCR_ACT);
  const float* cw = p.in[37] + (size_t)layer * 3 * 2816;
  const float* cb = p.in[38] + (size_t)layer * 2816;
  const float* cache = p.in[7] + (size_t)layer * 128 * 2 * 2816;
  float* srs = (float*)(lds + LDS_SRS);
  TileSched ts; ts.init_even(67, 22);
  for (int ti = ts.local; ti < ts.ntiles; ti += ts.nloc) {
    int mt, nt; ts.get_even(ti, mt, nt);
    const bool smp = mt == 66;
    const int gbase = 254 * mt - 2;
    auto growf = [&](int i) -> int { if (smp) return i < 128 ? NPR + i : -1; const int g = gbase + i; return (g >= 0 && g < NPR) ? g : -1; };
    if (tid < 256) { const int gr = growf(tid); srs[tid] = gr >= 0 ? row_rstd(ssq, gr) : 0.f; }
    f32x4 acc[8][4];
    gemm_tile256(acc, xb, [&](int i) -> int { int gr = smp ? NPR + (i < 128 ? i : 127) : gbase + i; gr = gr < 0 ? 0 : (gr > NR - 1 ? NR - 1 : gr); return gr * 1024; }, W + (size_t)nt * 256 * 1024, 1024, 1024, lds, zp);
    TREFRESH(); int zE = 0; asm volatile("" : "+v"(zE));
    {
      int z0 = 0; asm volatile("" : "+v"(z0));
      bf16_t* gl = (bf16_t*)lds + z0; bf16_t* vl = gl + 256 * 136;
#pragma unroll
      for (int m = 0; m < 8; ++m) {
        const int r = (m >> 2) * 128 + wr * 64 + (m & 3) * 16 + lr + zE;
        const float rs = srs[r];
#pragma unroll
        for (int n = 0; n < 2; ++n) {
          const int ch = wc * 32 + n * 16 + lq * 4;
          uint2 og, ov;
          og.x = pack2(acc[m][n][0] * rs, acc[m][n][1] * rs); og.y = pack2(acc[m][n][2] * rs, acc[m][n][3] * rs);
          ov.x = pack2(acc[m][n + 2][0] * rs, acc[m][n + 2][1] * rs); ov.y = pack2(acc[m][n + 2][2] * rs, acc[m][n + 2][3] * rs);
          *(uint2*)(gl + r * 136 + ch) = og;
          *(uint2*)(vl + r * 136 + ch) = ov;
        }
        asm volatile("" ::: "memory");
      }
      __syncthreads();
      float wv[4][8];
      {
        const int gch0 = nt * 128 + (tid & 15) * 8;
#pragma unroll
        for (int q = 0; q < 4; ++q) {
          const float* sp = (q < 3 ? cw + q * 2816 : cb) + gch0;
          const float4 x0 = *(const float4*)sp, x1 = *(const float4*)(sp + 4);
          wv[q][0] = x0.x; wv[q][1] = x0.y; wv[q][2] = x0.z; wv[q][3] = x0.w; wv[q][4] = x1.x; wv[q][5] = x1.y; wv[q][6] = x1.z; wv[q][7] = x1.w;
        }
      }
#pragma unroll 1
      for (int it = 0; it < 8; ++it) {
        const int idx = tid + 512 * it, r = idx >> 4, c8 = (idx & 15) * 8, gch = nt * 128 + c8;
        const int g = gbase + r;
        const bool valid = smp ? (r < 128) : (r >= 2 && g < NPR);
        if (valid) {
          const int grow = smp ? NPR + r : g;
          const int b = smp ? 0 : g / TP, t = smp ? 2 : g - b * TP;
          float g0[8], g1[8], g2[8], vv[8];
          {
            const uint4 u = *(const uint4*)(gl + r * 136 + c8);
            g2[0] = lo2f(u.x); g2[1] = hi2f(u.x); g2[2] = lo2f(u.y); g2[3] = hi2f(u.y); g2[4] = lo2f(u.z); g2[5] = hi2f(u.z); g2[6] = lo2f(u.w); g2[7] = hi2f(u.w);
            const uint4 v4 = *(const uint4*)(vl + r * 136 + c8);
            vv[0] = lo2f(v4.x); vv[1] = hi2f(v4.x); vv[2] = lo2f(v4.y); vv[3] = hi2f(v4.y); vv[4] = lo2f(v4.z); vv[5] = hi2f(v4.z); vv[6] = lo2f(v4.w); vv[7] = hi2f(v4.w);
          }
          if (smp) {
            const float4 a0 = *(const float4*)(cache + (size_t)(r * 2 + 0) * 2816 + gch), a1 = *(const float4*)(cache + (size_t)(r * 2 + 0) * 2816 + gch + 4);
            const float4 b0 = *(const float4*)(cache + (size_t)(r * 2 + 1) * 2816 + gch), b1 = *(const float4*)(cache + (size_t)(r * 2 + 1) * 2816 + gch + 4);
            g0[0] = a0.x; g0[1] = a0.y; g0[2] = a0.z; g0[3] = a0.w; g0[4] = a1.x; g0[5] = a1.y; g0[6] = a1.z; g0[7] = a1.w;
            g1[0] = b0.x; g1[1] = b0.y; g1[2] = b0.z; g1[3] = b0.w; g1[4] = b1.x; g1[5] = b1.y; g1[6] = b1.z; g1[7] = b1.w;
          } else {
            uint4 u0 = make_uint4(0, 0, 0, 0), u1 = make_uint4(0, 0, 0, 0);
            if (t >= 2) u0 = *(const uint4*)(gl + (r - 2) * 136 + c8);
            if (t >= 1) u1 = *(const uint4*)(gl + (r - 1) * 136 + c8);
            g0[0] = lo2f(u0.x); g0[1] = hi2f(u0.x); g0[2] = lo2f(u0.y); g0[3] = hi2f(u0.y); g0[4] = lo2f(u0.z); g0[5] = hi2f(u0.z); g0[6] = lo2f(u0.w); g0[7] = hi2f(u0.w);
            g1[0] = lo2f(u1.x); g1[1] = hi2f(u1.x); g1[2] = lo2f(u1.y); g1[3] = hi2f(u1.y); g1[4] = lo2f(u1.z); g1[5] = hi2f(u1.z); g1[6] = lo2f(u1.w); g1[7] = hi2f(u1.w);
          }
          float ov[8];
#pragma unroll
          for (int e = 0; e < 8; ++e) ov[e] = gelu_t(wv[3][e] + wv[0][e] * g0[e] + wv[1][e] * g1[e] + wv[2][e] * g2[e]) * vv[e];
          *(uint4*)(act + (size_t)grow * 2816 + gch) = make_uint4(pack2(ov[0], ov[1]), pack2(ov[2], ov[3]), pack2(ov[4], ov[5]), pack2(ov[6], ov[7]));
          if (smp) {
            float* oc = p.out + O_FCS + (size_t)((layer * 128 + r) * 2) * 2816 + gch;
            *(float4*)oc = make_float4(g1[0], g1[1], g1[2], g1[3]); *(float4*)(oc + 4) = make_float4(g1[4], g1[5], g1[6], g1[7]);
            *(float4*)(oc + 2816) = make_float4(g2[0], g2[1], g2[2], g2[3]); *(float4*)(oc + 2820) = make_float4(g2[4], g2[5], g2[6], g2[7]);
          } else if (t >= TP - 2) {
            float* oc = p.out + O_FCP + (size_t)((layer * 8 + b) * 2 + (t - (TP - 2))) * 2816 + gch;
            *(float4*)oc = make_float4(g2[0], g2[1], g2[2], g2[3]); *(float4*)(oc + 4) = make_float4(g2[4], g2[5], g2[6], g2[7]);
          }
        }
      }
    }
    __syncthreads();
  }
}

__device__ __forceinline__ void phase_g5(const Params& p, char* lds) {
  int tid, lane, w, wr, wc, lr, lq; TREFRESH();
  const bf16_t* zp = (const bf16_t*)(p.ws + WS_ZERO);
  const bf16_t* xb = (const bf16_t*)(p.ws + WS_XB);
  const bf16_t* W = (const bf16_t*)p.out + W_IN1;
  const float* ssq = (const float*)(p.ws + WS_SSQ2) + (size_t)2 * 4 * NR;
  bf16_t* xr = (bf16_t*)(p.ws + WS_SCR + SCR_XR);
  bf16_t* gg = (bf16_t*)(p.ws + WS_SCR + SCR_GG);
  float* srs = (float*)(lds + LDS_SRS);
  if (blockIdx.x < 48) {
    const int u = blockIdx.x, nt = u >> 2, ksi = u & 3, k0 = ksi * 256;
    f32x4 acc[8][4];
    gemm_tile256(acc, xb + k0, [&](int i) { return (16384 + i) * 1024; }, W + (size_t)nt * 256 * 1024 + k0, 1024, 256, lds, zp);
    TREFRESH(); int zE = 0; asm volatile("" : "+v"(zE));
    float* slab = (float*)(p.ws + WS_SLAB) + (size_t)(nt * 4 + ksi) * 65536;
#pragma unroll
    for (int m = 0; m < 8; ++m)
#pragma unroll
      for (int n = 0; n < 4; ++n)
        *(float4*)(slab + ((m >> 2) * 128 + wr * 64 + (m & 3) * 16 + lr + zE) * 256 + (n >> 1) * 128 + wc * 32 + (n & 1) * 16 + lq * 4 + zE) = make_float4(acc[m][n][0], acc[m][n][1], acc[m][n][2], acc[m][n][3]);
    asm volatile("s_waitcnt vmcnt(0)" ::: "memory");
    __syncthreads();
    if (tid == 0) {
      __builtin_amdgcn_fence(__ATOMIC_RELEASE, "agent");
      asm volatile("s_waitcnt vmcnt(0)" ::: "memory");
      (void)xb_add((unsigned*)(p.ws + WS_FLAG) + 4416 + nt, 1u);
    }
  }
  TileSched ts; ts.init(64, 12);
  for (int ti = ts.local; ti < ts.ntiles; ti += ts.nloc) {
    int mt, nt; ts.get(ti, mt, nt);
    if (tid < 256) srs[tid] = row_rstd(ssq, mt * 256 + tid);
    f32x4 acc[8][4];
    gemm_tile256(acc, xb, [&](int i) { return (mt * 256 + i) * 1024; }, W + (size_t)nt * 256 * 1024, 1024, 1024, lds, zp);
    TREFRESH(); int zE = 0; asm volatile("" : "+v"(zE));
#pragma unroll
    for (int m = 0; m < 8; ++m) {
      const int r = (m >> 2) * 128 + wr * 64 + (m & 3) * 16 + lr + zE, row = mt * 256 + r;
      const float rs = srs[r];
#pragma unroll
      for (int n = 0; n < 4; ++n) {
        const int col = nt * 256 + (n >> 1) * 128 + wc * 32 + (n & 1) * 16 + lq * 4 + zE;
        const f32x4 v = acc[m][n] * rs;
        uint2 o;
        if (nt < 6) {
          o.x = pack2(gelu_t(v[0]), gelu_t(v[1])); o.y = pack2(gelu_t(v[2]), gelu_t(v[3]));
          *(uint2*)(gg + (size_t)row * 1536 + col) = o;
        } else {
          o.x = pack2(v[0], v[1]); o.y = pack2(v[2], v[3]);
          *(uint2*)(xr + (size_t)row * 1536 + (col - 1536)) = o;
        }
      }
    }
    __syncthreads();
  }
  if (blockIdx.x < 48) {
    const int u = blockIdx.x, nt = u >> 2, ksi = u & 3;
    if (tid == 0) {
      XB_SPIN(xb_ld((unsigned*)(p.ws + WS_FLAG) + 4416 + nt) < 4u, (unsigned*)(p.ws + WS_BAR));
      __builtin_amdgcn_fence(__ATOMIC_ACQUIRE, "agent");
      asm volatile("s_waitcnt vmcnt(0)" ::: "memory");
    }
    __syncthreads();
    const float* sl = (const float*)(p.ws + WS_SLAB) + (size_t)(nt * 4) * 65536;
    for (int rr = ksi * 64 + (tid >> 6); rr < ksi * 64 + 64; rr += 8) {
      const int c4 = tid & 63, row = 16384 + rr, col = nt * 256 + c4 * 4;
      const float* s4 = sl + rr * 256 + c4 * 4;
      const float4 s0 = *(const float4*)s4, s1 = *(const float4*)(s4 + 65536), s2 = *(const float4*)(s4 + 131072), s3 = *(const float4*)(s4 + 196608);
      const float rs = row_rstd(ssq, row);
      const float v0 = ((s0.x + s1.x) + (s2.x + s3.x)) * rs, v1 = ((s0.y + s1.y) + (s2.y + s3.y)) * rs;
      const float v2 = ((s0.z + s1.z) + (s2.z + s3.z)) * rs, v3 = ((s0.w + s1.w) + (s2.w + s3.w)) * rs;
      uint2 o;
      if (nt < 6) {
        o.x = pack2(gelu_t(v0), gelu_t(v1)); o.y = pack2(gelu_t(v2), gelu_t(v3));
        *(uint2*)(gg + (size_t)row * 1536 + col) = o;
      } else {
        o.x = pack2(v0, v1); o.y = pack2(v2, v3);
        *(uint2*)(xr + (size_t)row * 1536 + (col - 1536)) = o;
      }
    }
  }
}

__device__ __forceinline__ void rglru_item(const Params& p, int item, char* lds) {
  const int tid = threadIdx.x & 255, lane = tid & 63, w = tid >> 6, lr = lane & 15, lq = lane >> 4;
  const bool smp = item >= 4352;
  const int pass = 1;
  int b, tl, n, half;
  if (smp) { const int it = item - 4352; b = 0; tl = 0; n = it >> 1; half = it & 1; }
  else { tl = item >> 8; const int chain = item & 255; b = chain >> 5; n = (chain >> 1) & 15; half = chain & 1; }
  unsigned* flags = (unsigned*)(p.ws + WS_FLAG);
  unsigned* barw = (unsigned*)(p.ws + WS_BAR);
  const bf16_t* xr = (const bf16_t*)(p.ws + WS_SCR + SCR_XR);
  bf16_t* gg = (bf16_t*)(p.ws + WS_SCR + SCR_GG);
  const bf16_t* Wg = (const bf16_t*)p.out + W_GATE;
  const bf16_t* zp = (const bf16_t*)(p.ws + WS_ZERO);
  float* carr = (float*)(p.ws + WS_XLOC);
  char* At = lds; char* Ba = lds + 26624; char* Bx = lds + 36608;
  char* xs = lds + 46592;
  float* sa = (float*)lds; float* sbx = (float*)(lds + 24576);
  float* segA = (float*)(lds + 49152); float* segH = (float*)(lds + 49920); float* carry = (float*)(lds + 50688);
  char* ggl = lds + 51200;
  float* par = (float*)(lds + 71744);
  const int t0 = tl * 128;
  const int nvalid = smp ? 128 : (TP - t0 < 128 ? TP - t0 : 128);
  if (tid < 156) {
    const float* src;
    const int q = tid;
    if (q < 96) { const int wt = q / 24; src = p.in[27] + wt * 1536 + n * 96 + (q - wt * 24) * 4; }
    else if (q < 120) src = p.in[28] + n * 96 + (q - 96) * 4;
    else if (q < 132) src = p.in[30] + n * 96 + half * 48 + (q - 120) * 4;
    else if (q < 144) src = p.in[32] + n * 96 + half * 48 + (q - 132) * 4;
    else src = (const float*)(p.ws + WS_NSP) + n * 96 + half * 48 + (q - 144) * 4;
    __builtin_amdgcn_global_load_lds((const unsigned*)src, (unsigned*)((char*)par + q * 16), 16, 0, 0);
  }
  for (int q = tid; q < 1248; q += 256) {
    const int mat = q >= 624 ? 1 : 0, q2 = q - mat * 624, d = q2 / 13, ch = q2 - d * 13;
    const bf16_t* src = Wg + (size_t)((mat * 16 + n) * 96 + half * 48 + d) * 96 + (ch < 12 ? ch : 0) * 8;
    __builtin_amdgcn_global_load_lds((const unsigned*)src, (unsigned*)(Ba + q * 16), 16, 0, 0);
  }
  if (!smp) {
    for (int q = tid; q < 1572; q += 256) {
      const int r = q / 12, ch = q - r * 12, t = t0 + r - 3;
      const bf16_t* src = (t >= 0 && t < TP) ? xr + (size_t)(b * TP + t) * 1536 + n * 96 + ch * 8 : zp;
      __builtin_amdgcn_global_load_lds((const unsigned*)src, (unsigned*)(xs + q * 16), 16, 0, 0);
    }
  }
  asm volatile("s_waitcnt vmcnt(0)" ::: "memory");
  __syncthreads();
#pragma unroll 2
  for (int i = 0; i < 6; ++i) {
    const int idx = tid + 256 * i, r = idx / 12, ch8 = idx - r * 12, c0 = n * 96 + ch8 * 8;
    float xc[8];
    if (r < nvalid) {
      const float4 b0 = *(const float4*)(par + 384 + ch8 * 8), b1 = *(const float4*)(par + 384 + ch8 * 8 + 4);
      xc[0] = b0.x; xc[1] = b0.y; xc[2] = b0.z; xc[3] = b0.w; xc[4] = b1.x; xc[5] = b1.y; xc[6] = b1.z; xc[7] = b1.w;
#pragma unroll
      for (int wt = 0; wt < 4; ++wt) {
        float xv[8];
        if (smp && wt < 3) {
          const float4 a0 = *(const float4*)(p.in[6] + (size_t)(r * 3 + wt) * 1536 + c0), a1 = *(const float4*)(p.in[6] + (size_t)(r * 3 + wt) * 1536 + c0 + 4);
          xv[0] = a0.x; xv[1] = a0.y; xv[2] = a0.z; xv[3] = a0.w; xv[4] = a1.x; xv[5] = a1.y; xv[6] = a1.z; xv[7] = a1.w;
        } else {
          uint4 u;
          if (smp) u = *(const uint4*)(xr + (size_t)(NPR + r) * 1536 + c0);
          else u = *(const uint4*)(xs + (r + wt) * 192 + ch8 * 16);
          xv[0] = lo2f(u.x); xv[1] = hi2f(u.x); xv[2] = lo2f(u.y); xv[3] = hi2f(u.y); xv[4] = lo2f(u.z); xv[5] = hi2f(u.z); xv[6] = lo2f(u.w); xv[7] = hi2f(u.w);
        }
        const float4 w0 = *(const float4*)(par + wt * 96 + ch8 * 8), w1 = *(const float4*)(par + wt * 96 + ch8 * 8 + 4);
        xc[0] += w0.x * xv[0]; xc[1] += w0.y * xv[1]; xc[2] += w0.z * xv[2]; xc[3] += w0.w * xv[3];
        xc[4] += w1.x * xv[4]; xc[5] += w1.y * xv[5]; xc[6] += w1.z * xv[6]; xc[7] += w1.w * xv[7];
      }
    } else {
#pragma unroll
      for (int e = 0; e < 8; ++e) xc[e] = 0.f;
    }
    *(uint4*)(At + r * 208 + ch8 * 16) = make_uint4(pack2(xc[0], xc[1]), pack2(xc[2], xc[3]), pack2(xc[4], xc[5]), pack2(xc[6], xc[7]));
  }
  __syncthreads();
  if (pass == 1 && !smp) {
    for (int q = tid; q < 768; q += 256) {
      const int r = q / 6, c = q - r * 6;
      const bf16_t* src = r < nvalid ? gg + (size_t)(b * TP + t0 + r) * 1536 + n * 96 + half * 48 + c * 8 : zp;
      __builtin_amdgcn_global_load_lds((const unsigned*)src, (unsigned*)(ggl + q * 16), 16, 0, 0);
    }
  }
  f32x4 aa[2][3], ax[2][3];
#pragma unroll
  for (int m = 0; m < 2; ++m)
#pragma unroll
    for (int q = 0; q < 3; ++q) { aa[m][q] = (f32x4){0.f, 0.f, 0.f, 0.f}; ax[m][q] = (f32x4){0.f, 0.f, 0.f, 0.f}; }
#pragma unroll
  for (int s2 = 0; s2 < 3; ++s2) {
    bf16x8 a[2];
#pragma unroll
    for (int m = 0; m < 2; ++m) a[m] = *(const bf16x8*)(At + (32 * w + 16 * m + lr) * 208 + (s2 * 4 + lq) * 16);
#pragma unroll
    for (int q = 0; q < 3; ++q) {
      const bf16x8 ba = *(const bf16x8*)(Ba + (16 * q + lr) * 208 + (s2 * 4 + lq) * 16);
      const bf16x8 bx = *(const bf16x8*)(Bx + (16 * q + lr) * 208 + (s2 * 4 + lq) * 16);
#pragma unroll
      for (int m = 0; m < 2; ++m) { aa[m][q] = mfma16(ba, a[m], aa[m][q]); ax[m][q] = mfma16(bx, a[m], ax[m][q]); }
    }
  }
  uint2 xcv[2][3];
#pragma unroll
  for (int m = 0; m < 2; ++m)
#pragma unroll
    for (int q = 0; q < 3; ++q) xcv[m][q] = *(const uint2*)(At + (32 * w + 16 * m + lr) * 208 + (half * 48 + 16 * q + lq * 4) * 2);
  float4 pba[3], pbx[3], plm[3];
#pragma unroll
  for (int q = 0; q < 3; ++q) {
    pba[q] = *(const float4*)(par + 480 + 16 * q + lq * 4);
    pbx[q] = *(const float4*)(par + 528 + 16 * q + lq * 4);
    plm[q] = *(const float4*)(par + 576 + 16 * q + lq * 4);
  }
  __syncthreads();
#pragma unroll
  for (int m = 0; m < 2; ++m) {
    const int row = 32 * w + 16 * m + lr;
#pragma unroll
    for (int q = 0; q < 3; ++q) {
      const int d0 = 16 * q + lq * 4;
      const float bav[4] = {pba[q].x, pba[q].y, pba[q].z, pba[q].w}, bxv[4] = {pbx[q].x, pbx[q].y, pbx[q].z, pbx[q].w}, lmv[4] = {plm[q].x, plm[q].y, plm[q].z, plm[q].w};
      const float xcf[4] = {lo2f(xcv[m][q].x), hi2f(xcv[m][q].x), lo2f(xcv[m][q].y), hi2f(xcv[m][q].y)};
      float av[4], bv[4];
#pragma unroll
      for (int e = 0; e < 4; ++e) {
        const float r_ = sigm(aa[m][q][e] + bav[e]);
        const float i_ = sigm(ax[m][q][e] + bxv[e]);
        const float la = r_ * lmv[e];
        float a = __expf(la);
        float bxx = __builtin_sqrtf(fmaxf(1.f - a * a, 0.f)) * (i_ * xcf[e]);
        if (row >= nvalid) { a = 1.f; bxx = 0.f; }
        av[e] = a; bv[e] = bxx;
      }
      *(float4*)(sa + row * 48 + d0) = make_float4(av[0], av[1], av[2], av[3]);
      *(float4*)(sbx + row * 48 + d0) = make_float4(bv[0], bv[1], bv[2], bv[3]);
    }
  }
  __syncthreads();
  if (smp) {
    for (int idx = tid; idx < 128 * 48; idx += 256) {
      const int row = idx / 48, ch = idx - row * 48, cgl = n * 96 + half * 48 + ch;
      const float hh = sa[idx] * p.in[5][row * 1536 + cgl] + sbx[idx];
      p.out[O_HS + row * 1536 + cgl] = hh;
      const size_t go = (size_t)(NPR + row) * 1536 + cgl;
      gg[go] = f2bf(hh * bf2f(gg[go]));
    }
  } else {
    const int ch = tid % 48, seg = tid / 48;
    if (tid < 192) {
      float A = 1.f, H = 0.f;
#pragma unroll 8
      for (int r = seg * 32; r < seg * 32 + 32; ++r) { const float a = sa[r * 48 + ch]; H = a * H + sbx[r * 48 + ch]; A *= a; }
      segA[seg * 48 + ch] = A; segH[seg * 48 + ch] = H;
    }
    asm volatile("s_waitcnt vmcnt(0)" ::: "memory");
    __syncthreads();
    {
      float At_ = 1.f, Ht_ = 0.f;
      if (tid < 48) {
#pragma unroll
        for (int s2 = 0; s2 < 4; ++s2) { Ht_ = segA[s2 * 48 + tid] * Ht_ + segH[s2 * 48 + tid]; At_ *= segA[s2 * 48 + tid]; }
      }
      if (tl > 0 && tid == 0) XB_SPIN(xb_ld(&flags[item - 256]) == 0u, barw);
      __syncthreads();
      if (tid < 48) {
        const int cgl = n * 96 + half * 48 + tid;
        float h0 = 0.f;
        if (tl > 0) h0 = __hip_atomic_load(&carr[(size_t)((b * 17 + tl - 1) * 32 + n * 2 + half) * 64 + tid], __ATOMIC_RELAXED, __HIP_MEMORY_SCOPE_AGENT);
        carry[tid] = h0;
        const float hend = At_ * h0 + Ht_;
        if (tl < 16) __hip_atomic_store(&carr[(size_t)((b * 17 + tl) * 32 + n * 2 + half) * 64 + tid], hend, __ATOMIC_RELAXED, __HIP_MEMORY_SCOPE_AGENT);
        else p.out[O_HP + b * 1536 + cgl] = hend;
      }
      asm volatile("s_waitcnt vmcnt(0)" ::: "memory");
      __syncthreads();
      if (tid == 0 && tl < 16) (void)xb_add(&flags[item], 1u);
    }
    if (tid < 192) {
      float hin = carry[ch];
      for (int s2 = 0; s2 < seg; ++s2) hin = segA[s2 * 48 + ch] * hin + segH[s2 * 48 + ch];
      const int cgl = n * 96 + half * 48 + ch;
#pragma unroll 8
      for (int r = seg * 32; r < seg * 32 + 32; ++r) {
        hin = sa[r * 48 + ch] * hin + sbx[r * 48 + ch];
        if (r < nvalid) gg[(size_t)(b * TP + t0 + r) * 1536 + cgl] = f2bf(hin * bf2f(*(const bf16_t*)(ggl + r * 96 + ch * 2)));
      }
    }
  }
  if (pass == 1) {
    if (!smp) {
      if (tl == 16 && half == 0 && tid < 96) {
#pragma unroll
        for (int wv = 0; wv < 3; ++wv) p.out[O_RCP + (b * 3 + wv) * 1536 + n * 96 + tid] = bf2f(xr[(size_t)(b * TP + TP - 3 + wv) * 1536 + n * 96 + tid]);
      }
    } else if (half == 0) {
      for (int idx = tid; idx < 128 * 96; idx += 256) {
        const int s2 = idx / 96, cc_ = idx - s2 * 96, cgl = n * 96 + cc_;
        p.out[O_RCS + (size_t)(s2 * 3 + 0) * 1536 + cgl] = p.in[6][(size_t)(s2 * 3 + 1) * 1536 + cgl];
        p.out[O_RCS + (size_t)(s2 * 3 + 1) * 1536 + cgl] = p.in[6][(size_t)(s2 * 3 + 2) * 1536 + cgl];
        p.out[O_RCS + (size_t)(s2 * 3 + 2) * 1536 + cgl] = bf2f(xr[(size_t)(NPR + s2) * 1536 + cgl]);
      }
    }
  }
  __syncthreads();
}

__device__ __forceinline__ void phase_final(const Params& p) {
  const int tid = threadIdx.x, lane = tid & 63;
  const bf16_t* xres = (const bf16_t*)(p.ws + WS_XB);
  const float* ssq = (const float*)(p.ws + WS_SSQ2);
  const int gw = blockIdx.x * 8 + (tid >> 6), nw = gridDim.x * 8;
  for (int r = gw; r < NR; r += nw) {
    float* dst;
    if (r >= NPR) dst = p.out + O_YS + (size_t)(r - NPR) * 1024;
    else { const int b = r / TP, t = r - b * TP; if (t < 16) continue; dst = p.out + O_YP + ((size_t)b * 2048 + (t - 16)) * 1024; }
    float s = lane < 4 ? ssq[(size_t)lane * NR + r] : 0.f;
    s = wave_sum(s);
    const float rstd = rsqrtf(s * (1.f / 1024.f) + EPSN);
    const uint2* src = (const uint2*)(xres + (size_t)r * 1024);
    const float4* nf = (const float4*)p.in[40];
#pragma unroll
    for (int j = 0; j < 4; ++j) {
      const uint2 u = src[lane + 64 * j];
      const float4 v = make_float4(lo2f(u.x), hi2f(u.x), lo2f(u.y), hi2f(u.y)), g = nf[lane + 64 * j];
      ((float4*)dst)[lane + 64 * j] = make_float4(v.x * rstd * g.x, v.y * rstd * g.y, v.z * rstd * g.z, v.w * rstd * g.w);
    }
  }
}

__global__ void __launch_bounds__(512, 2) mega_kernel(Params p) {
  extern __shared__ __attribute__((aligned(16))) char lds[];
  cg::grid_group grid = cg::this_grid();
  const bf16_t* wb = (const bf16_t*)p.out;
  volatile LAS unsigned* xst_ = (volatile LAS unsigned*)(lds + LDS_ST);
  if (threadIdx.x < 4) xst_[threadIdx.x] = 0u;
  __syncthreads();
  XcdBarrier xbar = xcd_barrier_post((unsigned*)(p.ws + WS_BAR), xst_);
  if (p.ph_hi > 1000) grid.sync();
#define PH(k, body) if (p.ph_lo <= (k) && (k) < p.ph_hi) { body; } if (p.ph_lo <= (k) && (k) + 1 < p.ph_hi) xcd_barrier(xbar);
  PH(0, phase_prep(p, lds))
  PH(1, phase_g1(p, lds))
  PH(2, phase_mix_a(p, lds))
  PH(3, phase_mix_b(p))
  PH(4, phase_mix_c(p, lds))
  PH(5, phase_glu(p, lds))
  PH(6, phase_resid(p, lds, (const bf16_t*)(p.ws + WS_SCR + SCR_ZB) + 512, 2048, wb + W_OUT0, 1024, 0, 1))
  PH(7, phase_ffn_up(p, lds, 0, 1))
  PH(8, phase_resid(p, lds, (const bf16_t*)(p.ws + WS_SCR + SCR_ACT), 2816, wb + W_DOWN, 2816, 16, 2))
  PH(9, phase_g5(p, lds))
  PH(10, for (int pr = blockIdx.x; pr < 2192; pr += gridDim.x) rglru_item(p, pr * 2 + (threadIdx.x >> 8), lds + (threadIdx.x >> 8) * HALF_LDS))
  PH(11, phase_resid(p, lds, (const bf16_t*)(p.ws + WS_SCR + SCR_GG), 1536, wb + W_OUT1, 1536, 32, 3))
  PH(12, phase_ffn_up(p, lds, 1, 3))
  PH(13, phase_resid(p, lds, (const bf16_t*)(p.ws + WS_SCR + SCR_ACT), 2816, wb + W_DOWN + (size_t)1024 * 2816, 2816, 48, 0))
  PH(14, phase_final(p))
}

extern "C" void kernel_launch(void* const* d_in, const int* in_sizes, int n_in, void* d_out, int out_size, void* d_ws, size_t ws_size, hipStream_t stream) {
  static int grid_blocks = 0;
  if (!grid_blocks) {
    int dev = 0, cus = 0, per_cu = 0;
    hipGetDevice(&dev);
    hipDeviceGetAttribute(&cus, hipDeviceAttributeMultiprocessorCount, dev);
    hipFuncSetAttribute((const void*)mega_kernel, hipFuncAttributeMaxDynamicSharedMemorySize, LDS_BYTES);
    hipOccupancyMaxActiveBlocksPerMultiprocessor(&per_cu, (const void*)mega_kernel, NTHR, LDS_BYTES);
    if (per_cu > 1) per_cu = 1;
    if (per_cu < 1) per_cu = 1;
    grid_blocks = cus * per_cu;
    if (n_in != 41 || ws_size < WS_NEED) fprintf(stderr, "kernel_launch: unexpected n_in %d or ws_size %zu (need %llu)\n", n_in, ws_size, (unsigned long long)WS_NEED);
  }
  Params p{};
  for (int i = 0; i < 41; ++i) p.in[i] = (const float*)d_in[i];
  p.out = (float*)d_out;
  p.ws = (char*)d_ws;
  (void)hipMemsetAsync((char*)d_ws + WS_BAR, 0, 16384, stream);
  (void)hipMemsetAsync((char*)d_ws + WS_FLAG, 0, 20480, stream);
#if MK_MULTI
  for (int ph = 0; ph < NPHASE; ++ph) {
    p.ph_lo = ph; p.ph_hi = ph + 1;
    hipLaunchKernelGGL(mega_kernel, dim3(grid_blocks), dim3(NTHR), LDS_BYTES, stream, p);
  }
#else
  p.ph_lo = 0; p.ph_hi = NPHASE;
  void* args[] = {&p};
  hipError_t e = hipLaunchCooperativeKernel((const void*)mega_kernel, dim3(grid_blocks), dim3(NTHR), args, LDS_BYTES, stream);
  if (e != hipSuccess) fprintf(stderr, "cooperative launch failed: %s (grid %d)\n", hipGetErrorString(e), grid_blocks);
#endif
}
```

```cpp
#include <hip/hip_runtime.h>
#include <hip/hip_cooperative_groups.h>
#include <stdint.h>
#include <stdio.h>
namespace cg = cooperative_groups;

#ifndef MK_MULTI
#define MK_MULTI 0
#endif

#define LAS __attribute__((address_space(3)))
typedef unsigned short bf16_t;
typedef __attribute__((ext_vector_type(8))) short bf16x8;
typedef __attribute__((ext_vector_type(4))) float f32x4;

#define TP 2064
#define NPR 16512
#define NR 16640
#define EPSN 1e-6f
#define NPHASE 15
#define LDS_BYTES 153600
#define HALF_LDS 75776
#define LDS_SRS 151552
#define LDS_ST 152576
#define LDS_TKL 152592
#define NTHR 512

#define O_YP 0
#define O_YS 16777216
#define O_GLAP 16908288
#define O_GLAS 17170432
#define O_S5RP 21364736
#define O_S5RS 21381120
#define O_S5IP 21643264
#define O_S5IS 21659648
#define O_HP 21921792
#define O_HS 21934080
#define O_RCP 22130688
#define O_RCS 22167552
#define O_FCP 22757376
#define O_FCS 22847488

#define W_IN0 0
#define W_GLU 2359296
#define W_OUT0 2621440
#define W_UP 3670016
#define W_DOWN 15204352
#define W_IN1 20971520
#define W_OUT1 24117248
#define W_GATE 25690112

#define WS_XB 0ull
#define WS_XRES 34078720ull
#define WS_SSQ 102236160ull
#define WS_S5AB 106496000ull
#define WS_S5BB 106545152ull
#define WS_S5CC 106807296ull
#define WS_XLOC 106938368ull
#define WS_XST 111263744ull
#define WS_DEC 115589120ull
#define WS_SCR 115859456ull
#define SCR_ZB 0ull
#define SCR_ALOG 68157440ull
#define SCR_SLOC 85196800ull
#define SCR_ACT 0ull
#define SCR_XR 0ull
#define SCR_GG 51118080ull
#define WS_BAR (WS_SCR + 119799808ull)
#define WS_ZERO (WS_BAR + 15360ull)
#define WS_NSP (WS_BAR + 16384ull)
#define WS_SLAB (WS_NSP + 8192ull)
#define WS_FLAG (WS_SLAB + 12582912ull)
#define WS_SSQ2 (WS_FLAG + 20480ull)
#define WS_NEED (WS_SSQ2 + 8519680ull)

struct Params {
  const float* in[41];
  float* out;
  char* ws;
  int ph_lo, ph_hi;
};

__device__ __forceinline__ bf16_t f2bf(float f) { uint32_t u = __float_as_uint(f); u += 0x7fffu + ((u >> 16) & 1u); return (bf16_t)(u >> 16); }
__device__ __forceinline__ float bf2f(bf16_t h) { return __uint_as_float(((uint32_t)h) << 16); }
__device__ __forceinline__ uint32_t pack2(float a, float b) { uint32_t r; asm("v_cvt_pk_bf16_f32 %0, %1, %2" : "=v"(r) : "v"(a), "v"(b)); return r; }
__device__ __forceinline__ uint32_t pack2_sw(float a, float b) { return (uint32_t)f2bf(a) | ((uint32_t)f2bf(b) << 16); }
__device__ __forceinline__ float lo2f(uint32_t u) { return __uint_as_float(u << 16); }
__device__ __forceinline__ float hi2f(uint32_t u) { return __uint_as_float(u & 0xffff0000u); }
__device__ __forceinline__ float sigm(float x) { return __builtin_amdgcn_rcpf(1.f + __expf(-x)); }
__device__ __forceinline__ float gelu_t(float x) { const float u = x * (1.5957691216f + 0.0713548162726f * x * x); return x * __builtin_amdgcn_rcpf(1.f + __expf(-u)); }
__device__ __forceinline__ float softplusf_(float x) { return fmaxf(x, 0.f) + __logf(1.f + __expf(-fabsf(x))); }
__device__ __forceinline__ float wave_sum(float v) {
#pragma unroll
  for (int o = 1; o < 64; o <<= 1) v += __shfl_xor(v, o);
  return v;
}
__device__ __forceinline__ int toff(int row, int chunk) { return row * 128 + ((chunk ^ (row & 7)) << 4); }
__device__ __forceinline__ f32x4 mfma16(bf16x8 a, bf16x8 b, f32x4 c) { return __builtin_amdgcn_mfma_f32_16x16x32_bf16(a, b, c, 0, 0, 0); }

__device__ __forceinline__ const float* xrow_src(const Params& p, int r) {
  if (r >= NPR) return p.in[1] + (size_t)(r - NPR) * 1024;
  int b = r / TP, t = r - b * TP;
  return t < 16 ? p.in[8] + t * 1024 : p.in[0] + ((size_t)b * 2048 + (t - 16)) * 1024;
}

#define TREFRESH() do { tid = threadIdx.x; asm volatile("" : "+v"(tid)); lane = tid & 63; w = tid >> 6; wr = w >> 2; wc = w & 3; lr = lane & 15; lq = lane >> 4; (void)w; (void)lane; } while (0)
__device__ __forceinline__ int lds_byte8(int r, int c) { const int st = (r >> 4) * 2 + (c >> 5), rr = r & 15, cc = c & 31, ob = rr * 64 + cc * 2; return st * 1024 + (ob ^ (((ob >> 9) & 1) << 5)); }
__device__ __forceinline__ void stage_rc8(int b, int& R, int& C) { const int st = b / 1024, sb = b % 1024, swz = sb ^ (((sb >> 9) & 1) << 5); R = (st >> 1) * 16 + swz / 64; C = (st & 1) * 32 + (swz % 64) / 2; }
template <class AF>
__device__ __forceinline__ void gemm_tile256(f32x4 (&acc)[8][4], const bf16_t* Ab, AF arow, const bf16_t* Bt, int ldb, int K, char* lds, const bf16_t* zpage) {
  const int wid = threadIdx.x >> 6, lane = threadIdx.x & 63, wr = wid >> 2, wc = wid & 3, fr = lane & 15, fq = lane >> 4;
#pragma unroll
  for (int m = 0; m < 8; ++m)
#pragma unroll
    for (int n = 0; n < 4; ++n) acc[m][n] = (f32x4){0.f, 0.f, 0.f, 0.f};
  int ao[2][2], bo[2][2];
#pragma unroll
  for (int i = 0; i < 2; ++i) {
    int r_, c_; stage_rc8(threadIdx.x * 16 + i * 8192, r_, c_);
#pragma unroll
    for (int h = 0; h < 2; ++h) {
      const int a = arow(h * 128 + r_);
      ao[h][i] = (a + c_) * 2;
      bo[h][i] = ((h * 128 + r_) * ldb + c_) * 2;
      asm volatile("" : "+v"(ao[h][i]), "+v"(bo[h][i]));
    }
  }
  char* lth = lds + threadIdx.x * 16;
  const __amdgpu_buffer_rsrc_t rA = __builtin_amdgcn_make_buffer_rsrc((void*)const_cast<bf16_t*>(Ab), (short)0, 0x7fffffff, 0x00020000);
  const __amdgpu_buffer_rsrc_t rB = __builtin_amdgcn_make_buffer_rsrc((void*)const_cast<bf16_t*>(Bt), (short)0, 0x7fffffff, 0x00020000);
#define SA8(b, h) (((b) * 2 + (h)) * 16384)
#define SB8(b, h) ((4 + (b) * 2 + (h)) * 16384)
#define STG_A(P, h, kt) do { _Pragma("unroll") for (int i_ = 0; i_ < 2; ++i_) \
    __builtin_amdgcn_raw_ptr_buffer_load_lds(rA, (LAS void*)(lth + (P) + i_ * 8192), 16, ao[h][i_], (kt) * 128, 0, 0); } while (0)
#define STG_B(P, h, kt) do { _Pragma("unroll") for (int i_ = 0; i_ < 2; ++i_) \
    __builtin_amdgcn_raw_ptr_buffer_load_lds(rB, (LAS void*)(lth + (P) + i_ * 8192), 16, bo[h][i_], (kt) * 128, 0, 0); } while (0)
#define LDA8(dst, b, h) do { _Pragma("unroll") for (int m = 0; m < 4; ++m) _Pragma("unroll") for (int k = 0; k < 2; ++k) \
    dst[m][k] = *(const bf16x8*)(lds + SA8(b, h) + lds_byte8(wr * 64 + m * 16 + fr, k * 32 + fq * 8)); } while (0)
#define LDB8(dst, b, h) do { _Pragma("unroll") for (int n = 0; n < 2; ++n) _Pragma("unroll") for (int k = 0; k < 2; ++k) \
    dst[n][k] = *(const bf16x8*)(lds + SB8(b, h) + lds_byte8(wc * 32 + n * 16 + fr, k * 32 + fq * 8)); } while (0)
#define MMA8(ai, bj, Ax, Bx) do { __builtin_amdgcn_s_setprio(1); \
    _Pragma("unroll") for (int m = 0; m < 4; ++m) _Pragma("unroll") for (int n = 0; n < 2; ++n) _Pragma("unroll") for (int k = 0; k < 2; ++k) \
      acc[(ai) * 4 + m][(bj) * 2 + n] = mfma16(Bx[n][k], Ax[m][k], acc[(ai) * 4 + m][(bj) * 2 + n]); \
    __builtin_amdgcn_s_setprio(0); } while (0)
#define WAIT_V(n) asm volatile("s_waitcnt vmcnt(" #n ")" ::: "memory")
#define WAIT_L(n) asm volatile("s_waitcnt lgkmcnt(" #n ")" ::: "memory")
#define BAR8 __builtin_amdgcn_s_barrier()
#define SCHED8 __builtin_amdgcn_sched_barrier(0)
  bf16x8 At[4][2], B0[2][2], B1[2][2];
  const int nt = K >> 6;
  STG_B(SB8(0, 0), 0, 0); STG_A(SA8(0, 0), 0, 0);
  STG_B(SB8(0, 1), 1, 0); STG_A(SA8(0, 1), 1, 0);
  if (wr == 1) BAR8;
  WAIT_V(4); BAR8;
  STG_B(SB8(1, 0), 0, 1); STG_A(SA8(1, 0), 0, 1); STG_B(SB8(1, 1), 1, 1);
  WAIT_V(6); BAR8;
  for (int t = 0; t < nt - 2; t += 2) {
    LDB8(B0, 0, 0); SCHED8; LDA8(At, 0, 0); STG_A(SA8(1, 1), 1, t + 1);
    WAIT_L(8); BAR8; WAIT_L(0); MMA8(0, 0, At, B0); BAR8; SCHED8;
    LDB8(B1, 0, 1); STG_B(SB8(0, 0), 0, t + 2);
    BAR8; WAIT_L(0); MMA8(0, 1, At, B1); BAR8;
    LDA8(At, 0, 1); STG_A(SA8(0, 0), 0, t + 2);
    BAR8; WAIT_L(0); MMA8(1, 0, At, B0); BAR8; SCHED8;
    STG_B(SB8(0, 1), 1, t + 2);
    WAIT_V(6); BAR8; MMA8(1, 1, At, B1); BAR8;
    LDB8(B0, 1, 0); SCHED8; LDA8(At, 1, 0); STG_A(SA8(0, 1), 1, t + 2);
    WAIT_L(8); BAR8; WAIT_L(0); MMA8(0, 0, At, B0); BAR8; SCHED8;
    LDB8(B1, 1, 1); STG_B(SB8(1, 0), 0, t + 3);
    BAR8; WAIT_L(0); MMA8(0, 1, At, B1); BAR8;
    LDA8(At, 1, 1); STG_A(SA8(1, 0), 0, t + 3);
    BAR8; WAIT_L(0); MMA8(1, 0, At, B0); BAR8; SCHED8;
    STG_B(SB8(1, 1), 1, t + 3);
    WAIT_V(6); BAR8; MMA8(1, 1, At, B1); BAR8;
  }
  { LDB8(B0, 0, 0); LDA8(At, 0, 0); STG_A(SA8(1, 1), 1, nt - 1);
    BAR8; WAIT_L(0); MMA8(0, 0, At, B0); BAR8;
    LDB8(B1, 0, 1); BAR8; WAIT_L(0); MMA8(0, 1, At, B1); BAR8;
    LDA8(At, 0, 1); WAIT_V(4); BAR8; WAIT_L(0); MMA8(1, 0, At, B0); MMA8(1, 1, At, B1); BAR8; }
  { LDB8(B0, 1, 0); LDA8(At, 1, 0); WAIT_V(2); BAR8; WAIT_L(0); MMA8(0, 0, At, B0); BAR8;
    LDB8(B1, 1, 1); WAIT_V(0); BAR8; WAIT_L(0); MMA8(0, 1, At, B1); BAR8;
    LDA8(At, 1, 1); BAR8; WAIT_L(0); MMA8(1, 0, At, B0); MMA8(1, 1, At, B1); BAR8; }
  if (wr == 0) BAR8;
#undef SA8
#undef SB8
#undef STG_A
#undef STG_B
#undef LDA8
#undef LDB8
#undef MMA8
  __syncthreads();
}

#define XB_TMO      128
#define XB_XCNT(j)  (256  + 64 * (j))
#define XB_XSUB(j)  (1280 + 64 * (j))
#define XB_XGEN(j)  (2304 + 64 * (j))
#define XB_TOP      3328
#define XB_TOPGEN   3392
#define XCD_BAR_WORDS 3456
#define XB_SPIN_CAP (1u << 22)
__device__ __forceinline__ unsigned xb_ld(unsigned* p)              { return __hip_atomic_load(p, __ATOMIC_RELAXED, __HIP_MEMORY_SCOPE_AGENT); }
__device__ __forceinline__ unsigned xb_add(unsigned* p, unsigned v) { return __hip_atomic_fetch_add(p, v, __ATOMIC_RELAXED, __HIP_MEMORY_SCOPE_AGENT); }
__device__ __forceinline__ unsigned xb_xcc_id() { return (unsigned)__builtin_amdgcn_s_getreg((3 << 11) | 20) & 0xFu; }
#define XB_SPIN(cond, bar) do { unsigned _sp = 0; while (cond) { __builtin_amdgcn_s_sleep(1); \
    if ((++_sp & 255u) == 0u) { if (xb_ld(&(bar)[XB_TMO])) break; if (_sp > XB_SPIN_CAP) { atomicAdd(&(bar)[XB_TMO], 1u); break; } } } } while (0)
struct XcdBarrier { unsigned* bar; unsigned x; volatile LAS unsigned* st; };
__device__ __forceinline__ XcdBarrier xcd_barrier_post(unsigned* bar, volatile LAS unsigned* st) {
    XcdBarrier b; b.bar = bar; b.x = xb_xcc_id(); b.st = st;
    if (threadIdx.x == 0) (void)xb_add(&bar[XB_XCNT(b.x)], 1u);
    return b;
}
__device__ __forceinline__ void xcd_barrier_complete(unsigned* bar, unsigned x, unsigned& nloc, unsigned& nx) {
    const unsigned G = gridDim.x * gridDim.y * gridDim.z;
    unsigned sum, cnt, mine, sp = 0u;
    for (;;) {
        sum = 0u; cnt = 0u; mine = 0u;
#pragma unroll
        for (unsigned j = 0; j < 16; ++j) { const unsigned c = xb_ld(&bar[XB_XCNT(j)]); sum += c; cnt += (c > 0u) ? 1u : 0u; mine = (j == x) ? c : mine; }
        if (sum == G) break;
        __builtin_amdgcn_s_sleep(1);
        if ((++sp & 255u) == 0u) { if (xb_ld(&bar[XB_TMO])) break; if (sp > XB_SPIN_CAP) { atomicAdd(&bar[XB_TMO], 1u); break; } }
    }
    nloc = mine > 0u ? mine : 1u; nx = cnt > 0u ? cnt : 1u;
}
__device__ __forceinline__ void xcd_barrier(const XcdBarrier& b) {
    asm volatile("s_waitcnt vmcnt(0)" ::: "memory");
    __syncthreads();
    if (threadIdx.x == 0) {
        unsigned* bar = b.bar;
        __builtin_amdgcn_s_waitcnt(0);
        unsigned nloc = b.st[0], nx = b.st[1];
        if (nloc == 0u) { xcd_barrier_complete(bar, b.x, nloc, nx); b.st[0] = nloc; b.st[1] = nx; }
        const unsigned old = xb_add(&bar[XB_XSUB(b.x)], 1u);
        const unsigned gen = old / nloc;
        if (old + 1u == (gen + 1u) * nloc) {
            __builtin_amdgcn_fence(__ATOMIC_RELEASE, "agent");
            asm volatile("s_waitcnt vmcnt(0)" ::: "memory");
            const unsigned og = xb_add(&bar[XB_TOP], 1u);
            const unsigned tg = og / nx;
            if (og + 1u == (tg + 1u) * nx) xb_add(&bar[XB_TOPGEN], 1u);
            else XB_SPIN(xb_ld(&bar[XB_TOPGEN]) == tg, bar);
            __builtin_amdgcn_fence(__ATOMIC_ACQUIRE, "agent");
            xb_add(&bar[XB_XGEN(b.x)], 1u);
            asm volatile("s_waitcnt vmcnt(0)" ::: "memory");
        } else {
            XB_SPIN(xb_ld(&bar[XB_XGEN(b.x)]) == gen, bar);
            __builtin_amdgcn_fence(__ATOMIC_ACQUIRE, "agent");
            asm volatile("s_waitcnt vmcnt(0)" ::: "memory");
        }
    }
    __syncthreads();
}


struct TileSched {
  int NT, m0, cnt, ntiles, nfull, local, nloc;
  __device__ __forceinline__ void init(int MT, int NT_) {
    NT = NT_;
    const int x = blockIdx.x & 7; local = blockIdx.x >> 3; nloc = gridDim.x >> 3;
    const int q = MT >> 3, r = MT & 7;
    cnt = q + (x < r ? 1 : 0); m0 = x * q + (x < r ? x : r);
    ntiles = cnt * NT; nfull = cnt >> 3;
  }
  int MTe, lin0;
  __device__ __forceinline__ void init_even(int MT, int NT_) {
    NT = NT_; MTe = MT;
    const int x = blockIdx.x & 7; local = blockIdx.x >> 3; nloc = gridDim.x >> 3;
    const int T = MT * NT_;
    lin0 = (int)(((long)T * x) >> 3);
    ntiles = (int)(((long)T * (x + 1)) >> 3) - lin0;
  }
  __device__ __forceinline__ void get_even(int i, int& mt, int& nt) const {
    const int L = lin0 + i, nfullg = MTe >> 3, full = nfullg * 8 * NT;
    if (L < full) { const int grp = L / (8 * NT), rem = L - grp * 8 * NT; nt = rem >> 3; mt = grp * 8 + (rem & 7); }
    else { const int i2 = L - full, gs = MTe - nfullg * 8; nt = i2 / gs; mt = nfullg * 8 + (i2 - nt * gs); }
  }
  __device__ __forceinline__ void get(int i, int& mt, int& nt) const {
    const int full = nfull * 8 * NT;
    if (i < full) { const int grp = i / (8 * NT), rem = i - grp * 8 * NT; nt = rem >> 3; mt = m0 + grp * 8 + (rem & 7); }
    else { const int i2 = i - full, gs = cnt - nfull * 8; nt = i2 / gs; mt = m0 + nfull * 8 + (i2 - nt * gs); }
  }
};

__device__ __forceinline__ float row_rstd(const float* ssq, int row) {
  float s = 0.f;
#pragma unroll
  for (int q = 0; q < 4; ++q) s += ssq[(size_t)q * NR + row];
  return rsqrtf(s * (1.f / 1024.f) + EPSN);
}

__device__ __forceinline__ void transpose_mat(const float* src, int ldsrc, int K, int N, bf16_t* dst, const float* scale, int kind, float* sm) {
  const int tid = threadIdx.x & 255;
  sm += (threadIdx.x >> 8) * 8448;
  const int nnb = N >> 7, ntile = (K >> 6) * nnb;
  for (int tile2 = blockIdx.x; tile2 < (ntile >> 1); tile2 += gridDim.x) {
    const int tile = tile2 * 2 + (threadIdx.x >> 8);
    const int kb = tile / nnb, nb4 = tile - kb * nnb;
    const int i = tid >> 3, j4 = tid & 7;
    float4 v[4][2];
#pragma unroll
    for (int sub = 0; sub < 4; ++sub) {
      const int nb = nb4 * 4 + sub;
      int scol;
      if (kind == 0) scol = nb * 32;
      else if (kind == 1) scol = nb * 32 < 1536 ? nb * 32 : nb * 32 + 16;
      else { int j = nb >> 3, half = (nb >> 2) & 1; scol = half * 2816 + j * 128 + (nb & 3) * 32; }
#pragma unroll
      for (int r = 0; r < 2; ++r) v[sub][r] = *(const float4*)(src + (size_t)(kb * 64 + i + 32 * r) * ldsrc + scol + j4 * 4);
    }
    const float sc0 = scale ? scale[kb * 64 + i] : 1.f, sc1 = scale ? scale[kb * 64 + i + 32] : 1.f;
#pragma unroll
    for (int sub = 0; sub < 4; ++sub) {
#pragma unroll
      for (int r = 0; r < 2; ++r) {
        const float sc = r ? sc1 : sc0;
        float* d = sm + sub * 2112 + (i + 32 * r) * 33 + j4 * 4;
        d[0] = v[sub][r].x * sc; d[1] = v[sub][r].y * sc; d[2] = v[sub][r].z * sc; d[3] = v[sub][r].w * sc;
      }
    }
    __syncthreads();
    {
      const int n = tid >> 3, kq = tid & 7;
#pragma unroll
      for (int sub = 0; sub < 4; ++sub) {
        const float* s2 = sm + sub * 2112 + (kq * 8) * 33 + n;
        uint4 o;
        o.x = pack2(s2[0], s2[33]); o.y = pack2(s2[66], s2[99]); o.z = pack2(s2[132], s2[165]); o.w = pack2(s2[198], s2[231]);
        *(uint4*)(dst + (size_t)((nb4 * 4 + sub) * 32 + n) * K + kb * 64 + kq * 8) = o;
      }
    }
    __syncthreads();
  }
}

__device__ __forceinline__ void phase_prep(const Params& p, char* lds) {
  const int tid = threadIdx.x, lane = tid & 63;
  bf16_t* wb = (bf16_t*)p.out;
  {
    bf16_t* xb = (bf16_t*)(p.ws + WS_XB);
    float* ssq = (float*)(p.ws + WS_SSQ2);
    const int gw = blockIdx.x * 8 + (tid >> 6), nw = gridDim.x * 8;
    for (int r = gw; r < NR; r += nw) {
      const float4* src = (const float4*)xrow_src(p, r);
      float s = 0.f;
#pragma unroll
      for (int j = 0; j < 4; ++j) {
        float4 v = src[lane + 64 * j];
        s += v.x * v.x + v.y * v.y + v.z * v.z + v.w * v.w;
        uint2 o; o.x = pack2(v.x, v.y); o.y = pack2(v.z, v.w);
        *(uint2*)(xb + (size_t)r * 1024 + (lane + 64 * j) * 4) = o;
      }
      s = wave_sum(s);
      if (lane < 4) ssq[(size_t)lane * NR + r] = lane == 0 ? s : 0.f;
    }
  }
  float* sm = (float*)lds;
  transpose_mat(p.in[10], 2064, 1024, 2048, wb + W_IN0, p.in[9], 1, sm);
  transpose_mat(p.in[22], 512, 512, 512, wb + W_GLU, nullptr, 0, sm);
  transpose_mat(p.in[24], 1024, 1024, 1024, wb + W_OUT0, nullptr, 0, sm);
  transpose_mat(p.in[36], 5632, 1024, 5632, wb + W_UP, p.in[35], 2, sm);
  transpose_mat(p.in[36] + (size_t)1024 * 5632, 5632, 1024, 5632, wb + W_UP + (size_t)5632 * 1024, p.in[35] + 1024, 2, sm);
  transpose_mat(p.in[39], 1024, 2816, 1024, wb + W_DOWN, nullptr, 0, sm);
  transpose_mat(p.in[39] + (size_t)2816 * 1024, 1024, 2816, 1024, wb + W_DOWN + (size_t)1024 * 2816, nullptr, 0, sm);
  transpose_mat(p.in[26], 3072, 1024, 3072, wb + W_IN1, p.in[25], 0, sm);
  transpose_mat(p.in[34], 1024, 1536, 1024, wb + W_OUT1, nullptr, 0, sm);
  const int gt = blockIdx.x * 512 + tid, ngt = gridDim.x * 512;
  for (int idx = gt; idx < 256 * 1024; idx += ngt) {
    const int c = idx >> 10, k = idx & 1023;
    const float* wi = p.in[10] + (size_t)k * 2064 + 1536;
    float s = 0.f;
#pragma unroll
    for (int r = 0; r < 16; ++r) s += wi[r] * p.in[11][r * 256 + c];
    wb[W_IN0 + (size_t)(2048 + c) * 1024 + k] = f2bf(s * p.in[9][k]);
  }
  for (int idx = gt; idx < 2 * 16 * 96 * 96; idx += ngt) {
    const int mat = idx / 147456, rem = idx - mat * 147456;
    const int nb = rem / 9216, r2 = rem - nb * 9216, d = r2 / 96, c = r2 - d * 96;
    const float* src = mat ? p.in[31] : p.in[29];
    wb[W_GATE + idx] = f2bf(src[nb * 9216 + c * 96 + d]);
  }
  for (int idx = gt; idx < 1536; idx += ngt) ((float*)(p.ws + WS_NSP))[idx] = -8.f * softplusf_(-p.in[33][idx]);
  for (int idx = gt; idx < 2048; idx += ngt) {
    const int g = idx >> 6;
    const float dt = expf(p.in[16][g]);
    const float lr = p.in[14][idx], li = p.in[15][idx];
    const float y = li * dt;
    const float kk = rintf(y * 0.15915494309189535f);
    float yr = fmaf(-kk, 6.2831854820251465f, y);
    yr = fmaf(-kk, -1.7484555e-7f, yr);
    const float sn = sinf(yr), cs = cosf(yr);
    const float mag = expf(lr * dt);
    const float abr = mag * cs, abi = mag * sn;
    const float sh = sinf(0.5f * yr);
    const float nr = expm1f(lr * dt) * cs - 2.f * sh * sh, ni = abi;
    const float den = lr * lr + li * li;
    const float fr = (nr * lr + ni * li) / den, fi = (ni * lr - nr * li) / den;
    float* ab = (float*)(p.ws + WS_S5AB);
    ab[idx] = abr; ab[2048 + idx] = abi;
    float pr = abr, pi = abi;
#pragma unroll
    for (int q = 0; q < 4; ++q) { float t = pr * pr - pi * pi; pi = 2.f * pr * pi; pr = t; }
    ab[4096 + idx] = pr; ab[6144 + idx] = pi;
#pragma unroll
    for (int q = 0; q < 2; ++q) { float t = pr * pr - pi * pi; pi = 2.f * pr * pi; pr = t; }
    ab[8192 + idx] = pr; ab[10240 + idx] = pi;
    float* bbr = (float*)(p.ws + WS_S5BB);
    float* bbi = bbr + 2048 * 16;
#pragma unroll
    for (int h = 0; h < 16; ++h) {
      const float br = p.in[17][idx * 16 + h], bi = p.in[18][idx * 16 + h];
      bbr[idx * 16 + h] = fr * br - fi * bi;
      bbi[idx * 16 + h] = fr * bi + fi * br;
    }
    bf16_t* cc = (bf16_t*)(p.ws + WS_S5CC);
    const int pp = idx & 63;
#pragma unroll
    for (int h = 0; h < 16; ++h) {
      cc[(g * 16 + h) * 128 + 2 * pp] = f2bf(p.in[19][(g * 16 + h) * 64 + pp]);
      cc[(g * 16 + h) * 128 + 2 * pp + 1] = f2bf(-p.in[20][(g * 16 + h) * 64 + pp]);
    }
  }
}

__device__ __forceinline__ void g1_store(const Params& p, bf16_t* zb, float* alog, int row, int col, float v0, float v1, float v2, float v3) {
  if (col < 2048) {
    if (col < 256) { v0 *= 0.125f; v1 *= 0.125f; v2 *= 0.125f; v3 *= 0.125f; }
    uint2 o; o.x = pack2(v0, v1); o.y = pack2(v2, v3);
    *(uint2*)(zb + (size_t)row * 2048 + col) = o;
  } else {
    const int c = col - 2048;
    const float4 ba = *(const float4*)(p.in[12] + c);
    float4 o;
    o.x = -softplusf_(-(v0 + ba.x)) * 0.0625f; o.y = -softplusf_(-(v1 + ba.y)) * 0.0625f;
    o.z = -softplusf_(-(v2 + ba.z)) * 0.0625f; o.w = -softplusf_(-(v3 + ba.w)) * 0.0625f;
    *(float4*)(alog + (size_t)row * 256 + c) = o;
  }
}
__device__ __forceinline__ void phase_g1(const Params& p, char* lds) {
  int tid, lane, w, wr, wc, lr, lq; TREFRESH();
  const bf16_t* zp = (const bf16_t*)(p.ws + WS_ZERO);
  const bf16_t* xb = (const bf16_t*)(p.ws + WS_XB);
  const bf16_t* W = (const bf16_t*)p.out + W_IN0;
  const float* ssq = (const float*)(p.ws + WS_SSQ2);
  bf16_t* zb = (bf16_t*)(p.ws + WS_SCR + SCR_ZB);
  float* alog = (float*)(p.ws + WS_SCR + SCR_ALOG);
  float* srs = (float*)(lds + LDS_SRS);
  unsigned* flg = (unsigned*)(p.ws + WS_FLAG);
  const int u = blockIdx.x;
  const bool unitA = u < 128, unitB = u >= 128 && u < 164;
  const int umt = unitA ? (u >> 1) : 64, unt = unitA ? 8 : ((u - 128) >> 2), uks = unitA ? (u & 1) : ((u - 128) & 3);
  const int uK = unitA ? 512 : 256, nsl = unitA ? 2 : 4;
  float* slab0 = unitA ? (float*)(p.ws + WS_SCR + SCR_SLOC) + (size_t)(u >> 1) * 2 * 65536 : (float*)(p.ws + WS_SLAB) + (size_t)unt * 4 * 65536;
  unsigned* tick = unitA ? flg + 4432 + (u >> 1) : flg + 4496 + unt;
  if (unitA || unitB) {
    const int k0 = uks * uK;
    f32x4 acc[8][4];
    gemm_tile256(acc, xb + k0, [&](int i) { return (umt * 256 + i) * 1024; }, W + (size_t)unt * 256 * 1024 + k0, 1024, uK, lds, zp);
    TREFRESH(); int zE = 0; asm volatile("" : "+v"(zE));
    float* slab = slab0 + (size_t)uks * 65536;
#pragma unroll
    for (int m = 0; m < 8; ++m)
#pragma unroll
      for (int n = 0; n < 4; ++n)
        *(float4*)(slab + ((m >> 2) * 128 + wr * 64 + (m & 3) * 16 + lr + zE) * 256 + (n >> 1) * 128 + wc * 32 + (n & 1) * 16 + lq * 4 + zE) = make_float4(acc[m][n][0], acc[m][n][1], acc[m][n][2], acc[m][n][3]);
    asm volatile("s_waitcnt vmcnt(0)" ::: "memory");
    __syncthreads();
    if (tid == 0) {
      __builtin_amdgcn_fence(__ATOMIC_RELEASE, "agent");
      asm volatile("s_waitcnt vmcnt(0)" ::: "memory");
      (void)xb_add(tick, 1u);
    }
  }
  TileSched ts; ts.init(64, 8);
  for (int ti = ts.local; ti < ts.ntiles; ti += ts.nloc) {
    int mt, nt; ts.get(ti, mt, nt);
    if (tid < 256) srs[tid] = row_rstd(ssq, mt * 256 + tid);
    f32x4 acc[8][4];
    gemm_tile256(acc, xb, [&](int i) { return (mt * 256 + i) * 1024; }, W + (size_t)nt * 256 * 1024, 1024, 1024, lds, zp);
    TREFRESH(); int zE = 0; asm volatile("" : "+v"(zE));
#pragma unroll
    for (int m = 0; m < 8; ++m) {
      const int r = (m >> 2) * 128 + wr * 64 + (m & 3) * 16 + lr + zE, row = mt * 256 + r;
      const float rs = srs[r];
#pragma unroll
      for (int n = 0; n < 4; ++n) {
        const int col = nt * 256 + (n >> 1) * 128 + wc * 32 + (n & 1) * 16 + lq * 4 + zE;
        f32x4 v = acc[m][n] * rs;
        if (col < 256) v = v * 0.125f;
        uint2 o; o.x = pack2(v[0], v[1]); o.y = pack2(v[2], v[3]);
        *(uint2*)(zb + (size_t)row * 2048 + col) = o;
      }
    }
    __syncthreads();
  }
  if (unitA || unitB) {
    if (tid == 0) {
      XB_SPIN(xb_ld(tick) < (unsigned)nsl, (unsigned*)(p.ws + WS_BAR));
      __builtin_amdgcn_fence(__ATOMIC_ACQUIRE, "agent");
      asm volatile("s_waitcnt vmcnt(0)" ::: "memory");
    }
    __syncthreads();
    const int rpb = 256 / nsl, r0 = uks * rpb;
    for (int rr = r0 + (tid >> 6); rr < r0 + rpb; rr += 8) {
      const int c4 = tid & 63, row = umt * 256 + rr, col = unt * 256 + c4 * 4;
      const float* s4 = slab0 + rr * 256 + c4 * 4;
      float4 sum = make_float4(0.f, 0.f, 0.f, 0.f);
      for (int q = 0; q < nsl; ++q) { const float4 v = *(const float4*)(s4 + (size_t)q * 65536); sum.x += v.x; sum.y += v.y; sum.z += v.z; sum.w += v.w; }
      const float rs = row_rstd(ssq, row);
      g1_store(p, zb, alog, row, col, sum.x * rs, sum.y * rs, sum.z * rs, sum.w * rs);
    }
  }
}

__device__ __forceinline__ void gla_chunk(const Params& p, int item, int mode, char* lds) {
  const int tid = threadIdx.x & 255, lane = tid & 63, w = tid >> 6, lr = lane & 15, lq = lane >> 4;
  const int bh = item / 33, c = item - bh * 33, b = bh >> 2, h = bh & 3;
  const int row0 = b * TP + (c == 0 ? 0 : 16 + 64 * (c - 1));
  const int len = c == 0 ? 16 : 64;
  bf16_t* zb = (bf16_t*)(p.ws + WS_SCR + SCR_ZB);
  const float* alog = (const float*)(p.ws + WS_SCR + SCR_ALOG);
  float* sloc = (float*)(p.ws + WS_SCR + SCR_SLOC) + (size_t)(bh * 33 + c) * 8192;
  float* sb = (float*)lds;
  char* Qs = lds + 16384; char* Ks = lds + 24576; char* VT = lds + 32768; char* ST = lds + 49152;
#pragma unroll
  for (int i = 0; i < 4; ++i) {
    const int idx = tid + 256 * i, r = idx >> 4, c4 = idx & 15;
    float4 v = make_float4(0.f, 0.f, 0.f, 0.f);
    if (r < len) v = *(const float4*)(alog + (size_t)(row0 + r) * 256 + h * 64 + c4 * 4);
    *(float4*)(sb + r * 64 + c4 * 4) = v;
  }
  __syncthreads();
  {
    float run = 0.f;
#pragma unroll
    for (int t = 0; t < 16; ++t) { run += sb[(16 * w + t) * 64 + lane]; sb[(16 * w + t) * 64 + lane] = run; }
  }
  __syncthreads();
  float off = 0.f;
#pragma unroll
  for (int s = 0; s < 3; ++s) if (s < w) off += sb[(16 * s + 15) * 64 + lane];
  __syncthreads();
#pragma unroll
  for (int t = 0; t < 16; ++t) sb[(16 * w + t) * 64 + lane] += off;
  __syncthreads();
#pragma unroll
  for (int i = 0; i < 2; ++i) {
    const int idx = tid + 256 * i, r = idx & 63, ch = idx >> 6;
    uint4 qv = make_uint4(0, 0, 0, 0), kv = make_uint4(0, 0, 0, 0);
    if (r < len) {
      const bf16_t* zr = zb + (size_t)(row0 + r) * 2048 + h * 64 + ch * 8;
      qv = *(const uint4*)zr; kv = *(const uint4*)(zr + 256);
    }
    float bv[8];
#pragma unroll
    for (int e = 0; e < 8; ++e) bv[e] = sb[r * 64 + ch * 8 + e];
    const uint32_t qq[4] = {qv.x, qv.y, qv.z, qv.w}, kq[4] = {kv.x, kv.y, kv.z, kv.w};
    if (mode == 1) {
      uint32_t oq[4], ok[4];
#pragma unroll
      for (int e = 0; e < 4; ++e) {
        const float e0 = __expf(bv[2 * e]), e1 = __expf(bv[2 * e + 1]);
        oq[e] = pack2(lo2f(qq[e]) * e0, hi2f(qq[e]) * e1);
        ok[e] = pack2(lo2f(kq[e]) * __builtin_amdgcn_rcpf(e0), hi2f(kq[e]) * __builtin_amdgcn_rcpf(e1));
      }
      *(uint4*)(Qs + toff(r, ch)) = make_uint4(oq[0], oq[1], oq[2], oq[3]);
      *(uint4*)(Ks + toff(r, ch)) = make_uint4(ok[0], ok[1], ok[2], ok[3]);
    } else {
#pragma unroll
      for (int e = 0; e < 8; ++e) {
        const int d = ch * 8 + e;
        const float kf = (e & 1) ? hi2f(kq[e >> 1]) : lo2f(kq[e >> 1]);
        const float kh = kf * __expf(sb[63 * 64 + d] - bv[e]);
        *(bf16_t*)(Qs + d * 128 + ((((r >> 3) ^ (d & 7))) << 4) + (r & 7) * 2) = f2bf(kh);
      }
    }
  }
#pragma unroll
  for (int i = 0; i < 4; ++i) {
    const int idx = tid + 256 * i, r = idx & 63, ch = idx >> 6;
    uint4 vv = make_uint4(0, 0, 0, 0);
    if (r < len) vv = *(const uint4*)(zb + (size_t)(row0 + r) * 2048 + 512 + h * 128 + ch * 8);
    const uint32_t vq[4] = {vv.x, vv.y, vv.z, vv.w};
#pragma unroll
    for (int e = 0; e < 8; ++e) {
      const int ee = ch * 8 + e;
      const bf16_t val = (bf16_t)((e & 1) ? (vq[e >> 1] >> 16) : (vq[e >> 1] & 0xffffu));
      *(bf16_t*)(VT + ee * 128 + ((((r >> 3) ^ (ee & 7))) << 4) + (r & 7) * 2) = val;
    }
  }
  if (mode == 1) {
#pragma unroll
    for (int i = 0; i < 4; ++i) {
      const int idx = tid + 256 * i, e = idx >> 3, ch = idx & 7;
      const float4 a = *(const float4*)(sloc + e * 64 + ch * 8);
      const float4 bq = *(const float4*)(sloc + e * 64 + ch * 8 + 4);
      *(uint4*)(ST + toff(e, ch)) = make_uint4(pack2(a.x, a.y), pack2(a.z, a.w), pack2(bq.x, bq.y), pack2(bq.z, bq.w));
    }
  }
  __syncthreads();
  if (mode == 1) {
    f32x4 at[4];
#pragma unroll
    for (int n = 0; n < 4; ++n) at[n] = (f32x4){0.f, 0.f, 0.f, 0.f};
#pragma unroll
    for (int s = 0; s < 2; ++s) {
      const bf16x8 a = *(const bf16x8*)(Qs + toff(16 * w + lr, s * 4 + lq));
#pragma unroll
      for (int n = 0; n < 4; ++n) {
        const bf16x8 bk = *(const bf16x8*)(Ks + toff(16 * n + lr, s * 4 + lq));
        at[n] = mfma16(bk, a, at[n]);
      }
    }
    char* P = lds;
    const int i = 16 * w + lr;
#pragma unroll
    for (int n = 0; n < 4; ++n) {
      const int j0 = 16 * n + lq * 4;
      float v0 = (j0 + 0 <= i) ? at[n][0] : 0.f, v1 = (j0 + 1 <= i) ? at[n][1] : 0.f;
      float v2 = (j0 + 2 <= i) ? at[n][2] : 0.f, v3 = (j0 + 3 <= i) ? at[n][3] : 0.f;
      uint2 o; o.x = pack2(v0, v1); o.y = pack2(v2, v3);
      *(uint2*)(P + i * 128 + ((((j0 >> 3) ^ (i & 7))) << 4) + (j0 & 7) * 2) = o;
    }
    __syncthreads();
    f32x4 o[8];
#pragma unroll
    for (int n = 0; n < 8; ++n) o[n] = (f32x4){0.f, 0.f, 0.f, 0.f};
#pragma unroll
    for (int s = 0; s < 2; ++s) {
      const bf16x8 aP = *(const bf16x8*)(P + toff(16 * w + lr, s * 4 + lq));
      const bf16x8 aQ = *(const bf16x8*)(Qs + toff(16 * w + lr, s * 4 + lq));
#pragma unroll
      for (int n = 0; n < 8; ++n) {
        const bf16x8 bV = *(const bf16x8*)(VT + toff(16 * n + lr, s * 4 + lq));
        const bf16x8 bS = *(const bf16x8*)(ST + toff(16 * n + lr, s * 4 + lq));
        o[n] = mfma16(bV, aP, o[n]);
        o[n] = mfma16(bS, aQ, o[n]);
      }
    }
    float ss = 0.f;
#pragma unroll
    for (int n = 0; n < 8; ++n) ss += o[n][0] * o[n][0] + o[n][1] * o[n][1] + o[n][2] * o[n][2] + o[n][3] * o[n][3];
    ss += __shfl_xor(ss, 16); ss += __shfl_xor(ss, 32);
    const float rstd = rsqrtf(ss * (1.f / 128.f) + EPSN);
    if (i < len) {
      bf16_t* zr = zb + (size_t)(row0 + i) * 2048;
#pragma unroll
      for (int n = 0; n < 8; ++n) {
        const int e0 = 16 * n + lq * 4;
        const uint2 g2 = *(const uint2*)(zr + 1024 + h * 128 + e0);
        const float4 gn = *(const float4*)(p.in[13] + h * 128 + e0);
        const float g0 = lo2f(g2.x), g1 = hi2f(g2.x), g2f = lo2f(g2.y), g3 = hi2f(g2.y);
        uint2 ov;
        ov.x = pack2(o[n][0] * rstd * gn.x * g0 * sigm(g0), o[n][1] * rstd * gn.y * g1 * sigm(g1));
        ov.y = pack2(o[n][2] * rstd * gn.z * g2f * sigm(g2f), o[n][3] * rstd * gn.w * g3 * sigm(g3));
        *(uint2*)(zr + 512 + h * 128 + e0) = ov;
      }
    }
  } else {
    f32x4 sl[8];
#pragma unroll
    for (int n = 0; n < 8; ++n) sl[n] = (f32x4){0.f, 0.f, 0.f, 0.f};
#pragma unroll
    for (int s = 0; s < 2; ++s) {
      const bf16x8 aK = *(const bf16x8*)(Qs + toff(16 * w + lr, s * 4 + lq));
#pragma unroll
      for (int n = 0; n < 8; ++n) {
        const bf16x8 bV = *(const bf16x8*)(VT + toff(16 * n + lr, s * 4 + lq));
        sl[n] = mfma16(aK, bV, sl[n]);
      }
    }
#pragma unroll
    for (int n = 0; n < 8; ++n) {
      const int e = 16 * n + lr, d0 = 16 * w + lq * 4;
      *(float4*)(sloc + e * 64 + d0) = make_float4(sl[n][0], sl[n][1], sl[n][2], sl[n][3]);
    }
    if (tid < 64) ((float*)(p.ws + WS_DEC))[(bh * 33 + c) * 64 + tid] = __expf(sb[63 * 64 + tid]);
  }
  __syncthreads();
}

__device__ __forceinline__ void gla_sample(const Params& p, int item, char* lds) {
  const int tid = threadIdx.x & 255;
  const int s = item >> 2, h = item & 3, row = NPR + s;
  bf16_t* zb = (bf16_t*)(p.ws + WS_SCR + SCR_ZB);
  const float* alog = (const float*)(p.ws + WS_SCR + SCR_ALOG);
  float* sq = (float*)lds; float* sk = sq + 64; float* sa = sk + 64; float* part = sa + 64; float* red = part + 256;
  if (tid < 64) {
    sq[tid] = bf2f(zb[(size_t)row * 2048 + h * 64 + tid]);
    sk[tid] = bf2f(zb[(size_t)row * 2048 + 256 + h * 64 + tid]);
    sa[tid] = __expf(alog[(size_t)row * 256 + h * 64 + tid]);
  }
  __syncthreads();
  const int e = tid & 127, half = tid >> 7;
  const float v = bf2f(zb[(size_t)row * 2048 + 512 + h * 128 + e]);
  const float* S0 = p.in[2] + (size_t)(s * 4 + h) * 8192;
  float* So = p.out + O_GLAS + (size_t)(s * 4 + h) * 8192;
  float acc = 0.f;
#pragma unroll 8
  for (int dd = 0; dd < 32; ++dd) {
    const int d = half * 32 + dd;
    const float sn = sa[d] * S0[d * 128 + e] + sk[d] * v;
    So[d * 128 + e] = sn;
    acc += sq[d] * sn;
  }
  part[tid] = acc;
  __syncthreads();
  float o = 0.f;
  if (tid < 128) { o = part[tid] + part[tid + 128]; }
  float ssv = wave_sum(tid < 128 ? o * o : 0.f);
  if ((tid & 63) == 0) red[tid >> 6] = ssv;
  __syncthreads();
  if (tid < 128) {
    const float rstd = rsqrtf((red[0] + red[1]) * (1.f / 128.f) + EPSN);
    const float g = bf2f(zb[(size_t)row * 2048 + 1024 + h * 128 + e]);
    zb[(size_t)row * 2048 + 512 + h * 128 + e] = f2bf(o * rstd * p.in[13][h * 128 + e] * g * sigm(g));
  }
  __syncthreads();
}

typedef __attribute__((ext_vector_type(2))) float f32x2;
__device__ __forceinline__ void s5_load_u(const bf16_t* zb, int row0, int len, int g, int lane, char* ul) {
  uint4 a = make_uint4(0, 0, 0, 0), b = a;
  if (lane < len) {
    const uint4* s = (const uint4*)(zb + (size_t)(row0 + lane) * 2048 + 1536 + g * 16);
    a = s[0]; b = s[1];
  }
  float4* d = (float4*)(ul + lane * 64);
  d[0] = make_float4(lo2f(a.x), hi2f(a.x), lo2f(a.y), hi2f(a.y));
  d[1] = make_float4(lo2f(a.z), hi2f(a.z), lo2f(a.w), hi2f(a.w));
  d[2] = make_float4(lo2f(b.x), hi2f(b.x), lo2f(b.y), hi2f(b.y));
  d[3] = make_float4(lo2f(b.z), hi2f(b.z), lo2f(b.w), hi2f(b.w));
}
__device__ __forceinline__ void s5_load_bb(const float* bbrp, int idx, f32x2 (&bb)[16]) {
#pragma unroll
  for (int q = 0; q < 4; ++q) {
    const float4 x = *(const float4*)(bbrp + idx * 16 + q * 4), y = *(const float4*)(bbrp + 32768 + idx * 16 + q * 4);
    bb[4 * q] = (f32x2){x.x, y.x}; bb[4 * q + 1] = (f32x2){x.y, y.y}; bb[4 * q + 2] = (f32x2){x.z, y.z}; bb[4 * q + 3] = (f32x2){x.w, y.w};
  }
}
__device__ __forceinline__ void s5_step(const char* ul, int t, const f32x2 (&bb)[16], float ar, float ai, float& xr, float& xi) {
  const float4* u = (const float4*)(ul + t * 64);
  const float4 u0 = u[0], u1 = u[1], u2 = u[2], u3 = u[3];
  f32x2 acc = bb[0] * u0.x;
  acc += bb[1] * u0.y; acc += bb[2] * u0.z; acc += bb[3] * u0.w;
  acc += bb[4] * u1.x; acc += bb[5] * u1.y; acc += bb[6] * u1.z; acc += bb[7] * u1.w;
  acc += bb[8] * u2.x; acc += bb[9] * u2.y; acc += bb[10] * u2.z; acc += bb[11] * u2.w;
  acc += bb[12] * u3.x; acc += bb[13] * u3.y; acc += bb[14] * u3.z; acc += bb[15] * u3.w;
  const float nr = ar * xr - ai * xi + acc[0], ni = ar * xi + ai * xr + acc[1];
  xr = nr; xi = ni;
}

__device__ __forceinline__ void s5_pass1(const Params& p, char* lds) {
  const int tid = threadIdx.x, lane = tid & 63, w = tid >> 6;
  const bf16_t* zb = (const bf16_t*)(p.ws + WS_SCR + SCR_ZB);
  const float* ab = (const float*)(p.ws + WS_S5AB);
  const float* bbrp = (const float*)(p.ws + WS_S5BB);
  float* xloc = (float*)(p.ws + WS_XLOC);
  char* ul = lds + w * 4096;
  const int nitem = 8 * 32 * 32;
  for (int base = blockIdx.x * 8; base < nitem; base += gridDim.x * 8) {
    const int item = base + w;
    const bool valid = item < nitem;
    const int it = valid ? item : 0;
    const int bg = it >> 5, c = it & 31, b = bg >> 5, g = bg & 31;
    const int row0 = b * TP + (c == 0 ? 0 : 16 + 64 * (c - 1));
    const int len = c == 0 ? 16 : 64;
    const int idx = g * 64 + lane;
    f32x2 bb[16];
    s5_load_bb(bbrp, idx, bb);
    const float ar = ab[idx], ai = ab[2048 + idx];
    __syncthreads();
    s5_load_u(zb, row0, len, g, lane, ul);
    __syncthreads();
    float xr = 0.f, xi = 0.f;
    for (int t = 0; t < len; ++t) s5_step(ul, t, bb, ar, ai, xr, xi);
    if (valid) {
      xloc[(size_t)(bg * 33 + c) * 64 + lane] = xr;
      xloc[540672 + (size_t)(bg * 33 + c) * 64 + lane] = xi;
    }
  }
}

__device__ __forceinline__ void s5_pass2(const Params& p) {
  const int gt = blockIdx.x * 512 + threadIdx.x;
  if (gt >= 16384) return;
  const int bg = gt >> 6, pp = gt & 63, g = bg & 31, idx = g * 64 + pp;
  const float* ab = (const float*)(p.ws + WS_S5AB);
  const float* xloc = (const float*)(p.ws + WS_XLOC);
  float* xst = (float*)(p.ws + WS_XST);
  const float a16r = ab[4096 + idx], a16i = ab[6144 + idx], a64r = ab[8192 + idx], a64i = ab[10240 + idx];
  float xr = 0.f, xi = 0.f;
  const size_t o0 = (size_t)bg * 33 * 64 + pp;
  xst[o0] = 0.f; xst[540672 + o0] = 0.f;
#pragma unroll 1
  for (int c0 = 0; c0 < 32; c0 += 8) {
    float lr_[8], li_[8];
#pragma unroll
    for (int q = 0; q < 8; ++q) { lr_[q] = xloc[o0 + (c0 + q) * 64]; li_[q] = xloc[540672 + o0 + (c0 + q) * 64]; }
#pragma unroll
    for (int q = 0; q < 8; ++q) {
      const int c = c0 + q;
      const float Ar = c == 0 ? a16r : a64r, Ai = c == 0 ? a16i : a64i;
      const float nr = Ar * xr - Ai * xi + lr_[q], ni = Ar * xi + Ai * xr + li_[q];
      xr = nr; xi = ni;
      xst[o0 + (c + 1) * 64] = xr; xst[540672 + o0 + (c + 1) * 64] = xi;
    }
  }
}

__device__ __forceinline__ void s5_pass3(const Params& p, char* lds) {
  const int tid = threadIdx.x, lane = tid & 63, w = tid >> 6, lr = lane & 15, lq = lane >> 4;
  bf16_t* zb = (bf16_t*)(p.ws + WS_SCR + SCR_ZB);
  const float* ab = (const float*)(p.ws + WS_S5AB);
  const float* bbrp = (const float*)(p.ws + WS_S5BB);
  const float* xst = (const float*)(p.ws + WS_XST);
  const bf16_t* cc = (const bf16_t*)(p.ws + WS_S5CC);
  char* ul = lds + w * 4096;
  char* X = lds + 32768 + w * 8192;
  const int nprompt = 8 * 32 * 33, nitem = nprompt + 128 * 32;
  for (int base = blockIdx.x * 8; base < nitem; base += gridDim.x * 8) {
    const int item = base + w;
    const bool valid = item < nitem;
    const int it = valid ? item : 0;
    int b, g, c, row0, len; bool last, smp;
    float xr, xi;
    if (it < nprompt) {
      const int bg = it / 33; c = it - bg * 33; b = bg >> 5; g = bg & 31; smp = false;
      row0 = b * TP + (c == 0 ? 0 : 16 + 64 * (c - 1)); len = c == 0 ? 16 : 64; last = c == 32;
      xr = xst[(size_t)it * 64 + lane]; xi = xst[540672 + (size_t)it * 64 + lane];
    } else {
      const int i2 = it - nprompt; b = i2 >> 5; g = i2 & 31; c = 0; smp = true;
      row0 = NPR + b; len = 1; last = true;
      xr = p.in[3][(b * 32 + g) * 64 + lane]; xi = p.in[4][(b * 32 + g) * 64 + lane];
    }
    const int idx = g * 64 + lane;
    f32x2 bb[16];
    s5_load_bb(bbrp, idx, bb);
    const float ar = ab[idx], ai = ab[2048 + idx];
    bf16x8 bC[4];
#pragma unroll
    for (int s = 0; s < 4; ++s) bC[s] = *(const bf16x8*)(cc + (g * 16 + lr) * 128 + 32 * s + 8 * lq);
    const float4 dd = *(const float4*)(p.in[21] + g * 16 + lq * 4);
    __syncthreads();
    s5_load_u(zb, row0, len, g, lane, ul);
    __syncthreads();
#pragma unroll 1
    for (int half = 0; half < 2; ++half) {
      const int tl = len - 32 * half < 32 ? len - 32 * half : 32;
      for (int tt = 0; tt < tl; ++tt) {
        s5_step(ul, 32 * half + tt, bb, ar, ai, xr, xi);
        *(uint32_t*)(X + tt * 256 + ((((lane >> 2) ^ (tt & 15))) << 4) + (lane & 3) * 4) = pack2(xr, xi);
      }
      __syncthreads();
      f32x4 y[2];
#pragma unroll
      for (int m = 0; m < 2; ++m) {
        y[m] = (f32x4){0.f, 0.f, 0.f, 0.f};
        const int row = 16 * m + lr;
#pragma unroll
        for (int s = 0; s < 4; ++s) {
          const bf16x8 a = *(const bf16x8*)(X + row * 256 + ((((s * 4 + lq) ^ (row & 15))) << 4));
          y[m] = mfma16(bC[s], a, y[m]);
        }
      }
#pragma unroll
      for (int m = 0; m < 2; ++m) {
        const int t = 32 * half + 16 * m + lr;
        if (valid && t < len) {
          const float4 u4 = *(const float4*)(ul + t * 64 + lq * 16);
          const float y0 = gelu_t(y[m][0] + dd.x * u4.x), y1 = gelu_t(y[m][1] + dd.y * u4.y);
          const float y2 = gelu_t(y[m][2] + dd.z * u4.z), y3 = gelu_t(y[m][3] + dd.w * u4.w);
          uint2 o; o.x = pack2(y0, y1); o.y = pack2(y2, y3);
          *(uint2*)(zb + (size_t)(row0 + t) * 2048 + 1536 + g * 16 + lq * 4) = o;
        }
      }
      __syncthreads();
    }
    if (valid && last) {
      if (smp) { p.out[O_S5RS + (b * 32 + g) * 64 + lane] = xr; p.out[O_S5IS + (b * 32 + g) * 64 + lane] = xi; }
      else { p.out[O_S5RP + (b * 32 + g) * 64 + lane] = xr; p.out[O_S5IP + (b * 32 + g) * 64 + lane] = xi; }
    }
  }
}

__device__ __forceinline__ void phase_mix_a(const Params& p, char* lds) {
  { const int hf = threadIdx.x >> 8; for (int pr = blockIdx.x; pr < 16 * 33; pr += gridDim.x) gla_chunk(p, pr * 2 + hf, 0, lds + hf * HALF_LDS); }
  __syncthreads();
  s5_pass1(p, lds);
}
__device__ __forceinline__ void phase_mix_b(const Params& p) {
  float* slocb = (float*)(p.ws + WS_SCR + SCR_SLOC);
  const float* dec = (const float*)(p.ws + WS_DEC);
  const int gt = blockIdx.x * 512 + threadIdx.x, ngt = gridDim.x * 512;
#pragma unroll 1
  for (int idx = gt; idx < 32 * 8192; idx += ngt) {
    const int bh = idx >> 13, ed = idx & 8191, e = ed >> 6, d = ed & 63;
    float S = 0.f;
#pragma unroll 1
    for (int c0 = 0; c0 < 33; c0 += 11) {
      float tmp[11], dc[11];
#pragma unroll
      for (int q = 0; q < 11; ++q) { tmp[q] = slocb[(size_t)(bh * 33 + c0 + q) * 8192 + ed]; dc[q] = dec[(bh * 33 + c0 + q) * 64 + d]; }
#pragma unroll
      for (int q = 0; q < 11; ++q) { slocb[(size_t)(bh * 33 + c0 + q) * 8192 + ed] = S; S = dc[q] * S + tmp[q]; }
    }
    p.out[O_GLAP + (size_t)(bh * 64 + d) * 128 + e] = S;
  }
  s5_pass2(p);
}
__device__ __forceinline__ void phase_mix_c(const Params& p, char* lds) {
  const int hf = threadIdx.x >> 8;
  for (int pr = blockIdx.x; pr < 16 * 33; pr += gridDim.x) gla_chunk(p, pr * 2 + hf, 1, lds + hf * HALF_LDS);
  __syncthreads();
  for (int pr = blockIdx.x; pr < 256; pr += gridDim.x) gla_sample(p, pr * 2 + hf, lds + hf * HALF_LDS);
  __syncthreads();
  s5_pass3(p, lds);
}

__device__ __forceinline__ void phase_glu(const Params& p, char* lds) {
  int tid, lane, w, wr, wc, lr, lq; TREFRESH();
  const bf16_t* zp = (const bf16_t*)(p.ws + WS_ZERO);
  bf16_t* zb = (bf16_t*)(p.ws + WS_SCR + SCR_ZB);
  const bf16_t* W = (const bf16_t*)p.out + W_GLU;
  TileSched ts; ts.init(65, 2);
  for (int ti = ts.local; ti < ts.ntiles; ti += ts.nloc) {
    int mt, nt; ts.get(ti, mt, nt);
    f32x4 acc[8][4];
    gemm_tile256(acc, (const bf16_t*)zb + 1536, [&](int i) { return (mt * 256 + i) * 2048; }, W + (size_t)nt * 256 * 512, 512, 512, lds, zp);
    TREFRESH(); int zE = 0; asm volatile("" : "+v"(zE));
#pragma unroll
    for (int m = 0; m < 8; ++m) {
      const int row = mt * 256 + (m >> 2) * 128 + wr * 64 + (m & 3) * 16 + lr + zE;
#pragma unroll
      for (int n = 0; n < 4; ++n) {
        const int col = nt * 256 + (n >> 1) * 128 + wc * 32 + (n & 1) * 16 + lq * 4 + zE;
        const uint2 y2 = *(const uint2*)(zb + (size_t)row * 2048 + 1536 + col);
        const float4 bg = *(const float4*)(p.in[23] + col);
        uint2 o;
        o.x = pack2(lo2f(y2.x) * sigm(acc[m][n][0] + bg.x), hi2f(y2.x) * sigm(acc[m][n][1] + bg.y));
        o.y = pack2(lo2f(y2.y) * sigm(acc[m][n][2] + bg.z), hi2f(y2.y) * sigm(acc[m][n][3] + bg.w));
        *(uint2*)(zb + (size_t)row * 2048 + 1024 + col) = o;
      }
      asm volatile("" ::: "memory");
    }
  }
}

__device__ __forceinline__ void phase_resid(const Params& p, char* lds, const bf16_t* A, int lda, const bf16_t* W, int K, int tkbase, int site) {
  int tid, lane, w, wr, wc, lr, lq; TREFRESH();
  const bf16_t* zp = (const bf16_t*)(p.ws + WS_ZERO);
  bf16_t* xb = (bf16_t*)(p.ws + WS_XB);
  float* ssq = (float*)(p.ws + WS_SSQ2) + (size_t)site * 4 * NR;
  const int ks = K >> 8;
  const bool isunit = (int)blockIdx.x < 4 * ks;
  const int unt = (int)blockIdx.x / ks, uksi = (int)blockIdx.x - unt * ks;
  unsigned* tick = (unsigned*)(p.ws + WS_FLAG) + 4352 + tkbase;
  if (isunit) {
    const int nt = unt, k0 = uksi * 256;
    f32x4 acc[8][4];
    gemm_tile256(acc, A + k0, [&](int i) { return (16384 + i) * lda; }, W + (size_t)nt * 256 * K + k0, K, 256, lds, zp);
    TREFRESH(); int zE = 0; asm volatile("" : "+v"(zE));
    float* slab = (float*)(p.ws + WS_SLAB) + (size_t)(nt * ks + uksi) * 65536;
#pragma unroll
    for (int m = 0; m < 8; ++m)
#pragma unroll
      for (int n = 0; n < 4; ++n)
        *(float4*)(slab + ((m >> 2) * 128 + wr * 64 + (m & 3) * 16 + lr + zE) * 256 + (n >> 1) * 128 + wc * 32 + (n & 1) * 16 + lq * 4 + zE) = make_float4(acc[m][n][0], acc[m][n][1], acc[m][n][2], acc[m][n][3]);
    asm volatile("s_waitcnt vmcnt(0)" ::: "memory");
    __syncthreads();
    if (tid == 0) {
      __builtin_amdgcn_fence(__ATOMIC_RELEASE, "agent");
      asm volatile("s_waitcnt vmcnt(0)" ::: "memory");
      (void)xb_add(&tick[nt], 1u);
    }
  }
  TileSched ts; ts.init(64, 4);
  for (int ti = ts.local; ti < ts.ntiles; ti += ts.nloc) {
    int mt, nt; ts.get(ti, mt, nt);
    f32x4 acc[8][4];
    gemm_tile256(acc, A, [&](int i) { return (mt * 256 + i) * lda; }, W + (size_t)nt * 256 * K, K, K, lds, zp);
    TREFRESH(); int zE = 0; asm volatile("" : "+v"(zE));
#pragma unroll
    for (int m = 0; m < 8; ++m) {
      const int row = mt * 256 + (m >> 2) * 128 + wr * 64 + (m & 3) * 16 + lr + zE;
      float ss0 = 0.f, ss1 = 0.f;
#pragma unroll
      for (int n = 0; n < 4; ++n) {
        const int col = nt * 256 + (n >> 1) * 128 + wc * 32 + (n & 1) * 16 + lq * 4 + zE;
        const uint2 u = *(const uint2*)(xb + (size_t)row * 1024 + col);
        uint2 o; o.x = pack2(lo2f(u.x) + acc[m][n][0], hi2f(u.x) + acc[m][n][1]); o.y = pack2(lo2f(u.y) + acc[m][n][2], hi2f(u.y) + acc[m][n][3]);
        *(uint2*)(xb + (size_t)row * 1024 + col) = o;
        const float y0 = lo2f(o.x), y1 = hi2f(o.x), y2 = lo2f(o.y), y3 = hi2f(o.y);
        const float q = y0 * y0 + y1 * y1 + y2 * y2 + y3 * y3;
        if (n < 2) ss0 += q; else ss1 += q;
      }
      float ssw = ss0 + ss1;
      ssw += __shfl_xor(ssw, 16); ssw += __shfl_xor(ssw, 32);
      if (lq == 0) ((float*)lds)[((m >> 2) * 128 + wr * 64 + (m & 3) * 16 + lr) * 4 + wc] = ssw;
      asm volatile("" ::: "memory");
    }
    __syncthreads();
    if (tid < 256) { const float4 q4 = *(const float4*)((const float*)lds + tid * 4); ssq[(size_t)nt * NR + mt * 256 + tid] = (q4.x + q4.y) + (q4.z + q4.w); }
    __syncthreads();
  }
  if (isunit) {
    const int nt = unt;
    if (tid == 0) {
      XB_SPIN(xb_ld(&tick[nt]) < (unsigned)ks, (unsigned*)(p.ws + WS_BAR));
      __builtin_amdgcn_fence(__ATOMIC_ACQUIRE, "agent");
      asm volatile("s_waitcnt vmcnt(0)" ::: "memory");
    }
    __syncthreads();
    const int rpb = (256 + ks - 1) / ks, r0 = uksi * rpb, r1 = r0 + rpb < 256 ? r0 + rpb : 256;
    const float* sl = (const float*)(p.ws + WS_SLAB) + (size_t)(nt * ks) * 65536;
    for (int rr = r0 + (tid >> 6); rr < r1; rr += 8) {
      const int c4 = tid & 63, row = 16384 + rr, col = nt * 256 + c4 * 4;
      const float* s4 = sl + rr * 256 + c4 * 4;
      float4 sum = make_float4(0.f, 0.f, 0.f, 0.f);
      for (int q = 0; q < ks; ++q) { const float4 v = *(const float4*)(s4 + (size_t)q * 65536); sum.x += v.x; sum.y += v.y; sum.z += v.z; sum.w += v.w; }
      const uint2 u2 = *(const uint2*)(xb + (size_t)row * 1024 + col);
      uint2 o;
      o.x = pack2(lo2f(u2.x) + sum.x, hi2f(u2.x) + sum.y);
      o.y = pack2(lo2f(u2.y) + sum.z, hi2f(u2.y) + sum.w);
      *(uint2*)(xb + (size_t)row * 1024 + col) = o;
      const float y0 = lo2f(o.x), y1 = hi2f(o.x), y2 = lo2f(o.y), y3 = hi2f(o.y);
      float ss = wave_sum(y0 * y0 + y1 * y1 + y2 * y2 + y3 * y3);
      if (c4 == 0) ssq[(size_t)nt * NR + row] = ss;
    }
  }
}

__device__ __forceinline__ void phase_ffn_up(const Params& p, char* lds, int layer, int site) {
  int tid, lane, w, wr, wc, lr, lq; TREFRESH();
  const bf16_t* zp = (const bf16_t*)(p.ws + WS_ZERO);
  const bf16_t* xb = (const bf16_t*)(p.ws + WS_XB);
  const bf16_t* W = (const bf16_t*)p.out + W_UP + (size_t)layer * 5632 * 1024;
  const float* ssq = (const float*)(p.ws + WS_SSQ2) + (size_t)site * 4 * NR;
  bf16_t* act = (bf16_t*)(p.ws + WS_SCR + SCR_ACT);
  const float* cw = p.in[37] + (size_t)layer * 3 * 2816;
  const float* cb = p.in[38] + (size_t)layer * 2816;
  const float* cache = p.in[7] + (size_t)layer * 128 * 2 * 2816;
  float* srs = (float*)(lds + LDS_SRS);
  TileSched ts; ts.init_even(67, 22);
  for (int ti = ts.local; ti < ts.ntiles; ti += ts.nloc) {
    int mt, nt; ts.get_even(ti, mt, nt);
    const bool smp = mt == 66;
    const int gbase = 254 * mt - 2;
    auto growf = [&](int i) -> int { if (smp) return i < 128 ? NPR + i : -1; const int g = gbase + i; return (g >= 0 && g < NPR) ? g : -1; };
    if (tid < 256) { const int gr = growf(tid); srs[tid] = gr >= 0 ? row_rstd(ssq, gr) : 0.f; }
    f32x4 acc[8][4];
    gemm_tile256(acc, xb, [&](int i) -> int { int gr = smp ? NPR + (i < 128 ? i : 127) : gbase + i; gr = gr < 0 ? 0 : (gr > NR - 1 ? NR - 1 : gr); return gr * 1024; }, W + (size_t)nt * 256 * 1024, 1024, 1024, lds, zp);
    TREFRESH(); int zE = 0; asm volatile("" : "+v"(zE));
    {
      int z0 = 0; asm volatile("" : "+v"(z0));
      bf16_t* gl = (bf16_t*)lds + z0; bf16_t* vl = gl + 256 * 136;
#pragma unroll
      for (int m = 0; m < 8; ++m) {
        const int r = (m >> 2) * 128 + wr * 64 + (m & 3) * 16 + lr + zE;
        const float rs = srs[r];
#pragma unroll
        for (int n = 0; n < 2; ++n) {
          const int ch = wc * 32 + n * 16 + lq * 4;
          uint2 og, ov;
          og.x = pack2_sw(acc[m][n][0] * rs, acc[m][n][1] * rs); og.y = pack2_sw(acc[m][n][2] * rs, acc[m][n][3] * rs);
          ov.x = pack2_sw(acc[m][n + 2][0] * rs, acc[m][n + 2][1] * rs); ov.y = pack2_sw(acc[m][n + 2][2] * rs, acc[m][n + 2][3] * rs);
          *(uint2*)(gl + r * 136 + ch) = og;
          *(uint2*)(vl + r * 136 + ch) = ov;
        }
        asm volatile("" ::: "memory");
      }
      __syncthreads();
      float wv[4][8];
      {
        const int gch0 = nt * 128 + (tid & 15) * 8;
#pragma unroll
        for (int q = 0; q < 4; ++q) {
          const float* sp = (q < 3 ? cw + q * 2816 : cb) + gch0;
          const float4 x0 = *(const float4*)sp, x1 = *(const float4*)(sp + 4);
          wv[q][0] = x0.x; wv[q][1] = x0.y; wv[q][2] = x0.z; wv[q][3] = x0.w; wv[q][4] = x1.x; wv[q][5] = x1.y; wv[q][6] = x1.z; wv[q][7] = x1.w;
        }
      }
#pragma unroll 1
      for (int it = 0; it < 8; ++it) {
        const int idx = tid + 512 * it, r = idx >> 4, c8 = (idx & 15) * 8, gch = nt * 128 + c8;
        const int g = gbase + r;
        const bool valid = smp ? (r < 128) : (r >= 2 && g < NPR);
        if (valid) {
          const int grow = smp ? NPR + r : g;
          const int b = smp ? 0 : g / TP, t = smp ? 2 : g - b * TP;
          float g0[8], g1[8], g2[8], vv[8];
          {
            const uint4 u = *(const uint4*)(gl + r * 136 + c8);
            g2[0] = lo2f(u.x); g2[1] = hi2f(u.x); g2[2] = lo2f(u.y); g2[3] = hi2f(u.y); g2[4] = lo2f(u.z); g2[5] = hi2f(u.z); g2[6] = lo2f(u.w); g2[7] = hi2f(u.w);
            const uint4 v4 = *(const uint4*)(vl + r * 136 + c8);
            vv[0] = lo2f(v4.x); vv[1] = hi2f(v4.x); vv[2] = lo2f(v4.y); vv[3] = hi2f(v4.y); vv[4] = lo2f(v4.z); vv[5] = hi2f(v4.z); vv[6] = lo2f(v4.w); vv[7] = hi2f(v4.w);
          }
          if (smp) {
            const float4 a0 = *(const float4*)(cache + (size_t)(r * 2 + 0) * 2816 + gch), a1 = *(const float4*)(cache + (size_t)(r * 2 + 0) * 2816 + gch + 4);
            const float4 b0 = *(const float4*)(cache + (size_t)(r * 2 + 1) * 2816 + gch), b1 = *(const float4*)(cache + (size_t)(r * 2 + 1) * 2816 + gch + 4);
            g0[0] = a0.x; g0[1] = a0.y; g0[2] = a0.z; g0[3] = a0.w; g0[4] = a1.x; g0[5] = a1.y; g0[6] = a1.z; g0[7] = a1.w;
            g1[0] = b0.x; g1[1] = b0.y; g1[2] = b0.z; g1[3] = b0.w; g1[4] = b1.x; g1[5] = b1.y; g1[6] = b1.z; g1[7] = b1.w;
          } else {
            uint4 u0 = make_uint4(0, 0, 0, 0), u1 = make_uint4(0, 0, 0, 0);
            if (t >= 2) u0 = *(const uint4*)(gl + (r - 2) * 136 + c8);
            if (t >= 1) u1 = *(const uint4*)(gl + (r - 1) * 136 + c8);
            g0[0] = lo2f(u0.x); g0[1] = hi2f(u0.x); g0[2] = lo2f(u0.y); g0[3] = hi2f(u0.y); g0[4] = lo2f(u0.z); g0[5] = hi2f(u0.z); g0[6] = lo2f(u0.w); g0[7] = hi2f(u0.w);
            g1[0] = lo2f(u1.x); g1[1] = hi2f(u1.x); g1[2] = lo2f(u1.y); g1[3] = hi2f(u1.y); g1[4] = lo2f(u1.z); g1[5] = hi2f(u1.z); g1[6] = lo2f(u1.w); g1[7] = hi2f(u1.w);
          }
          float ov[8];
#pragma unroll
          for (int e = 0; e < 8; ++e) ov[e] = gelu_t(wv[3][e] + wv[0][e] * g0[e] + wv[1][e] * g1[e] + wv[2][e] * g2[e]) * vv[e];
          *(uint4*)(act + (size_t)grow * 2816 + gch) = make_uint4(pack2(ov[0], ov[1]), pack2(ov[2], ov[3]), pack2(ov[4], ov[5]), pack2(ov[6], ov[7]));
          if (smp) {
            float* oc = p.out + O_FCS + (size_t)((layer * 128 + r) * 2) * 2816 + gch;
            *(float4*)oc = make_float4(g1[0], g1[1], g1[2], g1[3]); *(float4*)(oc + 4) = make_float4(g1[4], g1[5], g1[6], g1[7]);
            *(float4*)(oc + 2816) = make_float4(g2[0], g2[1], g2[2], g2[3]); *(float4*)(oc + 2820) = make_float4(g2[4], g2[5], g2[6], g2[7]);
          } else if (t >= TP - 2) {
            float* oc = p.out + O_FCP + (size_t)((layer * 8 + b) * 2 + (t - (TP - 2))) * 2816 + gch;
            *(float4*)oc = make_float4(g2[0], g2[1], g2[2], g2[3]); *(float4*)(oc + 4) = make_float4(g2[4], g2[5], g2[6], g2[7]);
          }
        }
      }
    }
    __syncthreads();
  }
}

__device__ __forceinline__ void phase_g5(const Params& p, char* lds) {
  int tid, lane, w, wr, wc, lr, lq; TREFRESH();
  const bf16_t* zp = (const bf16_t*)(p.ws + WS_ZERO);
  const bf16_t* xb = (const bf16_t*)(p.ws + WS_XB);
  const bf16_t* W = (const bf16_t*)p.out + W_IN1;
  const float* ssq = (const float*)(p.ws + WS_SSQ2) + (size_t)2 * 4 * NR;
  bf16_t* xr = (bf16_t*)(p.ws + WS_SCR + SCR_XR);
  bf16_t* gg = (bf16_t*)(p.ws + WS_SCR + SCR_GG);
  float* srs = (float*)(lds + LDS_SRS);
  if (blockIdx.x < 48) {
    const int u = blockIdx.x, nt = u >> 2, ksi = u & 3, k0 = ksi * 256;
    f32x4 acc[8][4];
    gemm_tile256(acc, xb + k0, [&](int i) { return (16384 + i) * 1024; }, W + (size_t)nt * 256 * 1024 + k0, 1024, 256, lds, zp);
    TREFRESH(); int zE = 0; asm volatile("" : "+v"(zE));
    float* slab = (float*)(p.ws + WS_SLAB) + (size_t)(nt * 4 + ksi) * 65536;
#pragma unroll
    for (int m = 0; m < 8; ++m)
#pragma unroll
      for (int n = 0; n < 4; ++n)
        *(float4*)(slab + ((m >> 2) * 128 + wr * 64 + (m & 3) * 16 + lr + zE) * 256 + (n >> 1) * 128 + wc * 32 + (n & 1) * 16 + lq * 4 + zE) = make_float4(acc[m][n][0], acc[m][n][1], acc[m][n][2], acc[m][n][3]);
    asm volatile("s_waitcnt vmcnt(0)" ::: "memory");
    __syncthreads();
    if (tid == 0) {
      __builtin_amdgcn_fence(__ATOMIC_RELEASE, "agent");
      asm volatile("s_waitcnt vmcnt(0)" ::: "memory");
      (void)xb_add((unsigned*)(p.ws + WS_FLAG) + 4416 + nt, 1u);
    }
  }
  TileSched ts; ts.init(64, 12);
  for (int ti = ts.local; ti < ts.ntiles; ti += ts.nloc) {
    int mt, nt; ts.get(ti, mt, nt);
    if (tid < 256) srs[tid] = row_rstd(ssq, mt * 256 + tid);
    f32x4 acc[8][4];
    gemm_tile256(acc, xb, [&](int i) { return (mt * 256 + i) * 1024; }, W + (size_t)nt * 256 * 1024, 1024, 1024, lds, zp);
    TREFRESH(); int zE = 0; asm volatile("" : "+v"(zE));
#pragma unroll
    for (int m = 0; m < 8; ++m) {
      const int r = (m >> 2) * 128 + wr * 64 + (m & 3) * 16 + lr + zE, row = mt * 256 + r;
      const float rs = srs[r];
#pragma unroll
      for (int n = 0; n < 4; ++n) {
        const int col = nt * 256 + (n >> 1) * 128 + wc * 32 + (n & 1) * 16 + lq * 4 + zE;
        const f32x4 v = acc[m][n] * rs;
        uint2 o;
        if (nt < 6) {
          o.x = pack2(gelu_t(v[0]), gelu_t(v[1])); o.y = pack2(gelu_t(v[2]), gelu_t(v[3]));
          *(uint2*)(gg + (size_t)row * 1536 + col) = o;
        } else {
          o.x = pack2(v[0], v[1]); o.y = pack2(v[2], v[3]);
          *(uint2*)(xr + (size_t)row * 1536 + (col - 1536)) = o;
        }
      }
    }
    __syncthreads();
  }
  if (blockIdx.x < 48) {
    const int u = blockIdx.x, nt = u >> 2, ksi = u & 3;
    if (tid == 0) {
      XB_SPIN(xb_ld((unsigned*)(p.ws + WS_FLAG) + 4416 + nt) < 4u, (unsigned*)(p.ws + WS_BAR));
      __builtin_amdgcn_fence(__ATOMIC_ACQUIRE, "agent");
      asm volatile("s_waitcnt vmcnt(0)" ::: "memory");
    }
    __syncthreads();
    const float* sl = (const float*)(p.ws + WS_SLAB) + (size_t)(nt * 4) * 65536;
    for (int rr = ksi * 64 + (tid >> 6); rr < ksi * 64 + 64; rr += 8) {
      const int c4 = tid & 63, row = 16384 + rr, col = nt * 256 + c4 * 4;
      const float* s4 = sl + rr * 256 + c4 * 4;
      const float4 s0 = *(const float4*)s4, s1 = *(const float4*)(s4 + 65536), s2 = *(const float4*)(s4 + 131072), s3 = *(const float4*)(s4 + 196608);
      const float rs = row_rstd(ssq, row);
      const float v0 = ((s0.x + s1.x) + (s2.x + s3.x)) * rs, v1 = ((s0.y + s1.y) + (s2.y + s3.y)) * rs;
      const float v2 = ((s0.z + s1.z) + (s2.z + s3.z)) * rs, v3 = ((s0.w + s1.w) + (s2.w + s3.w)) * rs;
      uint2 o;
      if (nt < 6) {
        o.x = pack2(gelu_t(v0), gelu_t(v1)); o.y = pack2(gelu_t(v2), gelu_t(v3));
        *(uint2*)(gg + (size_t)row * 1536 + col) = o;
      } else {
        o.x = pack2(v0, v1); o.y = pack2(v2, v3);
        *(uint2*)(xr + (size_t)row * 1536 + (col - 1536)) = o;
      }
    }
  }
}

__device__ __forceinline__ void rglru_item(const Params& p, int item, char* lds) {
  const int tid = threadIdx.x & 255, lane = tid & 63, w = tid >> 6, lr = lane & 15, lq = lane >> 4;
  const bool smp = item >= 4352;
  const int pass = 1;
  int b, tl, n, half;
  if (smp) { const int it = item - 4352; b = 0; tl = 0; n = it >> 1; half = it & 1; }
  else { tl = item >> 8; const int chain = item & 255; b = chain >> 5; n = (chain >> 1) & 15; half = chain & 1; }
  unsigned* flags = (unsigned*)(p.ws + WS_FLAG);
  unsigned* barw = (unsigned*)(p.ws + WS_BAR);
  const bf16_t* xr = (const bf16_t*)(p.ws + WS_SCR + SCR_XR);
  bf16_t* gg = (bf16_t*)(p.ws + WS_SCR + SCR_GG);
  const bf16_t* Wg = (const bf16_t*)p.out + W_GATE;
  const bf16_t* zp = (const bf16_t*)(p.ws + WS_ZERO);
  float* carr = (float*)(p.ws + WS_XLOC);
  char* At = lds; char* Ba = lds + 26624; char* Bx = lds + 36608;
  char* xs = lds + 46592;
  float* sa = (float*)lds; float* sbx = (float*)(lds + 24576);
  float* segA = (float*)(lds + 49152); float* segH = (float*)(lds + 49920); float* carry = (float*)(lds + 50688);
  char* ggl = lds + 51200;
  float* par = (float*)(lds + 71744);
  const int t0 = tl * 128;
  const int nvalid = smp ? 128 : (TP - t0 < 128 ? TP - t0 : 128);
  if (tid < 156) {
    const float* src;
    const int q = tid;
    if (q < 96) { const int wt = q / 24; src = p.in[27] + wt * 1536 + n * 96 + (q - wt * 24) * 4; }
    else if (q < 120) src = p.in[28] + n * 96 + (q - 96) * 4;
    else if (q < 132) src = p.in[30] + n * 96 + half * 48 + (q - 120) * 4;
    else if (q < 144) src = p.in[32] + n * 96 + half * 48 + (q - 132) * 4;
    else src = (const float*)(p.ws + WS_NSP) + n * 96 + half * 48 + (q - 144) * 4;
    __builtin_amdgcn_global_load_lds((const unsigned*)src, (unsigned*)((char*)par + q * 16), 16, 0, 0);
  }
  for (int q = tid; q < 1248; q += 256) {
    const int mat = q >= 624 ? 1 : 0, q2 = q - mat * 624, d = q2 / 13, ch = q2 - d * 13;
    const bf16_t* src = Wg + (size_t)((mat * 16 + n) * 96 + half * 48 + d) * 96 + (ch < 12 ? ch : 0) * 8;
    __builtin_amdgcn_global_load_lds((const unsigned*)src, (unsigned*)(Ba + q * 16), 16, 0, 0);
  }
  if (!smp) {
    for (int q = tid; q < 1572; q += 256) {
      const int r = q / 12, ch = q - r * 12, t = t0 + r - 3;
      const bf16_t* src = (t >= 0 && t < TP) ? xr + (size_t)(b * TP + t) * 1536 + n * 96 + ch * 8 : zp;
      __builtin_amdgcn_global_load_lds((const unsigned*)src, (unsigned*)(xs + q * 16), 16, 0, 0);
    }
  }
  asm volatile("s_waitcnt vmcnt(0)" ::: "memory");
  __syncthreads();
#pragma unroll 2
  for (int i = 0; i < 6; ++i) {
    const int idx = tid + 256 * i, r = idx / 12, ch8 = idx - r * 12, c0 = n * 96 + ch8 * 8;
    float xc[8];
    if (r < nvalid) {
      const float4 b0 = *(const float4*)(par + 384 + ch8 * 8), b1 = *(const float4*)(par + 384 + ch8 * 8 + 4);
      xc[0] = b0.x; xc[1] = b0.y; xc[2] = b0.z; xc[3] = b0.w; xc[4] = b1.x; xc[5] = b1.y; xc[6] = b1.z; xc[7] = b1.w;
#pragma unroll
      for (int wt = 0; wt < 4; ++wt) {
        float xv[8];
        if (smp && wt < 3) {
          const float4 a0 = *(const float4*)(p.in[6] + (size_t)(r * 3 + wt) * 1536 + c0), a1 = *(const float4*)(p.in[6] + (size_t)(r * 3 + wt) * 1536 + c0 + 4);
          xv[0] = a0.x; xv[1] = a0.y; xv[2] = a0.z; xv[3] = a0.w; xv[4] = a1.x; xv[5] = a1.y; xv[6] = a1.z; xv[7] = a1.w;
        } else {
          uint4 u;
          if (smp) u = *(const uint4*)(xr + (size_t)(NPR + r) * 1536 + c0);
          else u = *(const uint4*)(xs + (r + wt) * 192 + ch8 * 16);
          xv[0] = lo2f(u.x); xv[1] = hi2f(u.x); xv[2] = lo2f(u.y); xv[3] = hi2f(u.y); xv[4] = lo2f(u.z); xv[5] = hi2f(u.z); xv[6] = lo2f(u.w); xv[7] = hi2f(u.w);
        }
        const float4 w0 = *(const float4*)(par + wt * 96 + ch8 * 8), w1 = *(const float4*)(par + wt * 96 + ch8 * 8 + 4);
        xc[0] += w0.x * xv[0]; xc[1] += w0.y * xv[1]; xc[2] += w0.z * xv[2]; xc[3] += w0.w * xv[3];
        xc[4] += w1.x * xv[4]; xc[5] += w1.y * xv[5]; xc[6] += w1.z * xv[6]; xc[7] += w1.w * xv[7];
      }
    } else {
#pragma unroll
      for (int e = 0; e < 8; ++e) xc[e] = 0.f;
    }
    *(uint4*)(At + r * 208 + ch8 * 16) = make_uint4(pack2(xc[0], xc[1]), pack2(xc[2], xc[3]), pack2(xc[4], xc[5]), pack2(xc[6], xc[7]));
  }
  __syncthreads();
  if (pass == 1 && !smp) {
    for (int q = tid; q < 768; q += 256) {
      const int r = q / 6, c = q - r * 6;
      const bf16_t* src = r < nvalid ? gg + (size_t)(b * TP + t0 + r) * 1536 + n * 96 + half * 48 + c * 8 : zp;
      __builtin_amdgcn_global_load_lds((const unsigned*)src, (unsigned*)(ggl + q * 16), 16, 0, 0);
    }
  }
  f32x4 aa[2][3], ax[2][3];
#pragma unroll
  for (int m = 0; m < 2; ++m)
#pragma unroll
    for (int q = 0; q < 3; ++q) { aa[m][q] = (f32x4){0.f, 0.f, 0.f, 0.f}; ax[m][q] = (f32x4){0.f, 0.f, 0.f, 0.f}; }
#pragma unroll
  for (int s2 = 0; s2 < 3; ++s2) {
    bf16x8 a[2];
#pragma unroll
    for (int m = 0; m < 2; ++m) a[m] = *(const bf16x8*)(At + (32 * w + 16 * m + lr) * 208 + (s2 * 4 + lq) * 16);
#pragma unroll
    for (int q = 0; q < 3; ++q) {
      const bf16x8 ba = *(const bf16x8*)(Ba + (16 * q + lr) * 208 + (s2 * 4 + lq) * 16);
      const bf16x8 bx = *(const bf16x8*)(Bx + (16 * q + lr) * 208 + (s2 * 4 + lq) * 16);
#pragma unroll
      for (int m = 0; m < 2; ++m) { aa[m][q] = mfma16(ba, a[m], aa[m][q]); ax[m][q] = mfma16(bx, a[m], ax[m][q]); }
    }
  }
  uint2 xcv[2][3];
#pragma unroll
  for (int m = 0; m < 2; ++m)
#pragma unroll
    for (int q = 0; q < 3; ++q) xcv[m][q] = *(const uint2*)(At + (32 * w + 16 * m + lr) * 208 + (half * 48 + 16 * q + lq * 4) * 2);
  float4 pba[3], pbx[3], plm[3];
#pragma unroll
  for (int q = 0; q < 3; ++q) {
    pba[q] = *(const float4*)(par + 480 + 16 * q + lq * 4);
    pbx[q] = *(const float4*)(par + 528 + 16 * q + lq * 4);
    plm[q] = *(const float4*)(par + 576 + 16 * q + lq * 4);
  }
  __syncthreads();
#pragma unroll
  for (int m = 0; m < 2; ++m) {
    const int row = 32 * w + 16 * m + lr;
#pragma unroll
    for (int q = 0; q < 3; ++q) {
      const int d0 = 16 * q + lq * 4;
      const float bav[4] = {pba[q].x, pba[q].y, pba[q].z, pba[q].w}, bxv[4] = {pbx[q].x, pbx[q].y, pbx[q].z, pbx[q].w}, lmv[4] = {plm[q].x, plm[q].y, plm[q].z, plm[q].w};
      const float xcf[4] = {lo2f(xcv[m][q].x), hi2f(xcv[m][q].x), lo2f(xcv[m][q].y), hi2f(xcv[m][q].y)};
      float av[4], bv[4];
#pragma unroll
      for (int e = 0; e < 4; ++e) {
        const float r_ = sigm(aa[m][q][e] + bav[e]);
        const float i_ = sigm(ax[m][q][e] + bxv[e]);
        const float la = r_ * lmv[e];
        float a = __expf(la);
        float bxx = __builtin_sqrtf(fmaxf(1.f - a * a, 0.f)) * (i_ * xcf[e]);
        if (row >= nvalid) { a = 1.f; bxx = 0.f; }
        av[e] = a; bv[e] = bxx;
      }
      *(float4*)(sa + row * 48 + d0) = make_float4(av[0], av[1], av[2], av[3]);
      *(float4*)(sbx + row * 48 + d0) = make_float4(bv[0], bv[1], bv[2], bv[3]);
    }
  }
  __syncthreads();
  if (smp) {
    for (int idx = tid; idx < 128 * 48; idx += 256) {
      const int row = idx / 48, ch = idx - row * 48, cgl = n * 96 + half * 48 + ch;
      const float hh = sa[idx] * p.in[5][row * 1536 + cgl] + sbx[idx];
      p.out[O_HS + row * 1536 + cgl] = hh;
      const size_t go = (size_t)(NPR + row) * 1536 + cgl;
      gg[go] = f2bf(hh * bf2f(gg[go]));
    }
  } else {
    const int ch = tid % 48, seg = tid / 48;
    if (tid < 192) {
      float A = 1.f, H = 0.f;
#pragma unroll 8
      for (int r = seg * 32; r < seg * 32 + 32; ++r) { const float a = sa[r * 48 + ch]; H = a * H + sbx[r * 48 + ch]; A *= a; }
      segA[seg * 48 + ch] = A; segH[seg * 48 + ch] = H;
    }
    asm volatile("s_waitcnt vmcnt(0)" ::: "memory");
    __syncthreads();
    {
      float At_ = 1.f, Ht_ = 0.f;
      if (tid < 48) {
#pragma unroll
        for (int s2 = 0; s2 < 4; ++s2) { Ht_ = segA[s2 * 48 + tid] * Ht_ + segH[s2 * 48 + tid]; At_ *= segA[s2 * 48 + tid]; }
      }
      if (tl > 0 && tid == 0) XB_SPIN(xb_ld(&flags[item - 256]) == 0u, barw);
      __syncthreads();
      if (tid < 48) {
        const int cgl = n * 96 + half * 48 + tid;
        float h0 = 0.f;
        if (tl > 0) h0 = __hip_atomic_load(&carr[(size_t)((b * 17 + tl - 1) * 32 + n * 2 + half) * 64 + tid], __ATOMIC_RELAXED, __HIP_MEMORY_SCOPE_AGENT);
        carry[tid] = h0;
        const float hend = At_ * h0 + Ht_;
        if (tl < 16) __hip_atomic_store(&carr[(size_t)((b * 17 + tl) * 32 + n * 2 + half) * 64 + tid], hend, __ATOMIC_RELAXED, __HIP_MEMORY_SCOPE_AGENT);
        else p.out[O_HP + b * 1536 + cgl] = hend;
      }
      asm volatile("s_waitcnt vmcnt(0)" ::: "memory");
      __syncthreads();
      if (tid == 0 && tl < 16) (void)xb_add(&flags[item], 1u);
    }
    if (tid < 192) {
      float hin = carry[ch];
      for (int s2 = 0; s2 < seg; ++s2) hin = segA[s2 * 48 + ch] * hin + segH[s2 * 48 + ch];
      const int cgl = n * 96 + half * 48 + ch;
#pragma unroll 8
      for (int r = seg * 32; r < seg * 32 + 32; ++r) {
        hin = sa[r * 48 + ch] * hin + sbx[r * 48 + ch];
        if (r < nvalid) gg[(size_t)(b * TP + t0 + r) * 1536 + cgl] = f2bf(hin * bf2f(*(const bf16_t*)(ggl + r * 96 + ch * 2)));
      }
    }
  }
  if (pass == 1) {
    if (!smp) {
      if (tl == 16 && half == 0 && tid < 96) {
#pragma unroll
        for (int wv = 0; wv < 3; ++wv) p.out[O_RCP + (b * 3 + wv) * 1536 + n * 96 + tid] = bf2f(xr[(size_t)(b * TP + TP - 3 + wv) * 1536 + n * 96 + tid]);
      }
    } else if (half == 0) {
      for (int idx = tid; idx < 128 * 96; idx += 256) {
        const int s2 = idx / 96, cc_ = idx - s2 * 96, cgl = n * 96 + cc_;
        p.out[O_RCS + (size_t)(s2 * 3 + 0) * 1536 + cgl] = p.in[6][(size_t)(s2 * 3 + 1) * 1536 + cgl];
        p.out[O_RCS + (size_t)(s2 * 3 + 1) * 1536 + cgl] = p.in[6][(size_t)(s2 * 3 + 2) * 1536 + cgl];
        p.out[O_RCS + (size_t)(s2 * 3 + 2) * 1536 + cgl] = bf2f(xr[(size_t)(NPR + s2) * 1536 + cgl]);
      }
    }
  }
  __syncthreads();
}

__device__ __forceinline__ void phase_final(const Params& p) {
  const int tid = threadIdx.x, lane = tid & 63;
  const bf16_t* xres = (const bf16_t*)(p.ws + WS_XB);
  const float* ssq = (const float*)(p.ws + WS_SSQ2);
  const int gw = blockIdx.x * 8 + (tid >> 6), nw = gridDim.x * 8;
  for (int r = gw; r < NR; r += nw) {
    float* dst;
    if (r >= NPR) dst = p.out + O_YS + (size_t)(r - NPR) * 1024;
    else { const int b = r / TP, t = r - b * TP; if (t < 16) continue; dst = p.out + O_YP + ((size_t)b * 2048 + (t - 16)) * 1024; }
    float s = lane < 4 ? ssq[(size_t)lane * NR + r] : 0.f;
    s = wave_sum(s);
    const float rstd = rsqrtf(s * (1.f / 1024.f) + EPSN);
    const uint2* src = (const uint2*)(xres + (size_t)r * 1024);
    const float4* nf = (const float4*)p.in[40];
#pragma unroll
    for (int j = 0; j < 4; ++j) {
      const uint2 u = src[lane + 64 * j];
      const float4 v = make_float4(lo2f(u.x), hi2f(u.x), lo2f(u.y), hi2f(u.y)), g = nf[lane + 64 * j];
      ((float4*)dst)[lane + 64 * j] = make_float4(v.x * rstd * g.x, v.y * rstd * g.y, v.z * rstd * g.z, v.w * rstd * g.w);
    }
  }
}

__global__ void __launch_bounds__(512, 2) mega_kernel(Params p) {
  extern __shared__ __attribute__((aligned(16))) char lds[];
  cg::grid_group grid = cg::this_grid();
  const bf16_t* wb = (const bf16_t*)p.out;
  volatile LAS unsigned* xst_ = (volatile LAS unsigned*)(lds + LDS_ST);
  if (threadIdx.x < 4) xst_[threadIdx.x] = 0u;
  __syncthreads();
  XcdBarrier xbar = xcd_barrier_post((unsigned*)(p.ws + WS_BAR), xst_);
  if (p.ph_hi > 1000) grid.sync();
#define PH(k, body) if (p.ph_lo <= (k) && (k) < p.ph_hi) { body; } if (p.ph_lo <= (k) && (k) + 1 < p.ph_hi) xcd_barrier(xbar);
  PH(0, phase_prep(p, lds))
  PH(1, phase_g1(p, lds))
  PH(2, phase_mix_a(p, lds))
  PH(3, phase_mix_b(p))
  PH(4, phase_mix_c(p, lds))
  PH(5, phase_glu(p, lds))
  PH(6, phase_resid(p, lds, (const bf16_t*)(p.ws + WS_SCR + SCR_ZB) + 512, 2048, wb + W_OUT0, 1024, 0, 1))
  PH(7, phase_ffn_up(p, lds, 0, 1))
  PH(8, phase_resid(p, lds, (const bf16_t*)(p.ws + WS_SCR + SCR_ACT), 2816, wb + W_DOWN, 2816, 16, 2))
  PH(9, phase_g5(p, lds))
  PH(10, for (int pr = blockIdx.x; pr < 2192; pr += gridDim.x) rglru_item(p, pr * 2 + (threadIdx.x >> 8), lds + (threadIdx.x >> 8) * HALF_LDS))
  PH(11, phase_resid(p, lds, (const bf16_t*)(p.ws + WS_SCR + SCR_GG), 1536, wb + W_OUT1, 1536, 32, 3))
  PH(12, phase_ffn_up(p, lds, 1, 3))
  PH(13, phase_resid(p, lds, (const bf16_t*)(p.ws + WS_SCR + SCR_ACT), 2816, wb + W_DOWN + (size_t)1024 * 2816, 2816, 48, 0))
  PH(14, phase_final(p))
}

extern "C" void kernel_launch(void* const* d_in, const int* in_sizes, int n_in, void* d_out, int out_size, void* d_ws, size_t ws_size, hipStream_t stream) {
  static int grid_blocks = 0;
  if (!grid_blocks) {
    int dev = 0, cus = 0, per_cu = 0;
    hipGetDevice(&dev);
    hipDeviceGetAttribute(&cus, hipDeviceAttributeMultiprocessorCount, dev);
    hipFuncSetAttribute((const void*)mega_kernel, hipFuncAttributeMaxDynamicSharedMemorySize, LDS_BYTES);
    hipOccupancyMaxActiveBlocksPerMultiprocessor(&per_cu, (const void*)mega_kernel, NTHR, LDS_BYTES);
    if (per_cu > 1) per_cu = 1;
    if (per_cu < 1) per_cu = 1;
    grid_blocks = cus * per_cu;
    if (n_in != 41 || ws_size < WS_NEED) fprintf(stderr, "kernel_launch: unexpected n_in %d or ws_size %zu (need %llu)\n", n_in, ws_size, (unsigned long long)WS_NEED);
  }
  Params p{};
  for (int i = 0; i < 41; ++i) p.in[i] = (const float*)d_in[i];
  p.out = (float*)d_out;
  p.ws = (char*)d_ws;
  (void)hipMemsetAsync((char*)d_ws + WS_BAR, 0, 16384, stream);
  (void)hipMemsetAsync((char*)d_ws + WS_FLAG, 0, 20480, stream);
#if MK_MULTI
  for (int ph = 0; ph < NPHASE; ++ph) {
    p.ph_lo = ph; p.ph_hi = ph + 1;
    hipLaunchKernelGGL(mega_kernel, dim3(grid_blocks), dim3(NTHR), LDS_BYTES, stream, p);
  }
#else
  p.ph_lo = 0; p.ph_hi = NPHASE;
  void* args[] = {&p};
  hipError_t e = hipLaunchCooperativeKernel((const void*)mega_kernel, dim3(grid_blocks), dim3(NTHR), args, LDS_BYTES, stream);
  if (e != hipSuccess) fprintf(stderr, "cooperative launch failed: %s (grid %d)\n", hipGetErrorString(e), grid_blocks);
#endif
}
```

```cpp
#include <hip/hip_runtime.h>
#include <hip/hip_cooperative_groups.h>
#include <stdint.h>
#include <stdio.h>
namespace cg = cooperative_groups;

#ifndef MK_MULTI
#define MK_MULTI 0
#endif

#define LAS __attribute__((address_space(3)))
typedef unsigned short bf16_t;
typedef __attribute__((ext_vector_type(8))) short bf16x8;
typedef __attribute__((ext_vector_type(4))) float f32x4;

#define TP 2064
#define NPR 16512
#define NR 16640
#define EPSN 1e-6f
#define NPHASE 15
#define LDS_BYTES 153600
#define HALF_LDS 75776
#define LDS_SRS 151552
#define LDS_ST 152576
#define LDS_TKL 152592
#define NTHR 512

#define O_YP 0
#define O_YS 16777216
#define O_GLAP 16908288
#define O_GLAS 17170432
#define O_S5RP 21364736
#define O_S5RS 21381120
#define O_S5IP 21643264
#define O_S5IS 21659648
#define O_HP 21921792
#define O_HS 21934080
#define O_RCP 22130688
#define O_RCS 22167552
#define O_FCP 22757376
#define O_FCS 22847488

#define W_IN0 0
#define W_GLU 2359296
#define W_OUT0 2621440
#define W_UP 3670016
#define W_DOWN 15204352
#define W_IN1 20971520
#define W_OUT1 24117248
#define W_GATE 25690112

#define WS_XB 0ull
#define WS_XRES 34078720ull
#define WS_SSQ 102236160ull
#define WS_S5AB 106496000ull
#define WS_S5BB 106545152ull
#define WS_S5CC 106807296ull
#define WS_XLOC 106938368ull
#define WS_XST 111263744ull
#define WS_DEC 115589120ull
#define WS_SCR 115859456ull
#define SCR_ZB 0ull
#define SCR_ALOG 68157440ull
#define SCR_SLOC 85196800ull
#define SCR_ACT 0ull
#define SCR_XR 0ull
#define SCR_GG 51118080ull
#define WS_BAR (WS_SCR + 119799808ull)
#define WS_ZERO (WS_BAR + 15360ull)
#define WS_NSP (WS_BAR + 16384ull)
#define WS_SLAB (WS_NSP + 8192ull)
#define WS_FLAG (WS_SLAB + 12582912ull)
#define WS_SSQ2 (WS_FLAG + 20480ull)
#define WS_NEED (WS_SSQ2 + 8519680ull)

struct Params {
  const float* in[41];
  float* out;
  char* ws;
  int ph_lo, ph_hi;
};

__device__ __forceinline__ bf16_t f2bf(float f) { uint32_t u = __float_as_uint(f); u += 0x7fffu + ((u >> 16) & 1u); return (bf16_t)(u >> 16); }
__device__ __forceinline__ float bf2f(bf16_t h) { return __uint_as_float(((uint32_t)h) << 16); }
__device__ __forceinline__ uint32_t pack2(float a, float b) { uint32_t r; asm("v_cvt_pk_bf16_f32 %0, %1, %2" : "=v"(r) : "v"(a), "v"(b)); return r; }
__device__ __forceinline__ uint32_t pack2_sw(float a, float b) { return (uint32_t)f2bf(a) | ((uint32_t)f2bf(b) << 16); }
__device__ __forceinline__ float lo2f(uint32_t u) { return __uint_as_float(u << 16); }
__device__ __forceinline__ float hi2f(uint32_t u) { return __uint_as_float(u & 0xffff0000u); }
__device__ __forceinline__ float sigm(float x) { return __builtin_amdgcn_rcpf(1.f + __expf(-x)); }
__device__ __forceinline__ float gelu_t(float x) { const float u = x * (1.5957691216f + 0.0713548162726f * x * x); return x * __builtin_amdgcn_rcpf(1.f + __expf(-u)); }
__device__ __forceinline__ float softplusf_(float x) { return fmaxf(x, 0.f) + __logf(1.f + __expf(-fabsf(x))); }
__device__ __forceinline__ float wave_sum(float v) {
#pragma unroll
  for (int o = 1; o < 64; o <<= 1) v += __shfl_xor(v, o);
  return v;
}
__device__ __forceinline__ int toff(int row, int chunk) { return row * 128 + ((chunk ^ (row & 7)) << 4); }
__device__ __forceinline__ f32x4 mfma16(bf16x8 a, bf16x8 b, f32x4 c) { return __builtin_amdgcn_mfma_f32_16x16x32_bf16(a, b, c, 0, 0, 0); }

__device__ __forceinline__ const float* xrow_src(const Params& p, int r) {
  if (r >= NPR) return p.in[1] + (size_t)(r - NPR) * 1024;
  int b = r / TP, t = r - b * TP;
  return t < 16 ? p.in[8] + t * 1024 : p.in[0] + ((size_t)b * 2048 + (t - 16)) * 1024;
}

#define TREFRESH() do { tid = threadIdx.x; asm volatile("" : "+v"(tid)); lane = tid & 63; w = tid >> 6; wr = w >> 2; wc = w & 3; lr = lane & 15; lq = lane >> 4; (void)w; (void)lane; } while (0)
__device__ __forceinline__ int lds_byte8(int r, int c) { const int st = (r >> 4) * 2 + (c >> 5), rr = r & 15, cc = c & 31, ob = rr * 64 + cc * 2; return st * 1024 + (ob ^ (((ob >> 9) & 1) << 5)); }
__device__ __forceinline__ void stage_rc8(int b, int& R, int& C) { const int st = b / 1024, sb = b % 1024, swz = sb ^ (((sb >> 9) & 1) << 5); R = (st >> 1) * 16 + swz / 64; C = (st & 1) * 32 + (swz % 64) / 2; }
template <class AF>
__device__ __forceinline__ void gemm_tile256(f32x4 (&acc)[8][4], const bf16_t* Ab, AF arow, const bf16_t* Bt, int ldb, int K, char* lds, const bf16_t* zpage) {
  const int wid = threadIdx.x >> 6, lane = threadIdx.x & 63, wr = wid >> 2, wc = wid & 3, fr = lane & 15, fq = lane >> 4;
#pragma unroll
  for (int m = 0; m < 8; ++m)
#pragma unroll
    for (int n = 0; n < 4; ++n) acc[m][n] = (f32x4){0.f, 0.f, 0.f, 0.f};
  int ao[2][2], bo[2][2];
#pragma unroll
  for (int i = 0; i < 2; ++i) {
    int r_, c_; stage_rc8(threadIdx.x * 16 + i * 8192, r_, c_);
#pragma unroll
    for (int h = 0; h < 2; ++h) {
      const int a = arow(h * 128 + r_);
      ao[h][i] = (a + c_) * 2;
      bo[h][i] = ((h * 128 + r_) * ldb + c_) * 2;
      asm volatile("" : "+v"(ao[h][i]), "+v"(bo[h][i]));
    }
  }
  char* lth = lds + threadIdx.x * 16;
  const __amdgpu_buffer_rsrc_t rA = __builtin_amdgcn_make_buffer_rsrc((void*)const_cast<bf16_t*>(Ab), (short)0, 0x7fffffff, 0x00020000);
  const __amdgpu_buffer_rsrc_t rB = __builtin_amdgcn_make_buffer_rsrc((void*)const_cast<bf16_t*>(Bt), (short)0, 0x7fffffff, 0x00020000);
#define SA8(b, h) (((b) * 2 + (h)) * 16384)
#define SB8(b, h) ((4 + (b) * 2 + (h)) * 16384)
#define STG_A(P, h, kt) do { _Pragma("unroll") for (int i_ = 0; i_ < 2; ++i_) \
    __builtin_amdgcn_raw_ptr_buffer_load_lds(rA, (LAS void*)(lth + (P) + i_ * 8192), 16, ao[h][i_], (kt) * 128, 0, 0); } while (0)
#define STG_B(P, h, kt) do { _Pragma("unroll") for (int i_ = 0; i_ < 2; ++i_) \
    __builtin_amdgcn_raw_ptr_buffer_load_lds(rB, (LAS void*)(lth + (P) + i_ * 8192), 16, bo[h][i_], (kt) * 128, 0, 0); } while (0)
#define LDA8(dst, b, h) do { _Pragma("unroll") for (int m = 0; m < 4; ++m) _Pragma("unroll") for (int k = 0; k < 2; ++k) \
    dst[m][k] = *(const bf16x8*)(lds + SA8(b, h) + lds_byte8(wr * 64 + m * 16 + fr, k * 32 + fq * 8)); } while (0)
#define LDB8(dst, b, h) do { _Pragma("unroll") for (int n = 0; n < 2; ++n) _Pragma("unroll") for (int k = 0; k < 2; ++k) \
    dst[n][k] = *(const bf16x8*)(lds + SB8(b, h) + lds_byte8(wc * 32 + n * 16 + fr, k * 32 + fq * 8)); } while (0)
#define MMA8(ai, bj, Ax, Bx) do { __builtin_amdgcn_s_setprio(1); \
    _Pragma("unroll") for (int m = 0; m < 4; ++m) _Pragma("unroll") for (int n = 0; n < 2; ++n) _Pragma("unroll") for (int k = 0; k < 2; ++k) \
      acc[(ai) * 4 + m][(bj) * 2 + n] = mfma16(Bx[n][k], Ax[m][k], acc[(ai) * 4 + m][(bj) * 2 + n]); \
    __builtin_amdgcn_s_setprio(0); } while (0)
#define WAIT_V(n) asm volatile("s_waitcnt vmcnt(" #n ")" ::: "memory")
#define WAIT_L(n) asm volatile("s_waitcnt lgkmcnt(" #n ")" ::: "memory")
#define BAR8 __builtin_amdgcn_s_barrier()
#define SCHED8 __builtin_amdgcn_sched_barrier(0)
  bf16x8 At[4][2], B0[2][2], B1[2][2];
  const int nt = K >> 6;
  STG_B(SB8(0, 0), 0, 0); STG_A(SA8(0, 0), 0, 0);
  STG_B(SB8(0, 1), 1, 0); STG_A(SA8(0, 1), 1, 0);
  if (wr == 1) BAR8;
  WAIT_V(4); BAR8;
  STG_B(SB8(1, 0), 0, 1); STG_A(SA8(1, 0), 0, 1); STG_B(SB8(1, 1), 1, 1);
  WAIT_V(6); BAR8;
  for (int t = 0; t < nt - 2; t += 2) {
    LDB8(B0, 0, 0); SCHED8; LDA8(At, 0, 0); STG_A(SA8(1, 1), 1, t + 1);
    WAIT_L(8); BAR8; WAIT_L(0); MMA8(0, 0, At, B0); BAR8; SCHED8;
    LDB8(B1, 0, 1); STG_B(SB8(0, 0), 0, t + 2);
    BAR8; WAIT_L(0); MMA8(0, 1, At, B1); BAR8;
    LDA8(At, 0, 1); STG_A(SA8(0, 0), 0, t + 2);
    BAR8; WAIT_L(0); MMA8(1, 0, At, B0); BAR8; SCHED8;
    STG_B(SB8(0, 1), 1, t + 2);
    WAIT_V(6); BAR8; MMA8(1, 1, At, B1); BAR8;
    LDB8(B0, 1, 0); SCHED8; LDA8(At, 1, 0); STG_A(SA8(0, 1), 1, t + 2);
    WAIT_L(8); BAR8; WAIT_L(0); MMA8(0, 0, At, B0); BAR8; SCHED8;
    LDB8(B1, 1, 1); STG_B(SB8(1, 0), 0, t + 3);
    BAR8; WAIT_L(0); MMA8(0, 1, At, B1); BAR8;
    LDA8(At, 1, 1); STG_A(SA8(1, 0), 0, t + 3);
    BAR8; WAIT_L(0); MMA8(1, 0, At, B0); BAR8; SCHED8;
    STG_B(SB8(1, 1), 1, t + 3);
    WAIT_V(6); BAR8; MMA8(1, 1, At, B1); BAR8;
  }
  { LDB8(B0, 0, 0); LDA8(At, 0, 0); STG_A(SA8(1, 1), 1, nt - 1);
    BAR8; WAIT_L(0); MMA8(0, 0, At, B0); BAR8;
    LDB8(B1, 0, 1); BAR8; WAIT_L(0); MMA8(0, 1, At, B1); BAR8;
    LDA8(At, 0, 1); WAIT_V(4); BAR8; WAIT_L(0); MMA8(1, 0, At, B0); MMA8(1, 1, At, B1); BAR8; }
  { LDB8(B0, 1, 0); LDA8(At, 1, 0); WAIT_V(2); BAR8; WAIT_L(0); MMA8(0, 0, At, B0); BAR8;
    LDB8(B1, 1, 1); WAIT_V(0); BAR8; WAIT_L(0); MMA8(0, 1, At, B1); BAR8;
    LDA8(At, 1, 1); BAR8; WAIT_L(0); MMA8(1, 0, At, B0); MMA8(1, 1, At, B1); BAR8; }
  if (wr == 0) BAR8;
#undef SA8
#undef SB8
#undef STG_A
#undef STG_B
#undef LDA8
#undef LDB8
#undef MMA8
  __syncthreads();
}

#define XB_TMO      128
#define XB_XCNT(j)  (256  + 64 * (j))
#define XB_XSUB(j)  (1280 + 64 * (j))
#define XB_XGEN(j)  (2304 + 64 * (j))
#define XB_TOP      3328
#define XB_TOPGEN   3392
#define XCD_BAR_WORDS 3456
#define XB_SPIN_CAP (1u << 22)
__device__ __forceinline__ unsigned xb_ld(unsigned* p)              { return __hip_atomic_load(p, __ATOMIC_RELAXED, __HIP_MEMORY_SCOPE_AGENT); }
__device__ __forceinline__ unsigned xb_add(unsigned* p, unsigned v) { return __hip_atomic_fetch_add(p, v, __ATOMIC_RELAXED, __HIP_MEMORY_SCOPE_AGENT); }
__device__ __forceinline__ unsigned xb_xcc_id() { return (unsigned)__builtin_amdgcn_s_getreg((3 << 11) | 20) & 0xFu; }
#define XB_SPIN(cond, bar) do { unsigned _sp = 0; while (cond) { __builtin_amdgcn_s_sleep(1); \
    if ((++_sp & 255u) == 0u) { if (xb_ld(&(bar)[XB_TMO])) break; if (_sp > XB_SPIN_CAP) { atomicAdd(&(bar)[XB_TMO], 1u); break; } } } } while (0)
struct XcdBarrier { unsigned* bar; unsigned x; volatile LAS unsigned* st; };
__device__ __forceinline__ XcdBarrier xcd_barrier_post(unsigned* bar, volatile LAS unsigned* st) {
    XcdBarrier b; b.bar = bar; b.x = xb_xcc_id(); b.st = st;
    if (threadIdx.x == 0) (void)xb_add(&bar[XB_XCNT(b.x)], 1u);
    return b;
}
__device__ __forceinline__ void xcd_barrier_complete(unsigned* bar, unsigned x, unsigned& nloc, unsigned& nx) {
    const unsigned G = gridDim.x * gridDim.y * gridDim.z;
    unsigned sum, cnt, mine, sp = 0u;
    for (;;) {
        sum = 0u; cnt = 0u; mine = 0u;
#pragma unroll
        for (unsigned j = 0; j < 16; ++j) { const unsigned c = xb_ld(&bar[XB_XCNT(j)]); sum += c; cnt += (c > 0u) ? 1u : 0u; mine = (j == x) ? c : mine; }
        if (sum == G) break;
        __builtin_amdgcn_s_sleep(1);
        if ((++sp & 255u) == 0u) { if (xb_ld(&bar[XB_TMO])) break; if (sp > XB_SPIN_CAP) { atomicAdd(&bar[XB_TMO], 1u); break; } }
    }
    nloc = mine > 0u ? mine : 1u; nx = cnt > 0u ? cnt : 1u;
}
__device__ __forceinline__ void xcd_barrier(const XcdBarrier& b) {
    asm volatile("s_waitcnt vmcnt(0)" ::: "memory");
    __syncthreads();
    if (threadIdx.x == 0) {
        unsigned* bar = b.bar;
        __builtin_amdgcn_s_waitcnt(0);
        unsigned nloc = b.st[0], nx = b.st[1];
        if (nloc == 0u) { xcd_barrier_complete(bar, b.x, nloc, nx); b.st[0] = nloc; b.st[1] = nx; }
        const unsigned old = xb_add(&bar[XB_XSUB(b.x)], 1u);
        const unsigned gen = old / nloc;
        if (old + 1u == (gen + 1u) * nloc) {
            __builtin_amdgcn_fence(__ATOMIC_RELEASE, "agent");
            asm volatile("s_waitcnt vmcnt(0)" ::: "memory");
            const unsigned og = xb_add(&bar[XB_TOP], 1u);
            const unsigned tg = og / nx;
            if (og + 1u == (tg + 1u) * nx) xb_add(&bar[XB_TOPGEN], 1u);
            else XB_SPIN(xb_ld(&bar[XB_TOPGEN]) == tg, bar);
            __builtin_amdgcn_fence(__ATOMIC_ACQUIRE, "agent");
            xb_add(&bar[XB_XGEN(b.x)], 1u);
            asm volatile("s_waitcnt vmcnt(0)" ::: "memory");
        } else {
            XB_SPIN(xb_ld(&bar[XB_XGEN(b.x)]) == gen, bar);
            __builtin_amdgcn_fence(__ATOMIC_ACQUIRE, "agent");
            asm volatile("s_waitcnt vmcnt(0)" ::: "memory");
        }
    }
    __syncthreads();
}


struct TileSched {
  int NT, m0, cnt, ntiles, nfull, local, nloc;
  __device__ __forceinline__ void init(int MT, int NT_) {
    NT = NT_;
    const int x = blockIdx.x & 7; local = blockIdx.x >> 3; nloc = gridDim.x >> 3;
    const int q = MT >> 3, r = MT & 7;
    cnt = q + (x < r ? 1 : 0); m0 = x * q + (x < r ? x : r);
    ntiles = cnt * NT; nfull = cnt >> 3;
  }
  int MTe, lin0;
  __device__ __forceinline__ void init_even(int MT, int NT_) {
    NT = NT_; MTe = MT;
    const int x = blockIdx.x & 7; local = blockIdx.x >> 3; nloc = gridDim.x >> 3;
    const int T = MT * NT_;
    lin0 = (int)(((long)T * x) >> 3);
    ntiles = (int)(((long)T * (x + 1)) >> 3) - lin0;
  }
  __device__ __forceinline__ void get_even(int i, int& mt, int& nt) const {
    const int L = lin0 + i, nfullg = MTe >> 3, full = nfullg * 8 * NT;
    if (L < full) { const int grp = L / (8 * NT), rem = L - grp * 8 * NT; nt = rem >> 3; mt = grp * 8 + (rem & 7); }
    else { const int i2 = L - full, gs = MTe - nfullg * 8; nt = i2 / gs; mt = nfullg * 8 + (i2 - nt * gs); }
  }
  __device__ __forceinline__ void get(int i, int& mt, int& nt) const {
    const int full = nfull * 8 * NT;
    if (i < full) { const int grp = i / (8 * NT), rem = i - grp * 8 * NT; nt = rem >> 3; mt = m0 + grp * 8 + (rem & 7); }
    else { const int i2 = i - full, gs = cnt - nfull * 8; nt = i2 / gs; mt = m0 + nfull * 8 + (i2 - nt * gs); }
  }
};

__device__ __forceinline__ float row_rstd(const float* ssq, int row) {
  float s = 0.f;
#pragma unroll
  for (int q = 0; q < 4; ++q) s += ssq[(size_t)q * NR + row];
  return rsqrtf(s * (1.f / 1024.f) + EPSN);
}

__device__ __forceinline__ void transpose_mat(const float* src, int ldsrc, int K, int N, bf16_t* dst, const float* scale, int kind, float* sm) {
  const int tid = threadIdx.x & 255;
  sm += (threadIdx.x >> 8) * 8448;
  const int nnb = N >> 7, ntile = (K >> 6) * nnb;
  for (int tile2 = blockIdx.x; tile2 < (ntile >> 1); tile2 += gridDim.x) {
    const int tile = tile2 * 2 + (threadIdx.x >> 8);
    const int kb = tile / nnb, nb4 = tile - kb * nnb;
    const int i = tid >> 3, j4 = tid & 7;
    float4 v[4][2];
#pragma unroll
    for (int sub = 0; sub < 4; ++sub) {
      const int nb = nb4 * 4 + sub;
      int scol;
      if (kind == 0) scol = nb * 32;
      else if (kind == 1) scol = nb * 32 < 1536 ? nb * 32 : nb * 32 + 16;
      else { int j = nb >> 3, half = (nb >> 2) & 1; scol = half * 2816 + j * 128 + (nb & 3) * 32; }
#pragma unroll
      for (int r = 0; r < 2; ++r) v[sub][r] = *(const float4*)(src + (size_t)(kb * 64 + i + 32 * r) * ldsrc + scol + j4 * 4);
    }
    const float sc0 = scale ? scale[kb * 64 + i] : 1.f, sc1 = scale ? scale[kb * 64 + i + 32] : 1.f;
#pragma unroll
    for (int sub = 0; sub < 4; ++sub) {
#pragma unroll
      for (int r = 0; r < 2; ++r) {
        const float sc = r ? sc1 : sc0;
        float* d = sm + sub * 2112 + (i + 32 * r) * 33 + j4 * 4;
        d[0] = v[sub][r].x * sc; d[1] = v[sub][r].y * sc; d[2] = v[sub][r].z * sc; d[3] = v[sub][r].w * sc;
      }
    }
    __syncthreads();
    {
      const int n = tid >> 3, kq = tid & 7;
#pragma unroll
      for (int sub = 0; sub < 4; ++sub) {
        const float* s2 = sm + sub * 2112 + (kq * 8) * 33 + n;
        uint4 o;
        o.x = pack2(s2[0], s2[33]); o.y = pack2(s2[66], s2[99]); o.z = pack2(s2[132], s2[165]); o.w = pack2(s2[198], s2[231]);
        *(uint4*)(dst + (size_t)((nb4 * 4 + sub) * 32 + n) * K + kb * 64 + kq * 8) = o;
      }
    }
    __syncthreads();
  }
}

__device__ __forceinline__ void phase_prep(const Params& p, char* lds) {
  const int tid = threadIdx.x, lane = tid & 63;
  bf16_t* wb = (bf16_t*)p.out;
  {
    bf16_t* xb = (bf16_t*)(p.ws + WS_XB);
    float* ssq = (float*)(p.ws + WS_SSQ2);
    const int gw = blockIdx.x * 8 + (tid >> 6), nw = gridDim.x * 8;
    for (int r = gw; r < NR; r += nw) {
      const float4* src = (const float4*)xrow_src(p, r);
      float s = 0.f;
#pragma unroll
      for (int j = 0; j < 4; ++j) {
        float4 v = src[lane + 64 * j];
        s += v.x * v.x + v.y * v.y + v.z * v.z + v.w * v.w;
        uint2 o; o.x = pack2(v.x, v.y); o.y = pack2(v.z, v.w);
        *(uint2*)(xb + (size_t)r * 1024 + (lane + 64 * j) * 4) = o;
      }
      s = wave_sum(s);
      if (lane < 4) ssq[(size_t)lane * NR + r] = lane == 0 ? s : 0.f;
    }
  }
  float* sm = (float*)lds;
  transpose_mat(p.in[10], 2064, 1024, 2048, wb + W_IN0, p.in[9], 1, sm);
  transpose_mat(p.in[22], 512, 512, 512, wb + W_GLU, nullptr, 0, sm);
  transpose_mat(p.in[24], 1024, 1024, 1024, wb + W_OUT0, nullptr, 0, sm);
  transpose_mat(p.in[36], 5632, 1024, 5632, wb + W_UP, p.in[35], 2, sm);
  transpose_mat(p.in[36] + (size_t)1024 * 5632, 5632, 1024, 5632, wb + W_UP + (size_t)5632 * 1024, p.in[35] + 1024, 2, sm);
  transpose_mat(p.in[39], 1024, 2816, 1024, wb + W_DOWN, nullptr, 0, sm);
  transpose_mat(p.in[39] + (size_t)2816 * 1024, 1024, 2816, 1024, wb + W_DOWN + (size_t)1024 * 2816, nullptr, 0, sm);
  transpose_mat(p.in[26], 3072, 1024, 3072, wb + W_IN1, p.in[25], 0, sm);
  transpose_mat(p.in[34], 1024, 1536, 1024, wb + W_OUT1, nullptr, 0, sm);
  const int gt = blockIdx.x * 512 + tid, ngt = gridDim.x * 512;
  for (int idx = gt; idx < 256 * 1024; idx += ngt) {
    const int c = idx >> 10, k = idx & 1023;
    const float* wi = p.in[10] + (size_t)k * 2064 + 1536;
    float s = 0.f;
#pragma unroll
    for (int r = 0; r < 16; ++r) s += wi[r] * p.in[11][r * 256 + c];
    wb[W_IN0 + (size_t)(2048 + c) * 1024 + k] = f2bf(s * p.in[9][k]);
  }
  for (int idx = gt; idx < 2 * 16 * 96 * 96; idx += ngt) {
    const int mat = idx / 147456, rem = idx - mat * 147456;
    const int nb = rem / 9216, r2 = rem - nb * 9216, d = r2 / 96, c = r2 - d * 96;
    const float* src = mat ? p.in[31] : p.in[29];
    wb[W_GATE + idx] = f2bf(src[nb * 9216 + c * 96 + d]);
  }
  for (int idx = gt; idx < 1536; idx += ngt) ((float*)(p.ws + WS_NSP))[idx] = -8.f * softplusf_(-p.in[33][idx]);
  for (int idx = gt; idx < 2048; idx += ngt) {
    const int g = idx >> 6;
    const float dt = expf(p.in[16][g]);
    const float lr = p.in[14][idx], li = p.in[15][idx];
    const float y = li * dt;
    const float kk = rintf(y * 0.15915494309189535f);
    float yr = fmaf(-kk, 6.2831854820251465f, y);
    yr = fmaf(-kk, -1.7484555e-7f, yr);
    const float sn = sinf(yr), cs = cosf(yr);
    const float mag = expf(lr * dt);
    const float abr = mag * cs, abi = mag * sn;
    const float sh = sinf(0.5f * yr);
    const float nr = expm1f(lr * dt) * cs - 2.f * sh * sh, ni = abi;
    const float den = lr * lr + li * li;
    const float fr = (nr * lr + ni * li) / den, fi = (ni * lr - nr * li) / den;
    float* ab = (float*)(p.ws + WS_S5AB);
    ab[idx] = abr; ab[2048 + idx] = abi;
    float pr = abr, pi = abi;
#pragma unroll
    for (int q = 0; q < 4; ++q) { float t = pr * pr - pi * pi; pi = 2.f * pr * pi; pr = t; }
    ab[4096 + idx] = pr; ab[6144 + idx] = pi;
#pragma unroll
    for (int q = 0; q < 2; ++q) { float t = pr * pr - pi * pi; pi = 2.f * pr * pi; pr = t; }
    ab[8192 + idx] = pr; ab[10240 + idx] = pi;
    float* bbr = (float*)(p.ws + WS_S5BB);
    float* bbi = bbr + 2048 * 16;
#pragma unroll
    for (int h = 0; h < 16; ++h) {
      const float br = p.in[17][idx * 16 + h], bi = p.in[18][idx * 16 + h];
      bbr[idx * 16 + h] = fr * br - fi * bi;
      bbi[idx * 16 + h] = fr * bi + fi * br;
    }
    bf16_t* cc = (bf16_t*)(p.ws + WS_S5CC);
    const int pp = idx & 63;
#pragma unroll
    for (int h = 0; h < 16; ++h) {
      cc[(g * 16 + h) * 128 + 2 * pp] = f2bf(p.in[19][(g * 16 + h) * 64 + pp]);
      cc[(g * 16 + h) * 128 + 2 * pp + 1] = f2bf(-p.in[20][(g * 16 + h) * 64 + pp]);
    }
  }
}

__device__ __forceinline__ void g1_store(const Params& p, bf16_t* zb, float* alog, int row, int col, float v0, float v1, float v2, float v3) {
  if (col < 2048) {
    if (col < 256) { v0 *= 0.125f; v1 *= 0.125f; v2 *= 0.125f; v3 *= 0.125f; }
    uint2 o; o.x = pack2(v0, v1); o.y = pack2(v2, v3);
    *(uint2*)(zb + (size_t)row * 2048 + col) = o;
  } else {
    const int c = col - 2048;
    const float4 ba = *(const float4*)(p.in[12] + c);
    float4 o;
    o.x = -softplusf_(-(v0 + ba.x)) * 0.0625f; o.y = -softplusf_(-(v1 + ba.y)) * 0.0625f;
    o.z = -softplusf_(-(v2 + ba.z)) * 0.0625f; o.w = -softplusf_(-(v3 + ba.w)) * 0.0625f;
    *(float4*)(alog + (size_t)row * 256 + c) = o;
  }
}
__device__ __forceinline__ void phase_g1(const Params& p, char* lds) {
  int tid, lane, w, wr, wc, lr, lq; TREFRESH();
  const bf16_t* zp = (const bf16_t*)(p.ws + WS_ZERO);
  const bf16_t* xb = (const bf16_t*)(p.ws + WS_XB);
  const bf16_t* W = (const bf16_t*)p.out + W_IN0;
  const float* ssq = (const float*)(p.ws + WS_SSQ2);
  bf16_t* zb = (bf16_t*)(p.ws + WS_SCR + SCR_ZB);
  float* alog = (float*)(p.ws + WS_SCR + SCR_ALOG);
  float* srs = (float*)(lds + LDS_SRS);
  unsigned* flg = (unsigned*)(p.ws + WS_FLAG);
  const int u = blockIdx.x;
  const bool unitA = u < 128, unitB = u >= 128 && u < 164;
  const int umt = unitA ? (u >> 1) : 64, unt = unitA ? 8 : ((u - 128) >> 2), uks = unitA ? (u & 1) : ((u - 128) & 3);
  const int uK = unitA ? 512 : 256, nsl = unitA ? 2 : 4;
  float* slab0 = unitA ? (float*)(p.ws + WS_SCR + SCR_SLOC) + (size_t)(u >> 1) * 2 * 65536 : (float*)(p.ws + WS_SLAB) + (size_t)unt * 4 * 65536;
  unsigned* tick = unitA ? flg + 4432 + (u >> 1) : flg + 4496 + unt;
  if (unitA || unitB) {
    const int k0 = uks * uK;
    f32x4 acc[8][4];
    gemm_tile256(acc, xb + k0, [&](int i) { return (umt * 256 + i) * 1024; }, W + (size_t)unt * 256 * 1024 + k0, 1024, uK, lds, zp);
    TREFRESH(); int zE = 0; asm volatile("" : "+v"(zE));
    float* slab = slab0 + (size_t)uks * 65536;
#pragma unroll
    for (int m = 0; m < 8; ++m)
#pragma unroll
      for (int n = 0; n < 4; ++n)
        *(float4*)(slab + ((m >> 2) * 128 + wr * 64 + (m & 3) * 16 + lr + zE) * 256 + (n >> 1) * 128 + wc * 32 + (n & 1) * 16 + lq * 4 + zE) = make_float4(acc[m][n][0], acc[m][n][1], acc[m][n][2], acc[m][n][3]);
    asm volatile("s_waitcnt vmcnt(0)" ::: "memory");
    __syncthreads();
    if (tid == 0) {
      __builtin_amdgcn_fence(__ATOMIC_RELEASE, "agent");
      asm volatile("s_waitcnt vmcnt(0)" ::: "memory");
      (void)xb_add(tick, 1u);
    }
  }
  TileSched ts; ts.init(64, 8);
  for (int ti = ts.local; ti < ts.ntiles; ti += ts.nloc) {
    int mt, nt; ts.get(ti, mt, nt);
    if (tid < 256) srs[tid] = row_rstd(ssq, mt * 256 + tid);
    f32x4 acc[8][4];
    gemm_tile256(acc, xb, [&](int i) { return (mt * 256 + i) * 1024; }, W + (size_t)nt * 256 * 1024, 1024, 1024, lds, zp);
    TREFRESH(); int zE = 0; asm volatile("" : "+v"(zE));
#pragma unroll
    for (int m = 0; m < 8; ++m) {
      const int r = (m >> 2) * 128 + wr * 64 + (m & 3) * 16 + lr + zE, row = mt * 256 + r;
      const float rs = srs[r];
#pragma unroll
      for (int n = 0; n < 4; ++n) {
        const int col = nt * 256 + (n >> 1) * 128 + wc * 32 + (n & 1) * 16 + lq * 4 + zE;
        f32x4 v = acc[m][n] * rs;
        if (col < 256) v = v * 0.125f;
        uint2 o; o.x = pack2(v[0], v[1]); o.y = pack2(v[2], v[3]);
        *(uint2*)(zb + (size_t)row * 2048 + col) = o;
      }
    }
    __syncthreads();
  }
  if (unitA || unitB) {
    if (tid == 0) {
      XB_SPIN(xb_ld(tick) < (unsigned)nsl, (unsigned*)(p.ws + WS_BAR));
      __builtin_amdgcn_fence(__ATOMIC_ACQUIRE, "agent");
      asm volatile("s_waitcnt vmcnt(0)" ::: "memory");
    }
    __syncthreads();
    const int rpb = 256 / nsl, r0 = uks * rpb;
    for (int rr = r0 + (tid >> 6); rr < r0 + rpb; rr += 8) {
      const int c4 = tid & 63, row = umt * 256 + rr, col = unt * 256 + c4 * 4;
      const float* s4 = slab0 + rr * 256 + c4 * 4;
      float4 sum = make_float4(0.f, 0.f, 0.f, 0.f);
      for (int q = 0; q < nsl; ++q) { const float4 v = *(const float4*)(s4 + (size_t)q * 65536); sum.x += v.x; sum.y += v.y; sum.z += v.z; sum.w += v.w; }
      const float rs = row_rstd(ssq, row);
      g1_store(p, zb, alog, row, col, sum.x * rs, sum.y * rs, sum.z * rs, sum.w * rs);
    }
  }
}

__device__ __forceinline__ void gla_chunk(const Params& p, int item, int mode, char* lds) {
  const int tid = threadIdx.x & 255, lane = tid & 63, w = tid >> 6, lr = lane & 15, lq = lane >> 4;
  const int bh = item / 33, c = item - bh * 33, b = bh >> 2, h = bh & 3;
  const int row0 = b * TP + (c == 0 ? 0 : 16 + 64 * (c - 1));
  const int len = c == 0 ? 16 : 64;
  bf16_t* zb = (bf16_t*)(p.ws + WS_SCR + SCR_ZB);
  const float* alog = (const float*)(p.ws + WS_SCR + SCR_ALOG);
  float* sloc = (float*)(p.ws + WS_SCR + SCR_SLOC) + (size_t)(bh * 33 + c) * 8192;
  float* sb = (float*)lds;
  char* Qs = lds + 16384; char* Ks = lds + 24576; char* VT = lds + 32768; char* ST = lds + 49152;
#pragma unroll
  for (int i = 0; i < 4; ++i) {
    const int idx = tid + 256 * i, r = idx >> 4, c4 = idx & 15;
    float4 v = make_float4(0.f, 0.f, 0.f, 0.f);
    if (r < len) v = *(const float4*)(alog + (size_t)(row0 + r) * 256 + h * 64 + c4 * 4);
    *(float4*)(sb + r * 64 + c4 * 4) = v;
  }
  __syncthreads();
  {
    float run = 0.f;
#pragma unroll
    for (int t = 0; t < 16; ++t) { run += sb[(16 * w + t) * 64 + lane]; sb[(16 * w + t) * 64 + lane] = run; }
  }
  __syncthreads();
  float off = 0.f;
#pragma unroll
  for (int s = 0; s < 3; ++s) if (s < w) off += sb[(16 * s + 15) * 64 + lane];
  __syncthreads();
#pragma unroll
  for (int t = 0; t < 16; ++t) sb[(16 * w + t) * 64 + lane] += off;
  __syncthreads();
#pragma unroll
  for (int i = 0; i < 2; ++i) {
    const int idx = tid + 256 * i, r = idx & 63, ch = idx >> 6;
    uint4 qv = make_uint4(0, 0, 0, 0), kv = make_uint4(0, 0, 0, 0);
    if (r < len) {
      const bf16_t* zr = zb + (size_t)(row0 + r) * 2048 + h * 64 + ch * 8;
      qv = *(const uint4*)zr; kv = *(const uint4*)(zr + 256);
    }
    float bv[8];
#pragma unroll
    for (int e = 0; e < 8; ++e) bv[e] = sb[r * 64 + ch * 8 + e];
    const uint32_t qq[4] = {qv.x, qv.y, qv.z, qv.w}, kq[4] = {kv.x, kv.y, kv.z, kv.w};
    if (mode == 1) {
      uint32_t oq[4], ok[4];
#pragma unroll
      for (int e = 0; e < 4; ++e) {
        const float e0 = __expf(bv[2 * e]), e1 = __expf(bv[2 * e + 1]);
        oq[e] = pack2(lo2f(qq[e]) * e0, hi2f(qq[e]) * e1);
        ok[e] = pack2(lo2f(kq[e]) * __builtin_amdgcn_rcpf(e0), hi2f(kq[e]) * __builtin_amdgcn_rcpf(e1));
      }
      *(uint4*)(Qs + toff(r, ch)) = make_uint4(oq[0], oq[1], oq[2], oq[3]);
      *(uint4*)(Ks + toff(r, ch)) = make_uint4(ok[0], ok[1], ok[2], ok[3]);
    } else {
#pragma unroll
      for (int e = 0; e < 8; ++e) {
        const int d = ch * 8 + e;
        const float kf = (e & 1) ? hi2f(kq[e >> 1]) : lo2f(kq[e >> 1]);
        const float kh = kf * __expf(sb[63 * 64 + d] - bv[e]);
        *(bf16_t*)(Qs + d * 128 + ((((r >> 3) ^ (d & 7))) << 4) + (r & 7) * 2) = f2bf(kh);
      }
    }
  }
#pragma unroll
  for (int i = 0; i < 4; ++i) {
    const int idx = tid + 256 * i, r = idx & 63, ch = idx >> 6;
    uint4 vv = make_uint4(0, 0, 0, 0);
    if (r < len) vv = *(const uint4*)(zb + (size_t)(row0 + r) * 2048 + 512 + h * 128 + ch * 8);
    const uint32_t vq[4] = {vv.x, vv.y, vv.z, vv.w};
#pragma unroll
    for (int e = 0; e < 8; ++e) {
      const int ee = ch * 8 + e;
      const bf16_t val = (bf16_t)((e & 1) ? (vq[e >> 1] >> 16) : (vq[e >> 1] & 0xffffu));
      *(bf16_t*)(VT + ee * 128 + ((((r >> 3) ^ (ee & 7))) << 4) + (r & 7) * 2) = val;
    }
  }
  if (mode == 1) {
#pragma unroll
    for (int i = 0; i < 4; ++i) {
      const int idx = tid + 256 * i, e = idx >> 3, ch = idx & 7;
      const float4 a = *(const float4*)(sloc + e * 64 + ch * 8);
      const float4 bq = *(const float4*)(sloc + e * 64 + ch * 8 + 4);
      *(uint4*)(ST + toff(e, ch)) = make_uint4(pack2(a.x, a.y), pack2(a.z, a.w), pack2(bq.x, bq.y), pack2(bq.z, bq.w));
    }
  }
  __syncthreads();
  if (mode == 1) {
    f32x4 at[4];
#pragma unroll
    for (int n = 0; n < 4; ++n) at[n] = (f32x4){0.f, 0.f, 0.f, 0.f};
#pragma unroll
    for (int s = 0; s < 2; ++s) {
      const bf16x8 a = *(const bf16x8*)(Qs + toff(16 * w + lr, s * 4 + lq));
#pragma unroll
      for (int n = 0; n < 4; ++n) {
        const bf16x8 bk = *(const bf16x8*)(Ks + toff(16 * n + lr, s * 4 + lq));
        at[n] = mfma16(bk, a, at[n]);
      }
    }
    char* P = lds;
    const int i = 16 * w + lr;
#pragma unroll
    for (int n = 0; n < 4; ++n) {
      const int j0 = 16 * n + lq * 4;
      float v0 = (j0 + 0 <= i) ? at[n][0] : 0.f, v1 = (j0 + 1 <= i) ? at[n][1] : 0.f;
      float v2 = (j0 + 2 <= i) ? at[n][2] : 0.f, v3 = (j0 + 3 <= i) ? at[n][3] : 0.f;
      uint2 o; o.x = pack2(v0, v1); o.y = pack2(v2, v3);
      *(uint2*)(P + i * 128 + ((((j0 >> 3) ^ (i & 7))) << 4) + (j0 & 7) * 2) = o;
    }
    __syncthreads();
    f32x4 o[8];
#pragma unroll
    for (int n = 0; n < 8; ++n) o[n] = (f32x4){0.f, 0.f, 0.f, 0.f};
#pragma unroll
    for (int s = 0; s < 2; ++s) {
      const bf16x8 aP = *(const bf16x8*)(P + toff(16 * w + lr, s * 4 + lq));
      const bf16x8 aQ = *(const bf16x8*)(Qs + toff(16 * w + lr, s * 4 + lq));
#pragma unroll
      for (int n = 0; n < 8; ++n) {
        const bf16x8 bV = *(const bf16x8*)(VT + toff(16 * n + lr, s * 4 + lq));
        const bf16x8 bS = *(const bf16x8*)(ST + toff(16 * n + lr, s * 4 + lq));
        o[n] = mfma16(bV, aP, o[n]);
        o[n] = mfma16(bS, aQ, o[n]);
      }
    }
    float ss = 0.f;
#pragma unroll
    for (int n = 0; n < 8; ++n) ss += o[n][0] * o[n][0] + o[n][1] * o[n][1] + o[n][2] * o[n][2] + o[n][3] * o[n][3];
    ss += __shfl_xor(ss, 16); ss += __shfl_xor(ss, 32);
    const float rstd = rsqrtf(ss * (1.f / 128.f) + EPSN);
    if (i < len) {
      bf16_t* zr = zb + (size_t)(row0 + i) * 2048;
#pragma unroll
      for (int n = 0; n < 8; ++n) {
        const int e0 = 16 * n + lq * 4;
        const uint2 g2 = *(const uint2*)(zr + 1024 + h * 128 + e0);
        const float4 gn = *(const float4*)(p.in[13] + h * 128 + e0);
        const float g0 = lo2f(g2.x), g1 = hi2f(g2.x), g2f = lo2f(g2.y), g3 = hi2f(g2.y);
        uint2 ov;
        ov.x = pack2(o[n][0] * rstd * gn.x * g0 * sigm(g0), o[n][1] * rstd * gn.y * g1 * sigm(g1));
        ov.y = pack2(o[n][2] * rstd * gn.z * g2f * sigm(g2f), o[n][3] * rstd * gn.w * g3 * sigm(g3));
        *(uint2*)(zr + 512 + h * 128 + e0) = ov;
      }
    }
  } else {
    f32x4 sl[8];
#pragma unroll
    for (int n = 0; n < 8; ++n) sl[n] = (f32x4){0.f, 0.f, 0.f, 0.f};
#pragma unroll
    for (int s = 0; s < 2; ++s) {
      const bf16x8 aK = *(const bf16x8*)(Qs + toff(16 * w + lr, s * 4 + lq));
#pragma unroll
      for (int n = 0; n < 8; ++n) {
        const bf16x8 bV = *(const bf16x8*)(VT + toff(16 * n + lr, s * 4 + lq));
        sl[n] = mfma16(aK, bV, sl[n]);
      }
    }
#pragma unroll
    for (int n = 0; n < 8; ++n) {
      const int e = 16 * n + lr, d0 = 16 * w + lq * 4;
      *(float4*)(sloc + e * 64 + d0) = make_float4(sl[n][0], sl[n][1], sl[n][2], sl[n][3]);
    }
    if (tid < 64) ((float*)(p.ws + WS_DEC))[(bh * 33 + c) * 64 + tid] = __expf(sb[63 * 64 + tid]);
  }
  __syncthreads();
}

__device__ __forceinline__ void gla_sample(const Params& p, int item, char* lds) {
  const int tid = threadIdx.x & 255;
  const int s = item >> 2, h = item & 3, row = NPR + s;
  bf16_t* zb = (bf16_t*)(p.ws + WS_SCR + SCR_ZB);
  const float* alog = (const float*)(p.ws + WS_SCR + SCR_ALOG);
  float* sq = (float*)lds; float* sk = sq + 64; float* sa = sk + 64; float* part = sa + 64; float* red = part + 256;
  if (tid < 64) {
    sq[tid] = bf2f(zb[(size_t)row * 2048 + h * 64 + tid]);
    sk[tid] = bf2f(zb[(size_t)row * 2048 + 256 + h * 64 + tid]);
    sa[tid] = __expf(alog[(size_t)row * 256 + h * 64 + tid]);
  }
  __syncthreads();
  const int e = tid & 127, half = tid >> 7;
  const float v = bf2f(zb[(size_t)row * 2048 + 512 + h * 128 + e]);
  const float* S0 = p.in[2] + (size_t)(s * 4 + h) * 8192;
  float* So = p.out + O_GLAS + (size_t)(s * 4 + h) * 8192;
  float acc = 0.f;
#pragma unroll 8
  for (int dd = 0; dd < 32; ++dd) {
    const int d = half * 32 + dd;
    const float sn = sa[d] * S0[d * 128 + e] + sk[d] * v;
    So[d * 128 + e] = sn;
    acc += sq[d] * sn;
  }
  part[tid] = acc;
  __syncthreads();
  float o = 0.f;
  if (tid < 128) { o = part[tid] + part[tid + 128]; }
  float ssv = wave_sum(tid < 128 ? o * o : 0.f);
  if ((tid & 63) == 0) red[tid >> 6] = ssv;
  __syncthreads();
  if (tid < 128) {
    const float rstd = rsqrtf((red[0] + red[1]) * (1.f / 128.f) + EPSN);
    const float g = bf2f(zb[(size_t)row * 2048 + 1024 + h * 128 + e]);
    zb[(size_t)row * 2048 + 512 + h * 128 + e] = f2bf(o * rstd * p.in[13][h * 128 + e] * g * sigm(g));
  }
  __syncthreads();
}

typedef __attribute__((ext_vector_type(2))) float f32x2;
__device__ __forceinline__ void s5_load_u(const bf16_t* zb, int row0, int len, int g, int lane, char* ul) {
  uint4 a = make_uint4(0, 0, 0, 0), b = a;
  if (lane < len) {
    const uint4* s = (const uint4*)(zb + (size_t)(row0 + lane) * 2048 + 1536 + g * 16);
    a = s[0]; b = s[1];
  }
  float4* d = (float4*)(ul + lane * 64);
  d[0] = make_float4(lo2f(a.x), hi2f(a.x), lo2f(a.y), hi2f(a.y));
  d[1] = make_float4(lo2f(a.z), hi2f(a.z), lo2f(a.w), hi2f(a.w));
  d[2] = make_float4(lo2f(b.x), hi2f(b.x), lo2f(b.y), hi2f(b.y));
  d[3] = make_float4(lo2f(b.z), hi2f(b.z), lo2f(b.w), hi2f(b.w));
}
__device__ __forceinline__ void s5_load_bb(const float* bbrp, int idx, f32x2 (&bb)[16]) {
#pragma unroll
  for (int q = 0; q < 4; ++q) {
    const float4 x = *(const float4*)(bbrp + idx * 16 + q * 4), y = *(const float4*)(bbrp + 32768 + idx * 16 + q * 4);
    bb[4 * q] = (f32x2){x.x, y.x}; bb[4 * q + 1] = (f32x2){x.y, y.y}; bb[4 * q + 2] = (f32x2){x.z, y.z}; bb[4 * q + 3] = (f32x2){x.w, y.w};
  }
}
__device__ __forceinline__ void s5_step(const char* ul, int t, const f32x2 (&bb)[16], float ar, float ai, float& xr, float& xi) {
  const float4* u = (const float4*)(ul + t * 64);
  const float4 u0 = u[0], u1 = u[1], u2 = u[2], u3 = u[3];
  f32x2 acc = bb[0] * u0.x;
  acc += bb[1] * u0.y; acc += bb[2] * u0.z; acc += bb[3] * u0.w;
  acc += bb[4] * u1.x; acc += bb[5] * u1.y; acc += bb[6] * u1.z; acc += bb[7] * u1.w;
  acc += bb[8] * u2.x; acc += bb[9] * u2.y; acc += bb[10] * u2.z; acc += bb[11] * u2.w;
  acc += bb[12] * u3.x; acc += bb[13] * u3.y; acc += bb[14] * u3.z; acc += bb[15] * u3.w;
  const float nr = ar * xr - ai * xi + acc[0], ni = ar * xi + ai * xr + acc[1];
  xr = nr; xi = ni;
}

__device__ __forceinline__ void s5_pass1(const Params& p, char* lds) {
  const int tid = threadIdx.x, lane = tid & 63, w = tid >> 6;
  const bf16_t* zb = (const bf16_t*)(p.ws + WS_SCR + SCR_ZB);
  const float* ab = (const float*)(p.ws + WS_S5AB);
  const float* bbrp = (const float*)(p.ws + WS_S5BB);
  float* xloc = (float*)(p.ws + WS_XLOC);
  char* ul = lds + w * 4096;
  const int nitem = 8 * 32 * 32;
  for (int base = blockIdx.x * 8; base < nitem; base += gridDim.x * 8) {
    const int item = base + w;
    const bool valid = item < nitem;
    const int it = valid ? item : 0;
    const int bg = it >> 5, c = it & 31, b = bg >> 5, g = bg & 31;
    const int row0 = b * TP + (c == 0 ? 0 : 16 + 64 * (c - 1));
    const int len = c == 0 ? 16 : 64;
    const int idx = g * 64 + lane;
    f32x2 bb[16];
    s5_load_bb(bbrp, idx, bb);
    const float ar = ab[idx], ai = ab[2048 + idx];
    __syncthreads();
    s5_load_u(zb, row0, len, g, lane, ul);
    __syncthreads();
    float xr = 0.f, xi = 0.f;
    for (int t = 0; t < len; ++t) s5_step(ul, t, bb, ar, ai, xr, xi);
    if (valid) {
      xloc[(size_t)(bg * 33 + c) * 64 + lane] = xr;
      xloc[540672 + (size_t)(bg * 33 + c) * 64 + lane] = xi;
    }
  }
}

__device__ __forceinline__ void s5_pass2(const Params& p) {
  const int gt = blockIdx.x * 512 + threadIdx.x;
  if (gt >= 16384) return;
  const int bg = gt >> 6, pp = gt & 63, g = bg & 31, idx = g * 64 + pp;
  const float* ab = (const float*)(p.ws + WS_S5AB);
  const float* xloc = (const float*)(p.ws + WS_XLOC);
  float* xst = (float*)(p.ws + WS_XST);
  const float a16r = ab[4096 + idx], a16i = ab[6144 + idx], a64r = ab[8192 + idx], a64i = ab[10240 + idx];
  float xr = 0.f, xi = 0.f;
  const size_t o0 = (size_t)bg * 33 * 64 + pp;
  xst[o0] = 0.f; xst[540672 + o0] = 0.f;
#pragma unroll 1
  for (int c0 = 0; c0 < 32; c0 += 8) {
    float lr_[8], li_[8];
#pragma unroll
    for (int q = 0; q < 8; ++q) { lr_[q] = xloc[o0 + (c0 + q) * 64]; li_[q] = xloc[540672 + o0 + (c0 + q) * 64]; }
#pragma unroll
    for (int q = 0; q < 8; ++q) {
      const int c = c0 + q;
      const float Ar = c == 0 ? a16r : a64r, Ai = c == 0 ? a16i : a64i;
      const float nr = Ar * xr - Ai * xi + lr_[q], ni = Ar * xi + Ai * xr + li_[q];
      xr = nr; xi = ni;
      xst[o0 + (c + 1) * 64] = xr; xst[540672 + o0 + (c + 1) * 64] = xi;
    }
  }
}

__device__ __forceinline__ void s5_pass3(const Params& p, char* lds) {
  const int tid = threadIdx.x, lane = tid & 63, w = tid >> 6, lr = lane & 15, lq = lane >> 4;
  bf16_t* zb = (bf16_t*)(p.ws + WS_SCR + SCR_ZB);
  const float* ab = (const float*)(p.ws + WS_S5AB);
  const float* bbrp = (const float*)(p.ws + WS_S5BB);
  const float* xst = (const float*)(p.ws + WS_XST);
  const bf16_t* cc = (const bf16_t*)(p.ws + WS_S5CC);
  char* ul = lds + w * 4096;
  char* X = lds + 32768 + w * 8192;
  const int nprompt = 8 * 32 * 33, nitem = nprompt + 128 * 32;
  for (int base = blockIdx.x * 8; base < nitem; base += gridDim.x * 8) {
    const int item = base + w;
    const bool valid = item < nitem;
    const int it = valid ? item : 0;
    int b, g, c, row0, len; bool last, smp;
    float xr, xi;
    if (it < nprompt) {
      const int bg = it / 33; c = it - bg * 33; b = bg >> 5; g = bg & 31; smp = false;
      row0 = b * TP + (c == 0 ? 0 : 16 + 64 * (c - 1)); len = c == 0 ? 16 : 64; last = c == 32;
      xr = xst[(size_t)it * 64 + lane]; xi = xst[540672 + (size_t)it * 64 + lane];
    } else {
      const int i2 = it - nprompt; b = i2 >> 5; g = i2 & 31; c = 0; smp = true;
      row0 = NPR + b; len = 1; last = true;
      xr = p.in[3][(b * 32 + g) * 64 + lane]; xi = p.in[4][(b * 32 + g) * 64 + lane];
    }
    const int idx = g * 64 + lane;
    f32x2 bb[16];
    s5_load_bb(bbrp, idx, bb);
    const float ar = ab[idx], ai = ab[2048 + idx];
    bf16x8 bC[4];
#pragma unroll
    for (int s = 0; s < 4; ++s) bC[s] = *(const bf16x8*)(cc + (g * 16 + lr) * 128 + 32 * s + 8 * lq);
    const float4 dd = *(const float4*)(p.in[21] + g * 16 + lq * 4);
    __syncthreads();
    s5_load_u(zb, row0, len, g, lane, ul);
    __syncthreads();
#pragma unroll 1
    for (int half = 0; half < 2; ++half) {
      const int tl = len - 32 * half < 32 ? len - 32 * half : 32;
      for (int tt = 0; tt < tl; ++tt) {
        s5_step(ul, 32 * half + tt, bb, ar, ai, xr, xi);
        *(uint32_t*)(X + tt * 256 + ((((lane >> 2) ^ (tt & 15))) << 4) + (lane & 3) * 4) = pack2(xr, xi);
      }
      __syncthreads();
      f32x4 y[2];
#pragma unroll
      for (int m = 0; m < 2; ++m) {
        y[m] = (f32x4){0.f, 0.f, 0.f, 0.f};
        const int row = 16 * m + lr;
#pragma unroll
        for (int s = 0; s < 4; ++s) {
          const bf16x8 a = *(const bf16x8*)(X + row * 256 + ((((s * 4 + lq) ^ (row & 15))) << 4));
          y[m] = mfma16(bC[s], a, y[m]);
        }
      }
#pragma unroll
      for (int m = 0; m < 2; ++m) {
        const int t = 32 * half + 16 * m + lr;
        if (valid && t < len) {
          const float4 u4 = *(const float4*)(ul + t * 64 + lq * 16);
          const float y0 = gelu_t(y[m][0] + dd.x * u4.x), y1 = gelu_t(y[m][1] + dd.y * u4.y);
          const float y2 = gelu_t(y[m][2] + dd.z * u4.z), y3 = gelu_t(y[m][3] + dd.w * u4.w);
          uint2 o; o.x = pack2(y0, y1); o.y = pack2(y2, y3);
          *(uint2*)(zb + (size_t)(row0 + t) * 2048 + 1536 + g * 16 + lq * 4) = o;
        }
      }
      __syncthreads();
    }
    if (valid && last) {
      if (smp) { p.out[O_S5RS + (b * 32 + g) * 64 + lane] = xr; p.out[O_S5IS + (b * 32 + g) * 64 + lane] = xi; }
      else { p.out[O_S5RP + (b * 32 + g) * 64 + lane] = xr; p.out[O_S5IP + (b * 32 + g) * 64 + lane] = xi; }
    }
  }
}

__device__ __forceinline__ void phase_mix_a(const Params& p, char* lds) {
  { const int hf = threadIdx.x >> 8; for (int pr = blockIdx.x; pr < 16 * 33; pr += gridDim.x) gla_chunk(p, pr * 2 + hf, 0, lds + hf * HALF_LDS); }
  __syncthreads();
  s5_pass1(p, lds);
}
__device__ __forceinline__ void phase_mix_b(const Params& p) {
  float* slocb = (float*)(p.ws + WS_SCR + SCR_SLOC);
  const float* dec = (const float*)(p.ws + WS_DEC);
  const int gt = blockIdx.x * 512 + threadIdx.x, ngt = gridDim.x * 512;
#pragma unroll 1
  for (int idx = gt; idx < 32 * 8192; idx += ngt) {
    const int bh = idx >> 13, ed = idx & 8191, e = ed >> 6, d = ed & 63;
    float S = 0.f;
#pragma unroll 1
    for (int c0 = 0; c0 < 33; c0 += 11) {
      float tmp[11], dc[11];
#pragma unroll
      for (int q = 0; q < 11; ++q) { tmp[q] = slocb[(size_t)(bh * 33 + c0 + q) * 8192 + ed]; dc[q] = dec[(bh * 33 + c0 + q) * 64 + d]; }
#pragma unroll
      for (int q = 0; q < 11; ++q) { slocb[(size_t)(bh * 33 + c0 + q) * 8192 + ed] = S; S = dc[q] * S + tmp[q]; }
    }
    p.out[O_GLAP + (size_t)(bh * 64 + d) * 128 + e] = S;
  }
  s5_pass2(p);
}
__device__ __forceinline__ void phase_mix_c(const Params& p, char* lds) {
  const int hf = threadIdx.x >> 8;
  for (int pr = blockIdx.x; pr < 16 * 33; pr += gridDim.x) gla_chunk(p, pr * 2 + hf, 1, lds + hf * HALF_LDS);
  __syncthreads();
  for (int pr = blockIdx.x; pr < 256; pr += gridDim.x) gla_sample(p, pr * 2 + hf, lds + hf * HALF_LDS);
  __syncthreads();
  s5_pass3(p, lds);
}

__device__ __forceinline__ void phase_glu(const Params& p, char* lds) {
  int tid, lane, w, wr, wc, lr, lq; TREFRESH();
  const bf16_t* zp = (const bf16_t*)(p.ws + WS_ZERO);
  bf16_t* zb = (bf16_t*)(p.ws + WS_SCR + SCR_ZB);
  const bf16_t* W = (const bf16_t*)p.out + W_GLU;
  TileSched ts; ts.init(65, 2);
  for (int ti = ts.local; ti < ts.ntiles; ti += ts.nloc) {
    int mt, nt; ts.get(ti, mt, nt);
    f32x4 acc[8][4];
    gemm_tile256(acc, (const bf16_t*)zb + 1536, [&](int i) { return (mt * 256 + i) * 2048; }, W + (size_t)nt * 256 * 512, 512, 512, lds, zp);
    TREFRESH(); int zE = 0; asm volatile("" : "+v"(zE));
#pragma unroll
    for (int m = 0; m < 8; ++m) {
      const int row = mt * 256 + (m >> 2) * 128 + wr * 64 + (m & 3) * 16 + lr + zE;
#pragma unroll
      for (int n = 0; n < 4; ++n) {
        const int col = nt * 256 + (n >> 1) * 128 + wc * 32 + (n & 1) * 16 + lq * 4 + zE;
        const uint2 y2 = *(const uint2*)(zb + (size_t)row * 2048 + 1536 + col);
        const float4 bg = *(const float4*)(p.in[23] + col);
        uint2 o;
        o.x = pack2(lo2f(y2.x) * sigm(acc[m][n][0] + bg.x), hi2f(y2.x) * sigm(acc[m][n][1] + bg.y));
        o.y = pack2(lo2f(y2.y) * sigm(acc[m][n][2] + bg.z), hi2f(y2.y) * sigm(acc[m][n][3] + bg.w));
        *(uint2*)(zb + (size_t)row * 2048 + 1024 + col) = o;
      }
      asm volatile("" ::: "memory");
    }
  }
}

__device__ __forceinline__ void phase_resid(const Params& p, char* lds, const bf16_t* A, int lda, const bf16_t* W, int K, int tkbase, int site) {
  int tid, lane, w, wr, wc, lr, lq; TREFRESH();
  const bf16_t* zp = (const bf16_t*)(p.ws + WS_ZERO);
  bf16_t* xb = (bf16_t*)(p.ws + WS_XB);
  float* ssq = (float*)(p.ws + WS_SSQ2) + (size_t)site * 4 * NR;
  const int ks = K >> 8;
  const bool isunit = (int)blockIdx.x < 4 * ks;
  const int unt = (int)blockIdx.x / ks, uksi = (int)blockIdx.x - unt * ks;
  unsigned* tick = (unsigned*)(p.ws + WS_FLAG) + 4352 + tkbase;
  if (isunit) {
    const int nt = unt, k0 = uksi * 256;
    f32x4 acc[8][4];
    gemm_tile256(acc, A + k0, [&](int i) { return (16384 + i) * lda; }, W + (size_t)nt * 256 * K + k0, K, 256, lds, zp);
    TREFRESH(); int zE = 0; asm volatile("" : "+v"(zE));
    float* slab = (float*)(p.ws + WS_SLAB) + (size_t)(nt * ks + uksi) * 65536;
#pragma unroll
    for (int m = 0; m < 8; ++m)
#pragma unroll
      for (int n = 0; n < 4; ++n)
        *(float4*)(slab + ((m >> 2) * 128 + wr * 64 + (m & 3) * 16 + lr + zE) * 256 + (n >> 1) * 128 + wc * 32 + (n & 1) * 16 + lq * 4 + zE) = make_float4(acc[m][n][0], acc[m][n][1], acc[m][n][2], acc[m][n][3]);
    asm volatile("s_waitcnt vmcnt(0)" ::: "memory");
    __syncthreads();
    if (tid == 0) {
      __builtin_amdgcn_fence(__ATOMIC_RELEASE, "agent");
      asm volatile("s_waitcnt vmcnt(0)" ::: "memory");
      (void)xb_add(&tick[nt], 1u);
    }
  }
  TileSched ts; ts.init(64, 4);
  for (int ti = ts.local; ti < ts.ntiles; ti += ts.nloc) {
    int mt, nt; ts.get(ti, mt, nt);
    f32x4 acc[8][4];
    gemm_tile256(acc, A, [&](int i) { return (mt * 256 + i) * lda; }, W + (size_t)nt * 256 * K, K, K, lds, zp);
    TREFRESH(); int zE = 0; asm volatile("" : "+v"(zE));
#pragma unroll
    for (int m = 0; m < 8; ++m) {
      const int row = mt * 256 + (m >> 2) * 128 + wr * 64 + (m & 3) * 16 + lr + zE;
      float ss0 = 0.f, ss1 = 0.f;
#pragma unroll
      for (int n = 0; n < 4; ++n) {
        const int col = nt * 256 + (n >> 1) * 128 + wc * 32 + (n & 1) * 16 + lq * 4 + zE;
        const uint2 u = *(const uint2*)(xb + (size_t)row * 1024 + col);
        uint2 o; o.x = pack2(lo2f(u.x) + acc[m][n][0], hi2f(u.x) + acc[m][n][1]); o.y = pack2(lo2f(u.y) + acc[m][n][2], hi2f(u.y) + acc[m][n][3]);
        *(uint2*)(xb + (size_t)row * 1024 + col) = o;
        const float y0 = lo2f(o.x), y1 = hi2f(o.x), y2 = lo2f(o.y), y3 = hi2f(o.y);
        const float q = y0 * y0 + y1 * y1 + y2 * y2 + y3 * y3;
        if (n < 2) ss0 += q; else ss1 += q;
      }
      float ssw = ss0 + ss1;
      ssw += __shfl_xor(ssw, 16); ssw += __shfl_xor(ssw, 32);
      if (lq == 0) ((float*)lds)[((m >> 2) * 128 + wr * 64 + (m & 3) * 16 + lr) * 4 + wc] = ssw;
      asm volatile("" ::: "memory");
    }
    __syncthreads();
    if (tid < 256) { const float4 q4 = *(const float4*)((const float*)lds + tid * 4); ssq[(size_t)nt * NR + mt * 256 + tid] = (q4.x + q4.y) + (q4.z + q4.w); }
    __syncthreads();
  }
  if (isunit) {
    const int nt = unt;
    if (tid == 0) {
      XB_SPIN(xb_ld(&tick[nt]) < (unsigned)ks, (unsigned*)(p.ws + WS_BAR));
      __builtin_amdgcn_fence(__ATOMIC_ACQUIRE, "agent");
      asm volatile("s_waitcnt vmcnt(0)" ::: "memory");
    }
    __syncthreads();
    const int rpb = (256 + ks - 1) / ks, r0 = uksi * rpb, r1 = r0 + rpb < 256 ? r0 + rpb : 256;
    const float* sl = (const float*)(p.ws + WS_SLAB) + (size_t)(nt * ks) * 65536;
    for (int rr = r0 + (tid >> 6); rr < r1; rr += 8) {
      const int c4 = tid & 63, row = 16384 + rr, col = nt * 256 + c4 * 4;
      const float* s4 = sl + rr * 256 + c4 * 4;
      float4 sum = make_float4(0.f, 0.f, 0.f, 0.f);
      for (int q = 0; q < ks; ++q) { const float4 v = *(const float4*)(s4 + (size_t)q * 65536); sum.x += v.x; sum.y += v.y; sum.z += v.z; sum.w += v.w; }
      const uint2 u2 = *(const uint2*)(xb + (size_t)row * 1024 + col);
      uint2 o;
      o.x = pack2(lo2f(u2.x) + sum.x, hi2f(u2.x) + sum.y);
      o.y = pack2(lo2f(u2.y) + sum.z, hi2f(u2.y) + sum.w);
      *(uint2*)(xb + (size_t)row * 1024 + col) = o;
      const float y0 = lo2f(o.x), y1 = hi2f(o.x), y2 = lo2f(o.y), y3 = hi2f(o.y);
      float ss = wave_sum(y0 * y0 + y1 * y1 + y2 * y2 + y3 * y3);
      if (c4 == 0) ssq[(size_t)nt * NR + row] = ss;
    }
  }
}

__device__ __forceinline__ void phase_ffn_up(const Params& p, char* lds, int layer, int site) {
  int tid, lane, w, wr, wc, lr, lq; TREFRESH();
  const bf16_t* zp = (const bf16_t*)(p.ws + WS_ZERO);
  const bf16_t* xb = (const bf16_t*)(p.ws + WS_XB);
  const bf16_t* W = (const bf16_t*)p.out + W_UP + (size_t)layer * 5632 * 1024;
  const float* ssq = (const float*)(p.ws + WS_SSQ2) + (size_t)site * 4 * NR;
  bf16_t* act = (bf16_t*)(p.ws + WS_SCR + SCR_ACT);
  const float* cw = p.in[37] + (size_t)layer * 3 * 2816;
  const float* cb = p.in[38] + (size_t)layer * 2816;
  const float* cache = p.in[7] + (size_t)layer * 128 * 2 * 2816;
  float* srs = (float*)(lds + LDS_SRS);
  TileSched ts; ts.init_even(67, 22);
  for (int ti = ts.local; ti < ts.ntiles; ti += ts.nloc) {
    int mt, nt; ts.get_even(ti, mt, nt);
    const bool smp = mt == 66;
    const int gbase = 254 * mt - 2;
    auto growf = [&](int i) -> int { if (smp) return i < 128 ? NPR + i : -1; const int g = gbase + i; return (g >= 0 && g < NPR) ? g : -1; };
    if (tid < 256) { const int gr = growf(tid); srs[tid] = gr >= 0 ? row_rstd(ssq, gr) : 0.f; }
    f32x4 acc[8][4];
    gemm_tile256(acc, xb, [&](int i) -> int { int gr = smp ? NPR + (i < 128 ? i : 127) : gbase + i; gr = gr < 0 ? 0 : (gr > NR - 1 ? NR - 1 : gr); return gr * 1024; }, W + (size_t)nt * 256 * 1024, 1024, 1024, lds, zp);
    TREFRESH(); int zE = 0; asm volatile("" : "+v"(zE));
    {
      int z0 = 0; asm volatile("" : "+v"(z0));
      bf16_t* gl = (bf16_t*)lds + z0; bf16_t* vl = gl + 256 * 136;
#pragma unroll
      for (int m = 0; m < 8; ++m) {
        const int r = (m >> 2) * 128 + wr * 64 + (m & 3) * 16 + lr + zE;
        const float rs = srs[r];
#pragma unroll
        for (int n = 0; n < 2; ++n) {
          const int ch = wc * 32 + n * 16 + lq * 4;
          uint2 og, ov;
          og.x = pack2_sw(acc[m][n][0] * rs, acc[m][n][1] * rs); og.y = pack2_sw(acc[m][n][2] * rs, acc[m][n][3] * rs);
          ov.x = pack2_sw(acc[m][n + 2][0] * rs, acc[m][n + 2][1] * rs); ov.y = pack2_sw(acc[m][n + 2][2] * rs, acc[m][n + 2][3] * rs);
          *(uint2*)(gl + r * 136 + ch) = og;
          *(uint2*)(vl + r * 136 + ch) = ov;
        }
        asm volatile("" ::: "memory");
      }
      __syncthreads();
      float wv[4][8];
      {
        const int gch0 = nt * 128 + (tid & 15) * 8;
#pragma unroll
        for (int q = 0; q < 4; ++q) {
          const float* sp = (q < 3 ? cw + q * 2816 : cb) + gch0;
          const float4 x0 = *(const float4*)sp, x1 = *(const float4*)(sp + 4);
          wv[q][0] = x0.x; wv[q][1] = x0.y; wv[q][2] = x0.z; wv[q][3] = x0.w; wv[q][4] = x1.x; wv[q][5] = x1.y; wv[q][6] = x1.z; wv[q][7] = x1.w;
        }
      }
#pragma unroll 2
      for (int it = 0; it < 8; ++it) {
        const int idx = tid + 512 * it, r = idx >> 4, c8 = (idx & 15) * 8, gch = nt * 128 + c8;
        const int g = gbase + r;
        const bool valid = smp ? (r < 128) : (r >= 2 && g < NPR);
        if (valid) {
          const int grow = smp ? NPR + r : g;
          const int b = smp ? 0 : g / TP, t = smp ? 2 : g - b * TP;
          float g0[8], g1[8], g2[8], vv[8];
          {
            const uint4 u = *(const uint4*)(gl + r * 136 + c8);
            g2[0] = lo2f(u.x); g2[1] = hi2f(u.x); g2[2] = lo2f(u.y); g2[3] = hi2f(u.y); g2[4] = lo2f(u.z); g2[5] = hi2f(u.z); g2[6] = lo2f(u.w); g2[7] = hi2f(u.w);
            const uint4 v4 = *(const uint4*)(vl + r * 136 + c8);
            vv[0] = lo2f(v4.x); vv[1] = hi2f(v4.x); vv[2] = lo2f(v4.y); vv[3] = hi2f(v4.y); vv[4] = lo2f(v4.z); vv[5] = hi2f(v4.z); vv[6] = lo2f(v4.w); vv[7] = hi2f(v4.w);
          }
          if (smp) {
            const float4 a0 = *(const float4*)(cache + (size_t)(r * 2 + 0) * 2816 + gch), a1 = *(const float4*)(cache + (size_t)(r * 2 + 0) * 2816 + gch + 4);
            const float4 b0 = *(const float4*)(cache + (size_t)(r * 2 + 1) * 2816 + gch), b1 = *(const float4*)(cache + (size_t)(r * 2 + 1) * 2816 + gch + 4);
            g0[0] = a0.x; g0[1] = a0.y; g0[2] = a0.z; g0[3] = a0.w; g0[4] = a1.x; g0[5] = a1.y; g0[6] = a1.z; g0[7] = a1.w;
            g1[0] = b0.x; g1[1] = b0.y; g1[2] = b0.z; g1[3] = b0.w; g1[4] = b1.x; g1[5] = b1.y; g1[6] = b1.z; g1[7] = b1.w;
          } else {
            uint4 u0 = make_uint4(0, 0, 0, 0), u1 = make_uint4(0, 0, 0, 0);
            if (t >= 2) u0 = *(const uint4*)(gl + (r - 2) * 136 + c8);
            if (t >= 1) u1 = *(const uint4*)(gl + (r - 1) * 136 + c8);
            g0[0] = lo2f(u0.x); g0[1] = hi2f(u0.x); g0[2] = lo2f(u0.y); g0[3] = hi2f(u0.y); g0[4] = lo2f(u0.z); g0[5] = hi2f(u0.z); g0[6] = lo2f(u0.w); g0[7] = hi2f(u0.w);
            g1[0] = lo2f(u1.x); g1[1] = hi2f(u1.x); g1[2] = lo2f(u1.y); g1[3] = hi2f(u1.y); g1[4] = lo2f(u1.z); g1[5] = hi2f(u1.z); g1[6] = lo2f(u1.w); g1[7] = hi2f(u1.w);
          }
          float ov[8];
#pragma unroll
          for (int e = 0; e < 8; ++e) ov[e] = gelu_t(wv[3][e] + wv[0][e] * g0[e] + wv[1][e] * g1[e] + wv[2][e] * g2[e]) * vv[e];
          *(uint4*)(act + (size_t)grow * 2816 + gch) = make_uint4(pack2(ov[0], ov[1]), pack2(ov[2], ov[3]), pack2(ov[4], ov[5]), pack2(ov[6], ov[7]));
          if (smp) {
            float* oc = p.out + O_FCS + (size_t)((layer * 128 + r) * 2) * 2816 + gch;
            *(float4*)oc = make_float4(g1[0], g1[1], g1[2], g1[3]); *(float4*)(oc + 4) = make_float4(g1[4], g1[5], g1[6], g1[7]);
            *(float4*)(oc + 2816) = make_float4(g2[0], g2[1], g2[2], g2[3]); *(float4*)(oc + 2820) = make_float4(g2[4], g2[5], g2[6], g2[7]);
          } else if (t >= TP - 2) {
            float* oc = p.out + O_FCP + (size_t)((layer * 8 + b) * 2 + (t - (TP - 2))) * 2816 + gch;
            *(float4*)oc = make_float4(g2[0], g2[1], g2[2], g2[3]); *(float4*)(oc + 4) = make_float4(g2[4], g2[5], g2[6], g2[7]);
          }
        }
      }
    }
    __syncthreads();
  }
}

__device__ __forceinline__ void phase_g5(const Params& p, char* lds) {
  int tid, lane, w, wr, wc, lr, lq; TREFRESH();
  const bf16_t* zp = (const bf16_t*)(p.ws + WS_ZERO);
  const bf16_t* xb = (const bf16_t*)(p.ws + WS_XB);
  const bf16_t* W = (const bf16_t*)p.out + W_IN1;
  const float* ssq = (const float*)(p.ws + WS_SSQ2) + (size_t)2 * 4 * NR;
  bf16_t* xr = (bf16_t*)(p.ws + WS_SCR + SCR_XR);
  bf16_t* gg = (bf16_t*)(p.ws + WS_SCR + SCR_GG);
  float* srs = (float*)(lds + LDS_SRS);
  if (blockIdx.x < 48) {
    const int u = blockIdx.x, nt = u >> 2, ksi = u & 3, k0 = ksi * 256;
    f32x4 acc[8][4];
    gemm_tile256(acc, xb + k0, [&](int i) { return (16384 + i) * 1024; }, W + (size_t)nt * 256 * 1024 + k0, 1024, 256, lds, zp);
    TREFRESH(); int zE = 0; asm volatile("" : "+v"(zE));
    float* slab = (float*)(p.ws + WS_SLAB) + (size_t)(nt * 4 + ksi) * 65536;
#pragma unroll
    for (int m = 0; m < 8; ++m)
#pragma unroll
      for (int n = 0; n < 4; ++n)
        *(float4*)(slab + ((m >> 2) * 128 + wr * 64 + (m & 3) * 16 + lr + zE) * 256 + (n >> 1) * 128 + wc * 32 + (n & 1) * 16 + lq * 4 + zE) = make_float4(acc[m][n][0], acc[m][n][1], acc[m][n][2], acc[m][n][3]);
    asm volatile("s_waitcnt vmcnt(0)" ::: "memory");
    __syncthreads();
    if (tid == 0) {
      __builtin_amdgcn_fence(__ATOMIC_RELEASE, "agent");
      asm volatile("s_waitcnt vmcnt(0)" ::: "memory");
      (void)xb_add((unsigned*)(p.ws + WS_FLAG) + 4416 + nt, 1u);
    }
  }
  TileSched ts; ts.init(64, 12);
  for (int ti = ts.local; ti < ts.ntiles; ti += ts.nloc) {
    int mt, nt; ts.get(ti, mt, nt);
    if (tid < 256) srs[tid] = row_rstd(ssq, mt * 256 + tid);
    f32x4 acc[8][4];
    gemm_tile256(acc, xb, [&](int i) { return (mt * 256 + i) * 1024; }, W + (size_t)nt * 256 * 1024, 1024, 1024, lds, zp);
    TREFRESH(); int zE = 0; asm volatile("" : "+v"(zE));
#pragma unroll
    for (int m = 0; m < 8; ++m) {
      const int r = (m >> 2) * 128 + wr * 64 + (m & 3) * 16 + lr + zE, row = mt * 256 + r;
      const float rs = srs[r];
#pragma unroll
      for (int n = 0; n < 4; ++n) {
        const int col = nt * 256 + (n >> 1) * 128 + wc * 32 + (n & 1) * 16 + lq * 4 + zE;
        const f32x4 v = acc[m][n] * rs;
        uint2 o;
        if (nt < 6) {
          o.x = pack2(gelu_t(v[0]), gelu_t(v[1])); o.y = pack2(gelu_t(v[2]), gelu_t(v[3]));
          *(uint2*)(gg + (size_t)row * 1536 + col) = o;
        } else {
          o.x = pack2(v[0], v[1]); o.y = pack2(v[2], v[3]);
          *(uint2*)(xr + (size_t)row * 1536 + (col - 1536)) = o;
        }
      }
    }
    __syncthreads();
  }
  if (blockIdx.x < 48) {
    const int u = blockIdx.x, nt = u >> 2, ksi = u & 3;
    if (tid == 0) {
      XB_SPIN(xb_ld((unsigned*)(p.ws + WS_FLAG) + 4416 + nt) < 4u, (unsigned*)(p.ws + WS_BAR));
      __builtin_amdgcn_fence(__ATOMIC_ACQUIRE, "agent");
      asm volatile("s_waitcnt vmcnt(0)" ::: "memory");
    }
    __syncthreads();
    const float* sl = (const float*)(p.ws + WS_SLAB) + (size_t)(nt * 4) * 65536;
    for (int rr = ksi * 64 + (tid >> 6); rr < ksi * 64 + 64; rr += 8) {
      const int c4 = tid & 63, row = 16384 + rr, col = nt * 256 + c4 * 4;
      const float* s4 = sl + rr * 256 + c4 * 4;
      const float4 s0 = *(const float4*)s4, s1 = *(const float4*)(s4 + 65536), s2 = *(const float4*)(s4 + 131072), s3 = *(const float4*)(s4 + 196608);
      const float rs = row_rstd(ssq, row);
      const float v0 = ((s0.x + s1.x) + (s2.x + s3.x)) * rs, v1 = ((s0.y + s1.y) + (s2.y + s3.y)) * rs;
      const float v2 = ((s0.z + s1.z) + (s2.z + s3.z)) * rs, v3 = ((s0.w + s1.w) + (s2.w + s3.w)) * rs;
      uint2 o;
      if (nt < 6) {
        o.x = pack2(gelu_t(v0), gelu_t(v1)); o.y = pack2(gelu_t(v2), gelu_t(v3));
        *(uint2*)(gg + (size_t)row * 1536 + col) = o;
      } else {
        o.x = pack2(v0, v1); o.y = pack2(v2, v3);
        *(uint2*)(xr + (size_t)row * 1536 + (col - 1536)) = o;
      }
    }
  }
}

__device__ __forceinline__ void rglru_item(const Params& p, int item, char* lds) {
  const int tid = threadIdx.x & 255, lane = tid & 63, w = tid >> 6, lr = lane & 15, lq = lane >> 4;
  const bool smp = item >= 4352;
  const int pass = 1;
  int b, tl, n, half;
  if (smp) { const int it = item - 4352; b = 0; tl = 0; n = it >> 1; half = it & 1; }
  else { tl = item >> 8; const int chain = item & 255; b = chain >> 5; n = (chain >> 1) & 15; half = chain & 1; }
  unsigned* flags = (unsigned*)(p.ws + WS_FLAG);
  unsigned* barw = (unsigned*)(p.ws + WS_BAR);
  const bf16_t* xr = (const bf16_t*)(p.ws + WS_SCR + SCR_XR);
  bf16_t* gg = (bf16_t*)(p.ws + WS_SCR + SCR_GG);
  const bf16_t* Wg = (const bf16_t*)p.out + W_GATE;
  const bf16_t* zp = (const bf16_t*)(p.ws + WS_ZERO);
  float* carr = (float*)(p.ws + WS_XLOC);
  char* At = lds; char* Ba = lds + 26624; char* Bx = lds + 36608;
  char* xs = lds + 46592;
  float* sa = (float*)lds; float* sbx = (float*)(lds + 24576);
  float* segA = (float*)(lds + 49152); float* segH = (float*)(lds + 49920); float* carry = (float*)(lds + 50688);
  char* ggl = lds + 51200;
  float* par = (float*)(lds + 71744);
  const int t0 = tl * 128;
  const int nvalid = smp ? 128 : (TP - t0 < 128 ? TP - t0 : 128);
  if (tid < 156) {
    const float* src;
    const int q = tid;
    if (q < 96) { const int wt = q / 24; src = p.in[27] + wt * 1536 + n * 96 + (q - wt * 24) * 4; }
    else if (q < 120) src = p.in[28] + n * 96 + (q - 96) * 4;
    else if (q < 132) src = p.in[30] + n * 96 + half * 48 + (q - 120) * 4;
    else if (q < 144) src = p.in[32] + n * 96 + half * 48 + (q - 132) * 4;
    else src = (const float*)(p.ws + WS_NSP) + n * 96 + half * 48 + (q - 144) * 4;
    __builtin_amdgcn_global_load_lds((const unsigned*)src, (unsigned*)((char*)par + q * 16), 16, 0, 0);
  }
  for (int q = tid; q < 1248; q += 256) {
    const int mat = q >= 624 ? 1 : 0, q2 = q - mat * 624, d = q2 / 13, ch = q2 - d * 13;
    const bf16_t* src = Wg + (size_t)((mat * 16 + n) * 96 + half * 48 + d) * 96 + (ch < 12 ? ch : 0) * 8;
    __builtin_amdgcn_global_load_lds((const unsigned*)src, (unsigned*)(Ba + q * 16), 16, 0, 0);
  }
  if (!smp) {
    for (int q = tid; q < 1572; q += 256) {
      const int r = q / 12, ch = q - r * 12, t = t0 + r - 3;
      const bf16_t* src = (t >= 0 && t < TP) ? xr + (size_t)(b * TP + t) * 1536 + n * 96 + ch * 8 : zp;
      __builtin_amdgcn_global_load_lds((const unsigned*)src, (unsigned*)(xs + q * 16), 16, 0, 0);
    }
  }
  asm volatile("s_waitcnt vmcnt(0)" ::: "memory");
  __syncthreads();
#pragma unroll 2
  for (int i = 0; i < 6; ++i) {
    const int idx = tid + 256 * i, r = idx / 12, ch8 = idx - r * 12, c0 = n * 96 + ch8 * 8;
    float xc[8];
    if (r < nvalid) {
      const float4 b0 = *(const float4*)(par + 384 + ch8 * 8), b1 = *(const float4*)(par + 384 + ch8 * 8 + 4);
      xc[0] = b0.x; xc[1] = b0.y; xc[2] = b0.z; xc[3] = b0.w; xc[4] = b1.x; xc[5] = b1.y; xc[6] = b1.z; xc[7] = b1.w;
#pragma unroll
      for (int wt = 0; wt < 4; ++wt) {
        float xv[8];
        if (smp && wt < 3) {
          const float4 a0 = *(const float4*)(p.in[6] + (size_t)(r * 3 + wt) * 1536 + c0), a1 = *(const float4*)(p.in[6] + (size_t)(r * 3 + wt) * 1536 + c0 + 4);
          xv[0] = a0.x; xv[1] = a0.y; xv[2] = a0.z; xv[3] = a0.w; xv[4] = a1.x; xv[5] = a1.y; xv[6] = a1.z; xv[7] = a1.w;
        } else {
          uint4 u;
          if (smp) u = *(const uint4*)(xr + (size_t)(NPR + r) * 1536 + c0);
          else u = *(const uint4*)(xs + (r + wt) * 192 + ch8 * 16);
          xv[0] = lo2f(u.x); xv[1] = hi2f(u.x); xv[2] = lo2f(u.y); xv[3] = hi2f(u.y); xv[4] = lo2f(u.z); xv[5] = hi2f(u.z); xv[6] = lo2f(u.w); xv[7] = hi2f(u.w);
        }
        const float4 w0 = *(const float4*)(par + wt * 96 + ch8 * 8), w1 = *(const float4*)(par + wt * 96 + ch8 * 8 + 4);
        xc[0] += w0.x * xv[0]; xc[1] += w0.y * xv[1]; xc[2] += w0.z * xv[2]; xc[3] += w0.w * xv[3];
        xc[4] += w1.x * xv[4]; xc[5] += w1.y * xv[5]; xc[6] += w1.z * xv[6]; xc[7] += w1.w * xv[7];
      }
    } else {
#pragma unroll
      for (int e = 0; e < 8; ++e) xc[e] = 0.f;
    }
    *(uint4*)(At + r * 208 + ch8 * 16) = make_uint4(pack2(xc[0], xc[1]), pack2(xc[2], xc[3]), pack2(xc[4], xc[5]), pack2(xc[6], xc[7]));
  }
  __syncthreads();
  if (pass == 1 && !smp) {
    for (int q = tid; q < 768; q += 256) {
      const int r = q / 6, c = q - r * 6;
      const bf16_t* src = r < nvalid ? gg + (size_t)(b * TP + t0 + r) * 1536 + n * 96 + half * 48 + c * 8 : zp;
      __builtin_amdgcn_global_load_lds((const unsigned*)src, (unsigned*)(ggl + q * 16), 16, 0, 0);
    }
  }
  f32x4 aa[2][3], ax[2][3];
#pragma unroll
  for (int m = 0; m < 2; ++m)
#pragma unroll
    for (int q = 0; q < 3; ++q) { aa[m][q] = (f32x4){0.f, 0.f, 0.f, 0.f}; ax[m][q] = (f32x4){0.f, 0.f, 0.f, 0.f}; }
#pragma unroll
  for (int s2 = 0; s2 < 3; ++s2) {
    bf16x8 a[2];
#pragma unroll
    for (int m = 0; m < 2; ++m) a[m] = *(const bf16x8*)(At + (32 * w + 16 * m + lr) * 208 + (s2 * 4 + lq) * 16);
#pragma unroll
    for (int q = 0; q < 3; ++q) {
      const bf16x8 ba = *(const bf16x8*)(Ba + (16 * q + lr) * 208 + (s2 * 4 + lq) * 16);
      const bf16x8 bx = *(const bf16x8*)(Bx + (16 * q + lr) * 208 + (s2 * 4 + lq) * 16);
#pragma unroll
      for (int m = 0; m < 2; ++m) { aa[m][q] = mfma16(ba, a[m], aa[m][q]); ax[m][q] = mfma16(bx, a[m], ax[m][q]); }
    }
  }
  uint2 xcv[2][3];
#pragma unroll
  for (int m = 0; m < 2; ++m)
#pragma unroll
    for (int q = 0; q < 3; ++q) xcv[m][q] = *(const uint2*)(At + (32 * w + 16 * m + lr) * 208 + (half * 48 + 16 * q + lq * 4) * 2);
  float4 pba[3], pbx[3], plm[3];
#pragma unroll
  for (int q = 0; q < 3; ++q) {
    pba[q] = *(const float4*)(par + 480 + 16 * q + lq * 4);
    pbx[q] = *(const float4*)(par + 528 + 16 * q + lq * 4);
    plm[q] = *(const float4*)(par + 576 + 16 * q + lq * 4);
  }
  __syncthreads();
#pragma unroll
  for (int m = 0; m < 2; ++m) {
    const int row = 32 * w + 16 * m + lr;
#pragma unroll
    for (int q = 0; q < 3; ++q) {
      const int d0 = 16 * q + lq * 4;
      const float bav[4] = {pba[q].x, pba[q].y, pba[q].z, pba[q].w}, bxv[4] = {pbx[q].x, pbx[q].y, pbx[q].z, pbx[q].w}, lmv[4] = {plm[q].x, plm[q].y, plm[q].z, plm[q].w};
      const float xcf[4] = {lo2f(xcv[m][q].x), hi2f(xcv[m][q].x), lo2f(xcv[m][q].y), hi2f(xcv[m][q].y)};
      float av[4], bv[4];
#pragma unroll
      for (int e = 0; e < 4; ++e) {
        const float r_ = sigm(aa[m][q][e] + bav[e]);
        const float i_ = sigm(ax[m][q][e] + bxv[e]);
        const float la = r_ * lmv[e];
        float a = __expf(la);
        float bxx = __builtin_sqrtf(fmaxf(1.f - a * a, 0.f)) * (i_ * xcf[e]);
        if (row >= nvalid) { a = 1.f; bxx = 0.f; }
        av[e] = a; bv[e] = bxx;
      }
      *(float4*)(sa + row * 48 + d0) = make_float4(av[0], av[1], av[2], av[3]);
      *(float4*)(sbx + row * 48 + d0) = make_float4(bv[0], bv[1], bv[2], bv[3]);
    }
  }
  __syncthreads();
  if (smp) {
    for (int idx = tid; idx < 128 * 48; idx += 256) {
      const int row = idx / 48, ch = idx - row * 48, cgl = n * 96 + half * 48 + ch;
      const float hh = sa[idx] * p.in[5][row * 1536 + cgl] + sbx[idx];
      p.out[O_HS + row * 1536 + cgl] = hh;
      const size_t go = (size_t)(NPR + row) * 1536 + cgl;
      gg[go] = f2bf(hh * bf2f(gg[go]));
    }
  } else {
    const int ch = tid % 48, seg = tid / 48;
    if (tid < 192) {
      float A = 1.f, H = 0.f;
#pragma unroll 8
      for (int r = seg * 32; r < seg * 32 + 32; ++r) { const float a = sa[r * 48 + ch]; H = a * H + sbx[r * 48 + ch]; A *= a; }
      segA[seg * 48 + ch] = A; segH[seg * 48 + ch] = H;
    }
    asm volatile("s_waitcnt vmcnt(0)" ::: "memory");
    __syncthreads();
    {
      float At_ = 1.f, Ht_ = 0.f;
      if (tid < 48) {
#pragma unroll
        for (int s2 = 0; s2 < 4; ++s2) { Ht_ = segA[s2 * 48 + tid] * Ht_ + segH[s2 * 48 + tid]; At_ *= segA[s2 * 48 + tid]; }
      }
      if (tl > 0 && tid == 0) XB_SPIN(xb_ld(&flags[item - 256]) == 0u, barw);
      __syncthreads();
      if (tid < 48) {
        const int cgl = n * 96 + half * 48 + tid;
        float h0 = 0.f;
        if (tl > 0) h0 = __hip_atomic_load(&carr[(size_t)((b * 17 + tl - 1) * 32 + n * 2 + half) * 64 + tid], __ATOMIC_RELAXED, __HIP_MEMORY_SCOPE_AGENT);
        carry[tid] = h0;
        const float hend = At_ * h0 + Ht_;
        if (tl < 16) __hip_atomic_store(&carr[(size_t)((b * 17 + tl) * 32 + n * 2 + half) * 64 + tid], hend, __ATOMIC_RELAXED, __HIP_MEMORY_SCOPE_AGENT);
        else p.out[O_HP + b * 1536 + cgl] = hend;
      }
      asm volatile("s_waitcnt vmcnt(0)" ::: "memory");
      __syncthreads();
      if (tid == 0 && tl < 16) (void)xb_add(&flags[item], 1u);
    }
    if (tid < 192) {
      float hin = carry[ch];
      for (int s2 = 0; s2 < seg; ++s2) hin = segA[s2 * 48 + ch] * hin + segH[s2 * 48 + ch];
      const int cgl = n * 96 + half * 48 + ch;
#pragma unroll 8
      for (int r = seg * 32; r < seg * 32 + 32; ++r) {
        hin = sa[r * 48 + ch] * hin + sbx[r * 48 + ch];
        if (r < nvalid) gg[(size_t)(b * TP + t0 + r) * 1536 + cgl] = f2bf(hin * bf2f(*(const bf16_t*)(ggl + r * 96 + ch * 2)));
      }
    }
  }
  if (pass == 1) {
    if (!smp) {
      if (tl == 16 && half == 0 && tid < 96) {
#pragma unroll
        for (int wv = 0; wv < 3; ++wv) p.out[O_RCP + (b * 3 + wv) * 1536 + n * 96 + tid] = bf2f(xr[(size_t)(b * TP + TP - 3 + wv) * 1536 + n * 96 + tid]);
      }
    } else if (half == 0) {
      for (int idx = tid; idx < 128 * 96; idx += 256) {
        const int s2 = idx / 96, cc_ = idx - s2 * 96, cgl = n * 96 + cc_;
        p.out[O_RCS + (size_t)(s2 * 3 + 0) * 1536 + cgl] = p.in[6][(size_t)(s2 * 3 + 1) * 1536 + cgl];
        p.out[O_RCS + (size_t)(s2 * 3 + 1) * 1536 + cgl] = p.in[6][(size_t)(s2 * 3 + 2) * 1536 + cgl];
        p.out[O_RCS + (size_t)(s2 * 3 + 2) * 1536 + cgl] = bf2f(xr[(size_t)(NPR + s2) * 1536 + cgl]);
      }
    }
  }
  __syncthreads();
}

__device__ __forceinline__ void phase_final(const Params& p) {
  const int tid = threadIdx.x, lane = tid & 63;
  const bf16_t* xres = (const bf16_t*)(p.ws + WS_XB);
  const float* ssq = (const float*)(p.ws + WS_SSQ2);
  const int gw = blockIdx.x * 8 + (tid >> 6), nw = gridDim.x * 8;
  for (int r = gw; r < NR; r += nw) {
    float* dst;
    if (r >= NPR) dst = p.out + O_YS + (size_t)(r - NPR) * 1024;
    else { const int b = r / TP, t = r - b * TP; if (t < 16) continue; dst = p.out + O_YP + ((size_t)b * 2048 + (t - 16)) * 1024; }
    float s = lane < 4 ? ssq[(size_t)lane * NR + r] : 0.f;
    s = wave_sum(s);
    const float rstd = rsqrtf(s * (1.f / 1024.f) + EPSN);
    const uint2* src = (const uint2*)(xres + (size_t)r * 1024);
    const float4* nf = (const float4*)p.in[40];
#pragma unroll
    for (int j = 0; j < 4; ++j) {
      const uint2 u = src[lane + 64 * j];
      const float4 v = make_float4(lo2f(u.x), hi2f(u.x), lo2f(u.y), hi2f(u.y)), g = nf[lane + 64 * j];
      ((float4*)dst)[lane + 64 * j] = make_float4(v.x * rstd * g.x, v.y * rstd * g.y, v.z * rstd * g.z, v.w * rstd * g.w);
    }
  }
}

__global__ void __launch_bounds__(512, 2) mega_kernel(Params p) {
  extern __shared__ __attribute__((aligned(16))) char lds[];
  cg::grid_group grid = cg::this_grid();
  const bf16_t* wb = (const bf16_t*)p.out;
  volatile LAS unsigned* xst_ = (volatile LAS unsigned*)(lds + LDS_ST);
  if (threadIdx.x < 4) xst_[threadIdx.x] = 0u;
  __syncthreads();
  XcdBarrier xbar = xcd_barrier_post((unsigned*)(p.ws + WS_BAR), xst_);
  if (p.ph_hi > 1000) grid.sync();
#define PH(k, body) if (p.ph_lo <= (k) && (k) < p.ph_hi) { body; } if (p.ph_lo <= (k) && (k) + 1 < p.ph_hi) xcd_barrier(xbar);
  PH(0, phase_prep(p, lds))
  PH(1, phase_g1(p, lds))
  PH(2, phase_mix_a(p, lds))
  PH(3, phase_mix_b(p))
  PH(4, phase_mix_c(p, lds))
  PH(5, phase_glu(p, lds))
  PH(6, phase_resid(p, lds, (const bf16_t*)(p.ws + WS_SCR + SCR_ZB) + 512, 2048, wb + W_OUT0, 1024, 0, 1))
  PH(7, phase_ffn_up(p, lds, 0, 1))
  PH(8, phase_resid(p, lds, (const bf16_t*)(p.ws + WS_SCR + SCR_ACT), 2816, wb + W_DOWN, 2816, 16, 2))
  PH(9, phase_g5(p, lds))
  PH(10, for (int pr = blockIdx.x; pr < 2192; pr += gridDim.x) rglru_item(p, pr * 2 + (threadIdx.x >> 8), lds + (threadIdx.x >> 8) * HALF_LDS))
  PH(11, phase_resid(p, lds, (const bf16_t*)(p.ws + WS_SCR + SCR_GG), 1536, wb + W_OUT1, 1536, 32, 3))
  PH(12, phase_ffn_up(p, lds, 1, 3))
  PH(13, phase_resid(p, lds, (const bf16_t*)(p.ws + WS_SCR + SCR_ACT), 2816, wb + W_DOWN + (size_t)1024 * 2816, 2816, 48, 0))
  PH(14, phase_final(p))
}

extern "C" void kernel_launch(void* const* d_in, const int* in_sizes, int n_in, void* d_out, int out_size, void* d_ws, size_t ws_size, hipStream_t stream) {
  static int grid_blocks = 0;
  if (!grid_blocks) {
    int dev = 0, cus = 0, per_cu = 0;
    hipGetDevice(&dev);
    hipDeviceGetAttribute(&cus, hipDeviceAttributeMultiprocessorCount, dev);
    hipFuncSetAttribute((const void*)mega_kernel, hipFuncAttributeMaxDynamicSharedMemorySize, LDS_BYTES);
    hipOccupancyMaxActiveBlocksPerMultiprocessor(&per_cu, (const void*)mega_kernel, NTHR, LDS_BYTES);
    if (per_cu > 1) per_cu = 1;
    if (per_cu < 1) per_cu = 1;
    grid_blocks = cus * per_cu;
    if (n_in != 41 || ws_size < WS_NEED) fprintf(stderr, "kernel_launch: unexpected n_in %d or ws_size %zu (need %llu)\n", n_in, ws_size, (unsigned long long)WS_NEED);
  }
  Params p{};
  for (int i = 0; i < 41; ++i) p.in[i] = (const float*)d_in[i];
  p.out = (float*)d_out;
  p.ws = (char*)d_ws;
  (void)hipMemsetAsync((char*)d_ws + WS_BAR, 0, 16384, stream);
  (void)hipMemsetAsync((char*)d_ws + WS_FLAG, 0, 20480, stream);
#if MK_MULTI
  for (int ph = 0; ph < NPHASE; ++ph) {
    p.ph_lo = ph; p.ph_hi = ph + 1;
    hipLaunchKernelGGL(mega_kernel, dim3(grid_blocks), dim3(NTHR), LDS_BYTES, stream, p);
  }
#else
  p.ph_lo = 0; p.ph_hi = NPHASE;
  void* args[] = {&p};
  hipError_t e = hipLaunchCooperativeKernel((const void*)mega_kernel, dim3(grid_blocks), dim3(NTHR), args, LDS_BYTES, stream);
  if (e != hipSuccess) fprintf(stderr, "cooperative launch failed: %s (grid %d)\n", hipGetErrorString(e), grid_blocks);
#endif
}
```

```cpp
#include <hip/hip_runtime.h>
#include <hip/hip_cooperative_groups.h>
#include <stdint.h>
#include <stdio.h>
namespace cg = cooperative_groups;

#ifndef MK_MULTI
#define MK_MULTI 0
#endif

#define LAS __attribute__((address_space(3)))
typedef unsigned short bf16_t;
typedef __attribute__((ext_vector_type(8))) short bf16x8;
typedef __attribute__((ext_vector_type(4))) float f32x4;

#define TP 2064
#define NPR 16512
#define NR 16640
#define EPSN 1e-6f
#define NPHASE 15
#define LDS_BYTES 153600
#define HALF_LDS 75776
#define LDS_SRS 151552
#define LDS_ST 152576
#define LDS_TKL 152592
#define NTHR 512

#define O_YP 0
#define O_YS 16777216
#define O_GLAP 16908288
#define O_GLAS 17170432
#define O_S5RP 21364736
#define O_S5RS 21381120
#define O_S5IP 21643264
#define O_S5IS 21659648
#define O_HP 21921792
#define O_HS 21934080
#define O_RCP 22130688
#define O_RCS 22167552
#define O_FCP 22757376
#define O_FCS 22847488

#define W_IN0 0
#define W_GLU 2359296
#define W_OUT0 2621440
#define W_UP 3670016
#define W_DOWN 15204352
#define W_IN1 20971520
#define W_OUT1 24117248
#define W_GATE 25690112

#define WS_XB 0ull
#define WS_XRES 34078720ull
#define WS_SSQ 102236160ull
#define WS_S5AB 106496000ull
#define WS_S5BB 106545152ull
#define WS_S5CC 106807296ull
#define WS_XLOC 106938368ull
#define WS_XST 111263744ull
#define WS_DEC 115589120ull
#define WS_SCR 115859456ull
#define SCR_ZB 0ull
#define SCR_ALOG 68157440ull
#define SCR_SLOC 85196800ull
#define SCR_ACT 0ull
#define SCR_XR 0ull
#define SCR_GG 51118080ull
#define WS_BAR (WS_SCR + 119799808ull)
#define WS_ZERO (WS_BAR + 15360ull)
#define WS_NSP (WS_BAR + 16384ull)
#define WS_SLAB (WS_NSP + 8192ull)
#define WS_FLAG (WS_SLAB + 12582912ull)
#define WS_SSQ2 (WS_FLAG + 20480ull)
#define WS_NEED (WS_SSQ2 + 8519680ull)

struct Params {
  const float* in[41];
  float* out;
  char* ws;
  int ph_lo, ph_hi;
};

__device__ __forceinline__ bf16_t f2bf(float f) { uint32_t u = __float_as_uint(f); u += 0x7fffu + ((u >> 16) & 1u); return (bf16_t)(u >> 16); }
__device__ __forceinline__ float bf2f(bf16_t h) { return __uint_as_float(((uint32_t)h) << 16); }
__device__ __forceinline__ uint32_t pack2(float a, float b) { uint32_t r; asm("v_cvt_pk_bf16_f32 %0, %1, %2" : "=v"(r) : "v"(a), "v"(b)); return r; }
__device__ __forceinline__ uint32_t pack2_sw(float a, float b) { return (uint32_t)f2bf(a) | ((uint32_t)f2bf(b) << 16); }
__device__ __forceinline__ float lo2f(uint32_t u) { return __uint_as_float(u << 16); }
__device__ __forceinline__ float hi2f(uint32_t u) { return __uint_as_float(u & 0xffff0000u); }
__device__ __forceinline__ float sigm(float x) { return __builtin_amdgcn_rcpf(1.f + __expf(-x)); }
__device__ __forceinline__ float gelu_t(float x) { const float u = x * (1.5957691216f + 0.0713548162726f * x * x); return x * __builtin_amdgcn_rcpf(1.f + __expf(-u)); }
__device__ __forceinline__ float softplusf_(float x) { return fmaxf(x, 0.f) + __logf(1.f + __expf(-fabsf(x))); }
__device__ __forceinline__ float wave_sum(float v) {
#pragma unroll
  for (int o = 1; o < 64; o <<= 1) v += __shfl_xor(v, o);
  return v;
}
__device__ __forceinline__ int toff(int row, int chunk) { return row * 128 + ((chunk ^ (row & 7)) << 4); }
__device__ __forceinline__ f32x4 mfma16(bf16x8 a, bf16x8 b, f32x4 c) { return __builtin_amdgcn_mfma_f32_16x16x32_bf16(a, b, c, 0, 0, 0); }

__device__ __forceinline__ const float* xrow_src(const Params& p, int r) {
  if (r >= NPR) return p.in[1] + (size_t)(r - NPR) * 1024;
  int b = r / TP, t = r - b * TP;
  return t < 16 ? p.in[8] + t * 1024 : p.in[0] + ((size_t)b * 2048 + (t - 16)) * 1024;
}

#define TREFRESH() do { tid = threadIdx.x; asm volatile("" : "+v"(tid)); lane = tid & 63; w = tid >> 6; wr = w >> 2; wc = w & 3; lr = lane & 15; lq = lane >> 4; (void)w; (void)lane; } while (0)
__device__ __forceinline__ int lds_byte8(int r, int c) { const int st = (r >> 4) * 2 + (c >> 5), rr = r & 15, cc = c & 31, ob = rr * 64 + cc * 2; return st * 1024 + (ob ^ (((ob >> 9) & 1) << 5)); }
__device__ __forceinline__ void stage_rc8(int b, int& R, int& C) { const int st = b / 1024, sb = b % 1024, swz = sb ^ (((sb >> 9) & 1) << 5); R = (st >> 1) * 16 + swz / 64; C = (st & 1) * 32 + (swz % 64) / 2; }
template <class AF>
__device__ __forceinline__ void gemm_tile256(f32x4 (&acc)[8][4], const bf16_t* Ab, AF arow, const bf16_t* Bt, int ldb, int K, char* lds, const bf16_t* zpage) {
  const int wid = threadIdx.x >> 6, lane = threadIdx.x & 63, wr = wid >> 2, wc = wid & 3, fr = lane & 15, fq = lane >> 4;
#pragma unroll
  for (int m = 0; m < 8; ++m)
#pragma unroll
    for (int n = 0; n < 4; ++n) acc[m][n] = (f32x4){0.f, 0.f, 0.f, 0.f};
  int ao[2][2], bo[2][2];
#pragma unroll
  for (int i = 0; i < 2; ++i) {
    int r_, c_; stage_rc8(threadIdx.x * 16 + i * 8192, r_, c_);
#pragma unroll
    for (int h = 0; h < 2; ++h) {
      const int a = arow(h * 128 + r_);
      ao[h][i] = (a + c_) * 2;
      bo[h][i] = ((h * 128 + r_) * ldb + c_) * 2;
      asm volatile("" : "+v"(ao[h][i]), "+v"(bo[h][i]));
    }
  }
  char* lth = lds + threadIdx.x * 16;
  const __amdgpu_buffer_rsrc_t rA = __builtin_amdgcn_make_buffer_rsrc((void*)const_cast<bf16_t*>(Ab), (short)0, 0x7fffffff, 0x00020000);
  const __amdgpu_buffer_rsrc_t rB = __builtin_amdgcn_make_buffer_rsrc((void*)const_cast<bf16_t*>(Bt), (short)0, 0x7fffffff, 0x00020000);
#define SA8(b, h) (((b) * 2 + (h)) * 16384)
#define SB8(b, h) ((4 + (b) * 2 + (h)) * 16384)
#define STG_A(P, h, kt) do { _Pragma("unroll") for (int i_ = 0; i_ < 2; ++i_) \
    __builtin_amdgcn_raw_ptr_buffer_load_lds(rA, (LAS void*)(lth + (P) + i_ * 8192), 16, ao[h][i_], (kt) * 128, 0, 0); } while (0)
#define STG_B(P, h, kt) do { _Pragma("unroll") for (int i_ = 0; i_ < 2; ++i_) \
    __builtin_amdgcn_raw_ptr_buffer_load_lds(rB, (LAS void*)(lth + (P) + i_ * 8192), 16, bo[h][i_], (kt) * 128, 0, 0); } while (0)
#define LDA8(dst, b, h) do { _Pragma("unroll") for (int m = 0; m < 4; ++m) _Pragma("unroll") for (int k = 0; k < 2; ++k) \
    dst[m][k] = *(const bf16x8*)(lds + SA8(b, h) + lds_byte8(wr * 64 + m * 16 + fr, k * 32 + fq * 8)); } while (0)
#define LDB8(dst, b, h) do { _Pragma("unroll") for (int n = 0; n < 2; ++n) _Pragma("unroll") for (int k = 0; k < 2; ++k) \
    dst[n][k] = *(const bf16x8*)(lds + SB8(b, h) + lds_byte8(wc * 32 + n * 16 + fr, k * 32 + fq * 8)); } while (0)
#define MMA8(ai, bj, Ax, Bx) do { __builtin_amdgcn_s_setprio(1); \
    _Pragma("unroll") for (int m = 0; m < 4; ++m) _Pragma("unroll") for (int n = 0; n < 2; ++n) _Pragma("unroll") for (int k = 0; k < 2; ++k) \
      acc[(ai) * 4 + m][(bj) * 2 + n] = mfma16(Bx[n][k], Ax[m][k], acc[(ai) * 4 + m][(bj) * 2 + n]); \
    __builtin_amdgcn_s_setprio(0); } while (0)
#define WAIT_V(n) asm volatile("s_waitcnt vmcnt(" #n ")" ::: "memory")
#define WAIT_L(n) asm volatile("s_waitcnt lgkmcnt(" #n ")" ::: "memory")
#define BAR8 __builtin_amdgcn_s_barrier()
#define SCHED8 __builtin_amdgcn_sched_barrier(0)
  bf16x8 At[4][2], B0[2][2], B1[2][2];
  const int nt = K >> 6;
  STG_B(SB8(0, 0), 0, 0); STG_A(SA8(0, 0), 0, 0);
  STG_B(SB8(0, 1), 1, 0); STG_A(SA8(0, 1), 1, 0);
  if (wr == 1) BAR8;
  WAIT_V(4); BAR8;
  STG_B(SB8(1, 0), 0, 1); STG_A(SA8(1, 0), 0, 1); STG_B(SB8(1, 1), 1, 1);
  WAIT_V(6); BAR8;
  for (int t = 0; t < nt - 2; t += 2) {
    LDB8(B0, 0, 0); SCHED8; LDA8(At, 0, 0); STG_A(SA8(1, 1), 1, t + 1);
    WAIT_L(8); BAR8; WAIT_L(0); MMA8(0, 0, At, B0); BAR8; SCHED8;
    LDB8(B1, 0, 1); STG_B(SB8(0, 0), 0, t + 2);
    BAR8; WAIT_L(0); MMA8(0, 1, At, B1); BAR8;
    LDA8(At, 0, 1); STG_A(SA8(0, 0), 0, t + 2);
    BAR8; WAIT_L(0); MMA8(1, 0, At, B0); BAR8; SCHED8;
    STG_B(SB8(0, 1), 1, t + 2);
    WAIT_V(6); BAR8; MMA8(1, 1, At, B1); BAR8;
    LDB8(B0, 1, 0); SCHED8; LDA8(At, 1, 0); STG_A(SA8(0, 1), 1, t + 2);
    WAIT_L(8); BAR8; WAIT_L(0); MMA8(0, 0, At, B0); BAR8; SCHED8;
    LDB8(B1, 1, 1); STG_B(SB8(1, 0), 0, t + 3);
    BAR8; WAIT_L(0); MMA8(0, 1, At, B1); BAR8;
    LDA8(At, 1, 1); STG_A(SA8(1, 0), 0, t + 3);
    BAR8; WAIT_L(0); MMA8(1, 0, At, B0); BAR8; SCHED8;
    STG_B(SB8(1, 1), 1, t + 3);
    WAIT_V(6); BAR8; MMA8(1, 1, At, B1); BAR8;
  }
  { LDB8(B0, 0, 0); LDA8(At, 0, 0); STG_A(SA8(1, 1), 1, nt - 1);
    BAR8; WAIT_L(0); MMA8(0, 0, At, B0); BAR8;
    LDB8(B1, 0, 1); BAR8; WAIT_L(0); MMA8(0, 1, At, B1); BAR8;
    LDA8(At, 0, 1); WAIT_V(4); BAR8; WAIT_L(0); MMA8(1, 0, At, B0); MMA8(1, 1, At, B1); BAR8; }
  { LDB8(B0, 1, 0); LDA8(At, 1, 0); WAIT_V(2); BAR8; WAIT_L(0); MMA8(0, 0, At, B0); BAR8;
    LDB8(B1, 1, 1); WAIT_V(0); BAR8; WAIT_L(0); MMA8(0, 1, At, B1); BAR8;
    LDA8(At, 1, 1); BAR8; WAIT_L(0); MMA8(1, 0, At, B0); MMA8(1, 1, At, B1); BAR8; }
  if (wr == 0) BAR8;
#undef SA8
#undef SB8
#undef STG_A
#undef STG_B
#undef LDA8
#undef LDB8
#undef MMA8
  __syncthreads();
}

#define XB_TMO      128
#define XB_XCNT(j)  (256  + 64 * (j))
#define XB_XSUB(j)  (1280 + 64 * (j))
#define XB_XGEN(j)  (2304 + 64 * (j))
#define XB_TOP      3328
#define XB_TOPGEN   3392
#define XCD_BAR_WORDS 3456
#define XB_SPIN_CAP (1u << 22)
__device__ __forceinline__ unsigned xb_ld(unsigned* p)              { return __hip_atomic_load(p, __ATOMIC_RELAXED, __HIP_MEMORY_SCOPE_AGENT); }
__device__ __forceinline__ unsigned xb_add(unsigned* p, unsigned v) { return __hip_atomic_fetch_add(p, v, __ATOMIC_RELAXED, __HIP_MEMORY_SCOPE_AGENT); }
__device__ __forceinline__ unsigned xb_xcc_id() { return (unsigned)__builtin_amdgcn_s_getreg((3 << 11) | 20) & 0xFu; }
#define XB_SPIN(cond, bar) do { unsigned _sp = 0; while (cond) { __builtin_amdgcn_s_sleep(1); \
    if ((++_sp & 255u) == 0u) { if (xb_ld(&(bar)[XB_TMO])) break; if (_sp > XB_SPIN_CAP) { atomicAdd(&(bar)[XB_TMO], 1u); break; } } } } while (0)
struct XcdBarrier { unsigned* bar; unsigned x; volatile LAS unsigned* st; };
__device__ __forceinline__ XcdBarrier xcd_barrier_post(unsigned* bar, volatile LAS unsigned* st) {
    XcdBarrier b; b.bar = bar; b.x = xb_xcc_id(); b.st = st;
    if (threadIdx.x == 0) (void)xb_add(&bar[XB_XCNT(b.x)], 1u);
    return b;
}
__device__ __forceinline__ void xcd_barrier_complete(unsigned* bar, unsigned x, unsigned& nloc, unsigned& nx) {
    const unsigned G = gridDim.x * gridDim.y * gridDim.z;
    unsigned sum, cnt, mine, sp = 0u;
    for (;;) {
        sum = 0u; cnt = 0u; mine = 0u;
#pragma unroll
        for (unsigned j = 0; j < 16; ++j) { const unsigned c = xb_ld(&bar[XB_XCNT(j)]); sum += c; cnt += (c > 0u) ? 1u : 0u; mine = (j == x) ? c : mine; }
        if (sum == G) break;
        __builtin_amdgcn_s_sleep(1);
        if ((++sp & 255u) == 0u) { if (xb_ld(&bar[XB_TMO])) break; if (sp > XB_SPIN_CAP) { atomicAdd(&bar[XB_TMO], 1u); break; } }
    }
    nloc = mine > 0u ? mine : 1u; nx = cnt > 0u ? cnt : 1u;
}
__device__ __forceinline__ void xcd_barrier(const XcdBarrier& b) {
    asm volatile("s_waitcnt vmcnt(0)" ::: "memory");
    __syncthreads();
    if (threadIdx.x == 0) {
        unsigned* bar = b.bar;
        __builtin_amdgcn_s_waitcnt(0);
        unsigned nloc = b.st[0], nx = b.st[1];
        if (nloc == 0u) { xcd_barrier_complete(bar, b.x, nloc, nx); b.st[0] = nloc; b.st[1] = nx; }
        const unsigned old = xb_add(&bar[XB_XSUB(b.x)], 1u);
        const unsigned gen = old / nloc;
        if (old + 1u == (gen + 1u) * nloc) {
            __builtin_amdgcn_fence(__ATOMIC_RELEASE, "agent");
            asm volatile("s_waitcnt vmcnt(0)" ::: "memory");
            const unsigned og = xb_add(&bar[XB_TOP], 1u);
            const unsigned tg = og / nx;
            if (og + 1u == (tg + 1u) * nx) xb_add(&bar[XB_TOPGEN], 1u);
            else XB_SPIN(xb_ld(&bar[XB_TOPGEN]) == tg, bar);
            __builtin_amdgcn_fence(__ATOMIC_ACQUIRE, "agent");
            xb_add(&bar[XB_XGEN(b.x)], 1u);
            asm volatile("s_waitcnt vmcnt(0)" ::: "memory");
        } else {
            XB_SPIN(xb_ld(&bar[XB_XGEN(b.x)]) == gen, bar);
            __builtin_amdgcn_fence(__ATOMIC_ACQUIRE, "agent");
            asm volatile("s_waitcnt vmcnt(0)" ::: "memory");
        }
    }
    __syncthreads();
}


struct TileSched {
  int NT, m0, cnt, ntiles, nfull, local, nloc;
  __device__ __forceinline__ void init(int MT, int NT_) {
    NT = NT_;
    const int x = blockIdx.x & 7; local = blockIdx.x >> 3; nloc = gridDim.x >> 3;
    const int q = MT >> 3, r = MT & 7;
    cnt = q + (x < r ? 1 : 0); m0 = x * q + (x < r ? x : r);
    ntiles = cnt * NT; nfull = cnt >> 3;
  }
  int MTe, lin0;
  __device__ __forceinline__ void init_even(int MT, int NT_) {
    NT = NT_; MTe = MT;
    const int x = blockIdx.x & 7; local = blockIdx.x >> 3; nloc = gridDim.x >> 3;
    const int T = MT * NT_;
    lin0 = (int)(((long)T * x) >> 3);
    ntiles = (int)(((long)T * (x + 1)) >> 3) - lin0;
  }
  __device__ __forceinline__ void get_even(int i, int& mt, int& nt) const {
    const int L = lin0 + i, nfullg = MTe >> 3, full = nfullg * 8 * NT;
    if (L < full) { const int grp = L / (8 * NT), rem = L - grp * 8 * NT; nt = rem >> 3; mt = grp * 8 + (rem & 7); }
    else { const int i2 = L - full, gs = MTe - nfullg * 8; nt = i2 / gs; mt = nfullg * 8 + (i2 - nt * gs); }
  }
  __device__ __forceinline__ void get(int i, int& mt, int& nt) const {
    const int full = nfull * 8 * NT;
    if (i < full) { const int grp = i / (8 * NT), rem = i - grp * 8 * NT; nt = rem >> 3; mt = m0 + grp * 8 + (rem & 7); }
    else { const int i2 = i - full, gs = cnt - nfull * 8; nt = i2 / gs; mt = m0 + nfull * 8 + (i2 - nt * gs); }
  }
};

__device__ __forceinline__ float row_rstd(const float* ssq, int row) {
  float s = 0.f;
#pragma unroll
  for (int q = 0; q < 4; ++q) s += ssq[(size_t)q * NR + row];
  return rsqrtf(s * (1.f / 1024.f) + EPSN);
}

__device__ __forceinline__ void transpose_mat(const float* src, int ldsrc, int K, int N, bf16_t* dst, const float* scale, int kind, float* sm) {
  const int tid = threadIdx.x & 255;
  sm += (threadIdx.x >> 8) * 8448;
  const int nnb = N >> 7, ntile = (K >> 6) * nnb;
  for (int tile2 = blockIdx.x; tile2 < (ntile >> 1); tile2 += gridDim.x) {
    const int tile = tile2 * 2 + (threadIdx.x >> 8);
    const int kb = tile / nnb, nb4 = tile - kb * nnb;
    const int i = tid >> 3, j4 = tid & 7;
    float4 v[4][2];
#pragma unroll
    for (int sub = 0; sub < 4; ++sub) {
      const int nb = nb4 * 4 + sub;
      int scol;
      if (kind == 0) scol = nb * 32;
      else if (kind == 1) scol = nb * 32 < 1536 ? nb * 32 : nb * 32 + 16;
      else { int j = nb >> 3, half = (nb >> 2) & 1; scol = half * 2816 + j * 128 + (nb & 3) * 32; }
#pragma unroll
      for (int r = 0; r < 2; ++r) { const f32x4 t_ = __builtin_nontemporal_load((const f32x4*)(src + (size_t)(kb * 64 + i + 32 * r) * ldsrc + scol + j4 * 4)); v[sub][r] = make_float4(t_[0], t_[1], t_[2], t_[3]); }
    }
    const float sc0 = scale ? scale[kb * 64 + i] : 1.f, sc1 = scale ? scale[kb * 64 + i + 32] : 1.f;
#pragma unroll
    for (int sub = 0; sub < 4; ++sub) {
#pragma unroll
      for (int r = 0; r < 2; ++r) {
        const float sc = r ? sc1 : sc0;
        float* d = sm + sub * 2112 + (i + 32 * r) * 33 + j4 * 4;
        d[0] = v[sub][r].x * sc; d[1] = v[sub][r].y * sc; d[2] = v[sub][r].z * sc; d[3] = v[sub][r].w * sc;
      }
    }
    __syncthreads();
    {
      const int n = tid >> 3, kq = tid & 7;
#pragma unroll
      for (int sub = 0; sub < 4; ++sub) {
        const float* s2 = sm + sub * 2112 + (kq * 8) * 33 + n;
        uint4 o;
        o.x = pack2(s2[0], s2[33]); o.y = pack2(s2[66], s2[99]); o.z = pack2(s2[132], s2[165]); o.w = pack2(s2[198], s2[231]);
        *(uint4*)(dst + (size_t)((nb4 * 4 + sub) * 32 + n) * K + kb * 64 + kq * 8) = o;
      }
    }
    __syncthreads();
  }
}

__device__ __forceinline__ void phase_prep(const Params& p, char* lds) {
  const int tid = threadIdx.x, lane = tid & 63;
  bf16_t* wb = (bf16_t*)p.out;
  {
    bf16_t* xb = (bf16_t*)(p.ws + WS_XB);
    float* ssq = (float*)(p.ws + WS_SSQ2);
    const int gw = blockIdx.x * 8 + (tid >> 6), nw = gridDim.x * 8;
    for (int r = gw; r < NR; r += nw) {
      const float4* src = (const float4*)xrow_src(p, r);
      float s = 0.f;
#pragma unroll
      for (int j = 0; j < 4; ++j) {
        const f32x4 t_ = __builtin_nontemporal_load((const f32x4*)src + lane + 64 * j);
        float4 v = make_float4(t_[0], t_[1], t_[2], t_[3]);
        s += v.x * v.x + v.y * v.y + v.z * v.z + v.w * v.w;
        uint2 o; o.x = pack2(v.x, v.y); o.y = pack2(v.z, v.w);
        *(uint2*)(xb + (size_t)r * 1024 + (lane + 64 * j) * 4) = o;
      }
      s = wave_sum(s);
      if (lane < 4) ssq[(size_t)lane * NR + r] = lane == 0 ? s : 0.f;
    }
  }
  float* sm = (float*)lds;
  transpose_mat(p.in[10], 2064, 1024, 2048, wb + W_IN0, p.in[9], 1, sm);
  transpose_mat(p.in[22], 512, 512, 512, wb + W_GLU, nullptr, 0, sm);
  transpose_mat(p.in[24], 1024, 1024, 1024, wb + W_OUT0, nullptr, 0, sm);
  transpose_mat(p.in[36], 5632, 1024, 5632, wb + W_UP, p.in[35], 2, sm);
  transpose_mat(p.in[36] + (size_t)1024 * 5632, 5632, 1024, 5632, wb + W_UP + (size_t)5632 * 1024, p.in[35] + 1024, 2, sm);
  transpose_mat(p.in[39], 1024, 2816, 1024, wb + W_DOWN, nullptr, 0, sm);
  transpose_mat(p.in[39] + (size_t)2816 * 1024, 1024, 2816, 1024, wb + W_DOWN + (size_t)1024 * 2816, nullptr, 0, sm);
  transpose_mat(p.in[26], 3072, 1024, 3072, wb + W_IN1, p.in[25], 0, sm);
  transpose_mat(p.in[34], 1024, 1536, 1024, wb + W_OUT1, nullptr, 0, sm);
  const int gt = blockIdx.x * 512 + tid, ngt = gridDim.x * 512;
  for (int idx = gt; idx < 256 * 1024; idx += ngt) {
    const int c = idx >> 10, k = idx & 1023;
    const float* wi = p.in[10] + (size_t)k * 2064 + 1536;
    float s = 0.f;
#pragma unroll
    for (int r = 0; r < 16; ++r) s += wi[r] * p.in[11][r * 256 + c];
    wb[W_IN0 + (size_t)(2048 + c) * 1024 + k] = f2bf(s * p.in[9][k]);
  }
  for (int idx = gt; idx < 2 * 16 * 96 * 96; idx += ngt) {
    const int mat = idx / 147456, rem = idx - mat * 147456;
    const int nb = rem / 9216, r2 = rem - nb * 9216, d = r2 / 96, c = r2 - d * 96;
    const float* src = mat ? p.in[31] : p.in[29];
    wb[W_GATE + idx] = f2bf(src[nb * 9216 + c * 96 + d]);
  }
  for (int idx = gt; idx < 1536; idx += ngt) ((float*)(p.ws + WS_NSP))[idx] = -8.f * softplusf_(-p.in[33][idx]);
  for (int idx = gt; idx < 2048; idx += ngt) {
    const int g = idx >> 6;
    const float dt = expf(p.in[16][g]);
    const float lr = p.in[14][idx], li = p.in[15][idx];
    const float y = li * dt;
    const float kk = rintf(y * 0.15915494309189535f);
    float yr = fmaf(-kk, 6.2831854820251465f, y);
    yr = fmaf(-kk, -1.7484555e-7f, yr);
    const float sn = sinf(yr), cs = cosf(yr);
    const float mag = expf(lr * dt);
    const float abr = mag * cs, abi = mag * sn;
    const float sh = sinf(0.5f * yr);
    const float nr = expm1f(lr * dt) * cs - 2.f * sh * sh, ni = abi;
    const float den = lr * lr + li * li;
    const float fr = (nr * lr + ni * li) / den, fi = (ni * lr - nr * li) / den;
    float* ab = (float*)(p.ws + WS_S5AB);
    ab[idx] = abr; ab[2048 + idx] = abi;
    float pr = abr, pi = abi;
#pragma unroll
    for (int q = 0; q < 4; ++q) { float t = pr * pr - pi * pi; pi = 2.f * pr * pi; pr = t; }
    ab[4096 + idx] = pr; ab[6144 + idx] = pi;
#pragma unroll
    for (int q = 0; q < 2; ++q) { float t = pr * pr - pi * pi; pi = 2.f * pr * pi; pr = t; }
    ab[8192 + idx] = pr; ab[10240 + idx] = pi;
    float* bbr = (float*)(p.ws + WS_S5BB);
    float* bbi = bbr + 2048 * 16;
#pragma unroll
    for (int h = 0; h < 16; ++h) {
      const float br = p.in[17][idx * 16 + h], bi = p.in[18][idx * 16 + h];
      bbr[idx * 16 + h] = fr * br - fi * bi;
      bbi[idx * 16 + h] = fr * bi + fi * br;
    }
    bf16_t* cc = (bf16_t*)(p.ws + WS_S5CC);
    const int pp = idx & 63;
#pragma unroll
    for (int h = 0; h < 16; ++h) {
      cc[(g * 16 + h) * 128 + 2 * pp] = f2bf(p.in[19][(g * 16 + h) * 64 + pp]);
      cc[(g * 16 + h) * 128 + 2 * pp + 1] = f2bf(-p.in[20][(g * 16 + h) * 64 + pp]);
    }
  }
}

__device__ __forceinline__ void g1_store(const Params& p, bf16_t* zb, float* alog, int row, int col, float v0, float v1, float v2, float v3) {
  if (col < 2048) {
    if (col < 256) { v0 *= 0.125f; v1 *= 0.125f; v2 *= 0.125f; v3 *= 0.125f; }
    uint2 o; o.x = pack2(v0, v1); o.y = pack2(v2, v3);
    *(uint2*)(zb + (size_t)row * 2048 + col) = o;
  } else {
    const int c = col - 2048;
    const float4 ba = *(const float4*)(p.in[12] + c);
    float4 o;
    o.x = -softplusf_(-(v0 + ba.x)) * 0.0625f; o.y = -softplusf_(-(v1 + ba.y)) * 0.0625f;
    o.z = -softplusf_(-(v2 + ba.z)) * 0.0625f; o.w = -softplusf_(-(v3 + ba.w)) * 0.0625f;
    *(float4*)(alog + (size_t)row * 256 + c) = o;
  }
}
__device__ __forceinline__ void phase_g1(const Params& p, char* lds) {
  int tid, lane, w, wr, wc, lr, lq; TREFRESH();
  const bf16_t* zp = (const bf16_t*)(p.ws + WS_ZERO);
  const bf16_t* xb = (const bf16_t*)(p.ws + WS_XB);
  const bf16_t* W = (const bf16_t*)p.out + W_IN0;
  const float* ssq = (const float*)(p.ws + WS_SSQ2);
  bf16_t* zb = (bf16_t*)(p.ws + WS_SCR + SCR_ZB);
  float* alog = (float*)(p.ws + WS_SCR + SCR_ALOG);
  float* srs = (float*)(lds + LDS_SRS);
  unsigned* flg = (unsigned*)(p.ws + WS_FLAG);
  const int u = blockIdx.x;
  const bool unitA = u < 128, unitB = u >= 128 && u < 164;
  const int umt = unitA ? (u >> 1) : 64, unt = unitA ? 8 : ((u - 128) >> 2), uks = unitA ? (u & 1) : ((u - 128) & 3);
  const int uK = unitA ? 512 : 256, nsl = unitA ? 2 : 4;
  float* slab0 = unitA ? (float*)(p.ws + WS_SCR + SCR_SLOC) + (size_t)(u >> 1) * 2 * 65536 : (float*)(p.ws + WS_SLAB) + (size_t)unt * 4 * 65536;
  unsigned* tick = unitA ? flg + 4432 + (u >> 1) : flg + 4496 + unt;
  if (unitA || unitB) {
    const int k0 = uks * uK;
    f32x4 acc[8][4];
    gemm_tile256(acc, xb + k0, [&](int i) { return (umt * 256 + i) * 1024; }, W + (size_t)unt * 256 * 1024 + k0, 1024, uK, lds, zp);
    TREFRESH(); int zE = 0; asm volatile("" : "+v"(zE));
    float* slab = slab0 + (size_t)uks * 65536;
#pragma unroll
    for (int m = 0; m < 8; ++m)
#pragma unroll
      for (int n = 0; n < 4; ++n)
        *(float4*)(slab + ((m >> 2) * 128 + wr * 64 + (m & 3) * 16 + lr + zE) * 256 + (n >> 1) * 128 + wc * 32 + (n & 1) * 16 + lq * 4 + zE) = make_float4(acc[m][n][0], acc[m][n][1], acc[m][n][2], acc[m][n][3]);
    asm volatile("s_waitcnt vmcnt(0)" ::: "memory");
    __syncthreads();
    if (tid == 0) {
      __builtin_amdgcn_fence(__ATOMIC_RELEASE, "agent");
      asm volatile("s_waitcnt vmcnt(0)" ::: "memory");
      (void)xb_add(tick, 1u);
    }
  }
  TileSched ts; ts.init(64, 8);
  for (int ti = ts.local; ti < ts.ntiles; ti += ts.nloc) {
    int mt, nt; ts.get(ti, mt, nt);
    if (tid < 256) srs[tid] = row_rstd(ssq, mt * 256 + tid);
    f32x4 acc[8][4];
    gemm_tile256(acc, xb, [&](int i) { return (mt * 256 + i) * 1024; }, W + (size_t)nt * 256 * 1024, 1024, 1024, lds, zp);
    TREFRESH(); int zE = 0; asm volatile("" : "+v"(zE));
#pragma unroll
    for (int m = 0; m < 8; ++m) {
      const int r = (m >> 2) * 128 + wr * 64 + (m & 3) * 16 + lr + zE, row = mt * 256 + r;
      const float rs = srs[r];
#pragma unroll
      for (int n = 0; n < 4; ++n) {
        const int col = nt * 256 + (n >> 1) * 128 + wc * 32 + (n & 1) * 16 + lq * 4 + zE;
        f32x4 v = acc[m][n] * rs;
        if (col < 256) v = v * 0.125f;
        uint2 o; o.x = pack2(v[0], v[1]); o.y = pack2(v[2], v[3]);
        *(uint2*)(zb + (size_t)row * 2048 + col) = o;
      }
    }
    __syncthreads();
  }
  if (unitA || unitB) {
    if (tid == 0) {
      XB_SPIN(xb_ld(tick) < (unsigned)nsl, (unsigned*)(p.ws + WS_BAR));
      __builtin_amdgcn_fence(__ATOMIC_ACQUIRE, "agent");
      asm volatile("s_waitcnt vmcnt(0)" ::: "memory");
    }
    __syncthreads();
    const int rpb = 256 / nsl, r0 = uks * rpb;
    for (int rr = r0 + (tid >> 6); rr < r0 + rpb; rr += 8) {
      const int c4 = tid & 63, row = umt * 256 + rr, col = unt * 256 + c4 * 4;
      const float* s4 = slab0 + rr * 256 + c4 * 4;
      float4 sum = make_float4(0.f, 0.f, 0.f, 0.f);
      for (int q = 0; q < nsl; ++q) { const float4 v = *(const float4*)(s4 + (size_t)q * 65536); sum.x += v.x; sum.y += v.y; sum.z += v.z; sum.w += v.w; }
      const float rs = row_rstd(ssq, row);
      g1_store(p, zb, alog, row, col, sum.x * rs, sum.y * rs, sum.z * rs, sum.w * rs);
    }
  }
}

__device__ __forceinline__ void gla_chunk(const Params& p, int item, int mode, char* lds) {
  const int tid = threadIdx.x & 255, lane = tid & 63, w = tid >> 6, lr = lane & 15, lq = lane >> 4;
  const int bh = item / 33, c = item - bh * 33, b = bh >> 2, h = bh & 3;
  const int row0 = b * TP + (c == 0 ? 0 : 16 + 64 * (c - 1));
  const int len = c == 0 ? 16 : 64;
  bf16_t* zb = (bf16_t*)(p.ws + WS_SCR + SCR_ZB);
  const float* alog = (const float*)(p.ws + WS_SCR + SCR_ALOG);
  float* sloc = (float*)(p.ws + WS_SCR + SCR_SLOC) + (size_t)(bh * 33 + c) * 8192;
  float* sb = (float*)lds;
  char* Qs = lds + 16384; char* Ks = lds + 24576; char* VT = lds + 32768; char* ST = lds + 49152;
#pragma unroll
  for (int i = 0; i < 4; ++i) {
    const int idx = tid + 256 * i, r = idx >> 4, c4 = idx & 15;
    float4 v = make_float4(0.f, 0.f, 0.f, 0.f);
    if (r < len) v = *(const float4*)(alog + (size_t)(row0 + r) * 256 + h * 64 + c4 * 4);
    *(float4*)(sb + r * 64 + c4 * 4) = v;
  }
  __syncthreads();
  {
    float run = 0.f;
#pragma unroll
    for (int t = 0; t < 16; ++t) { run += sb[(16 * w + t) * 64 + lane]; sb[(16 * w + t) * 64 + lane] = run; }
  }
  __syncthreads();
  float off = 0.f;
#pragma unroll
  for (int s = 0; s < 3; ++s) if (s < w) off += sb[(16 * s + 15) * 64 + lane];
  __syncthreads();
#pragma unroll
  for (int t = 0; t < 16; ++t) sb[(16 * w + t) * 64 + lane] += off;
  __syncthreads();
#pragma unroll
  for (int i = 0; i < 2; ++i) {
    const int idx = tid + 256 * i, r = idx & 63, ch = idx >> 6;
    uint4 qv = make_uint4(0, 0, 0, 0), kv = make_uint4(0, 0, 0, 0);
    if (r < len) {
      const bf16_t* zr = zb + (size_t)(row0 + r) * 2048 + h * 64 + ch * 8;
      qv = *(const uint4*)zr; kv = *(const uint4*)(zr + 256);
    }
    float bv[8];
#pragma unroll
    for (int e = 0; e < 8; ++e) bv[e] = sb[r * 64 + ch * 8 + e];
    const uint32_t qq[4] = {qv.x, qv.y, qv.z, qv.w}, kq[4] = {kv.x, kv.y, kv.z, kv.w};
    if (mode == 1) {
      uint32_t oq[4], ok[4];
#pragma unroll
      for (int e = 0; e < 4; ++e) {
        const float e0 = __expf(bv[2 * e]), e1 = __expf(bv[2 * e + 1]);
        oq[e] = pack2(lo2f(qq[e]) * e0, hi2f(qq[e]) * e1);
        ok[e] = pack2(lo2f(kq[e]) * __builtin_amdgcn_rcpf(e0), hi2f(kq[e]) * __builtin_amdgcn_rcpf(e1));
      }
      *(uint4*)(Qs + toff(r, ch)) = make_uint4(oq[0], oq[1], oq[2], oq[3]);
      *(uint4*)(Ks + toff(r, ch)) = make_uint4(ok[0], ok[1], ok[2], ok[3]);
    } else {
#pragma unroll
      for (int e = 0; e < 8; ++e) {
        const int d = ch * 8 + e;
        const float kf = (e & 1) ? hi2f(kq[e >> 1]) : lo2f(kq[e >> 1]);
        const float kh = kf * __expf(sb[63 * 64 + d] - bv[e]);
        *(bf16_t*)(Qs + d * 128 + ((((r >> 3) ^ (d & 7))) << 4) + (r & 7) * 2) = f2bf(kh);
      }
    }
  }
#pragma unroll
  for (int i = 0; i < 4; ++i) {
    const int idx = tid + 256 * i, r = idx & 63, ch = idx >> 6;
    uint4 vv = make_uint4(0, 0, 0, 0);
    if (r < len) vv = *(const uint4*)(zb + (size_t)(row0 + r) * 2048 + 512 + h * 128 + ch * 8);
    const uint32_t vq[4] = {vv.x, vv.y, vv.z, vv.w};
#pragma unroll
    for (int e = 0; e < 8; ++e) {
      const int ee = ch * 8 + e;
      const bf16_t val = (bf16_t)((e & 1) ? (vq[e >> 1] >> 16) : (vq[e >> 1] & 0xffffu));
      *(bf16_t*)(VT + ee * 128 + ((((r >> 3) ^ (ee & 7))) << 4) + (r & 7) * 2) = val;
    }
  }
  if (mode == 1) {
#pragma unroll
    for (int i = 0; i < 4; ++i) {
      const int idx = tid + 256 * i, e = idx >> 3, ch = idx & 7;
      const float4 a = *(const float4*)(sloc + e * 64 + ch * 8);
      const float4 bq = *(const float4*)(sloc + e * 64 + ch * 8 + 4);
      *(uint4*)(ST + toff(e, ch)) = make_uint4(pack2(a.x, a.y), pack2(a.z, a.w), pack2(bq.x, bq.y), pack2(bq.z, bq.w));
    }
  }
  __syncthreads();
  if (mode == 1) {
    f32x4 at[4];
#pragma unroll
    for (int n = 0; n < 4; ++n) at[n] = (f32x4){0.f, 0.f, 0.f, 0.f};
#pragma unroll
    for (int s = 0; s < 2; ++s) {
      const bf16x8 a = *(const bf16x8*)(Qs + toff(16 * w + lr, s * 4 + lq));
#pragma unroll
      for (int n = 0; n < 4; ++n) {
        const bf16x8 bk = *(const bf16x8*)(Ks + toff(16 * n + lr, s * 4 + lq));
        at[n] = mfma16(bk, a, at[n]);
      }
    }
    char* P = lds;
    const int i = 16 * w + lr;
#pragma unroll
    for (int n = 0; n < 4; ++n) {
      const int j0 = 16 * n + lq * 4;
      float v0 = (j0 + 0 <= i) ? at[n][0] : 0.f, v1 = (j0 + 1 <= i) ? at[n][1] : 0.f;
      float v2 = (j0 + 2 <= i) ? at[n][2] : 0.f, v3 = (j0 + 3 <= i) ? at[n][3] : 0.f;
      uint2 o; o.x = pack2(v0, v1); o.y = pack2(v2, v3);
      *(uint2*)(P + i * 128 + ((((j0 >> 3) ^ (i & 7))) << 4) + (j0 & 7) * 2) = o;
    }
    __syncthreads();
    f32x4 o[8];
#pragma unroll
    for (int n = 0; n < 8; ++n) o[n] = (f32x4){0.f, 0.f, 0.f, 0.f};
#pragma unroll
    for (int s = 0; s < 2; ++s) {
      const bf16x8 aP = *(const bf16x8*)(P + toff(16 * w + lr, s * 4 + lq));
      const bf16x8 aQ = *(const bf16x8*)(Qs + toff(16 * w + lr, s * 4 + lq));
#pragma unroll
      for (int n = 0; n < 8; ++n) {
        const bf16x8 bV = *(const bf16x8*)(VT + toff(16 * n + lr, s * 4 + lq));
        const bf16x8 bS = *(const bf16x8*)(ST + toff(16 * n + lr, s * 4 + lq));
        o[n] = mfma16(bV, aP, o[n]);
        o[n] = mfma16(bS, aQ, o[n]);
      }
    }
    float ss = 0.f;
#pragma unroll
    for (int n = 0; n < 8; ++n) ss += o[n][0] * o[n][0] + o[n][1] * o[n][1] + o[n][2] * o[n][2] + o[n][3] * o[n][3];
    ss += __shfl_xor(ss, 16); ss += __shfl_xor(ss, 32);
    const float rstd = rsqrtf(ss * (1.f / 128.f) + EPSN);
    if (i < len) {
      bf16_t* zr = zb + (size_t)(row0 + i) * 2048;
#pragma unroll
      for (int n = 0; n < 8; ++n) {
        const int e0 = 16 * n + lq * 4;
        const uint2 g2 = *(const uint2*)(zr + 1024 + h * 128 + e0);
        const float4 gn = *(const float4*)(p.in[13] + h * 128 + e0);
        const float g0 = lo2f(g2.x), g1 = hi2f(g2.x), g2f = lo2f(g2.y), g3 = hi2f(g2.y);
        uint2 ov;
        ov.x = pack2(o[n][0] * rstd * gn.x * g0 * sigm(g0), o[n][1] * rstd * gn.y * g1 * sigm(g1));
        ov.y = pack2(o[n][2] * rstd * gn.z * g2f * sigm(g2f), o[n][3] * rstd * gn.w * g3 * sigm(g3));
        *(uint2*)(zr + 512 + h * 128 + e0) = ov;
      }
    }
  } else {
    f32x4 sl[8];
#pragma unroll
    for (int n = 0; n < 8; ++n) sl[n] = (f32x4){0.f, 0.f, 0.f, 0.f};
#pragma unroll
    for (int s = 0; s < 2; ++s) {
      const bf16x8 aK = *(const bf16x8*)(Qs + toff(16 * w + lr, s * 4 + lq));
#pragma unroll
      for (int n = 0; n < 8; ++n) {
        const bf16x8 bV = *(const bf16x8*)(VT + toff(16 * n + lr, s * 4 + lq));
        sl[n] = mfma16(aK, bV, sl[n]);
      }
    }
#pragma unroll
    for (int n = 0; n < 8; ++n) {
      const int e = 16 * n + lr, d0 = 16 * w + lq * 4;
      *(float4*)(sloc + e * 64 + d0) = make_float4(sl[n][0], sl[n][1], sl[n][2], sl[n][3]);
    }
    if (tid < 64) ((float*)(p.ws + WS_DEC))[(bh * 33 + c) * 64 + tid] = __expf(sb[63 * 64 + tid]);
  }
  __syncthreads();
}

__device__ __forceinline__ void gla_sample(const Params& p, int item, char* lds) {
  const int tid = threadIdx.x & 255;
  const int s = item >> 2, h = item & 3, row = NPR + s;
  bf16_t* zb = (bf16_t*)(p.ws + WS_SCR + SCR_ZB);
  const float* alog = (const float*)(p.ws + WS_SCR + SCR_ALOG);
  float* sq = (float*)lds; float* sk = sq + 64; float* sa = sk + 64; float* part = sa + 64; float* red = part + 256;
  if (tid < 64) {
    sq[tid] = bf2f(zb[(size_t)row * 2048 + h * 64 + tid]);
    sk[tid] = bf2f(zb[(size_t)row * 2048 + 256 + h * 64 + tid]);
    sa[tid] = __expf(alog[(size_t)row * 256 + h * 64 + tid]);
  }
  __syncthreads();
  const int e = tid & 127, half = tid >> 7;
  const float v = bf2f(zb[(size_t)row * 2048 + 512 + h * 128 + e]);
  const float* S0 = p.in[2] + (size_t)(s * 4 + h) * 8192;
  float* So = p.out + O_GLAS + (size_t)(s * 4 + h) * 8192;
  float acc = 0.f;
#pragma unroll 8
  for (int dd = 0; dd < 32; ++dd) {
    const int d = half * 32 + dd;
    const float sn = sa[d] * S0[d * 128 + e] + sk[d] * v;
    So[d * 128 + e] = sn;
    acc += sq[d] * sn;
  }
  part[tid] = acc;
  __syncthreads();
  float o = 0.f;
  if (tid < 128) { o = part[tid] + part[tid + 128]; }
  float ssv = wave_sum(tid < 128 ? o * o : 0.f);
  if ((tid & 63) == 0) red[tid >> 6] = ssv;
  __syncthreads();
  if (tid < 128) {
    const float rstd = rsqrtf((red[0] + red[1]) * (1.f / 128.f) + EPSN);
    const float g = bf2f(zb[(size_t)row * 2048 + 1024 + h * 128 + e]);
    zb[(size_t)row * 2048 + 512 + h * 128 + e] = f2bf(o * rstd * p.in[13][h * 128 + e] * g * sigm(g));
  }
  __syncthreads();
}

typedef __attribute__((ext_vector_type(2))) float f32x2;
__device__ __forceinline__ void s5_load_u(const bf16_t* zb, int row0, int len, int g, int lane, char* ul) {
  uint4 a = make_uint4(0, 0, 0, 0), b = a;
  if (lane < len) {
    const uint4* s = (const uint4*)(zb + (size_t)(row0 + lane) * 2048 + 1536 + g * 16);
    a = s[0]; b = s[1];
  }
  float4* d = (float4*)(ul + lane * 64);
  d[0] = make_float4(lo2f(a.x), hi2f(a.x), lo2f(a.y), hi2f(a.y));
  d[1] = make_float4(lo2f(a.z), hi2f(a.z), lo2f(a.w), hi2f(a.w));
  d[2] = make_float4(lo2f(b.x), hi2f(b.x), lo2f(b.y), hi2f(b.y));
  d[3] = make_float4(lo2f(b.z), hi2f(b.z), lo2f(b.w), hi2f(b.w));
}
__device__ __forceinline__ void s5_load_bb(const float* bbrp, int idx, f32x2 (&bb)[16]) {
#pragma unroll
  for (int q = 0; q < 4; ++q) {
    const float4 x = *(const float4*)(bbrp + idx * 16 + q * 4), y = *(const float4*)(bbrp + 32768 + idx * 16 + q * 4);
    bb[4 * q] = (f32x2){x.x, y.x}; bb[4 * q + 1] = (f32x2){x.y, y.y}; bb[4 * q + 2] = (f32x2){x.z, y.z}; bb[4 * q + 3] = (f32x2){x.w, y.w};
  }
}
__device__ __forceinline__ void s5_step(const char* ul, int t, const f32x2 (&bb)[16], float ar, float ai, float& xr, float& xi) {
  const float4* u = (const float4*)(ul + t * 64);
  const float4 u0 = u[0], u1 = u[1], u2 = u[2], u3 = u[3];
  f32x2 acc = bb[0] * u0.x;
  acc += bb[1] * u0.y; acc += bb[2] * u0.z; acc += bb[3] * u0.w;
  acc += bb[4] * u1.x; acc += bb[5] * u1.y; acc += bb[6] * u1.z; acc += bb[7] * u1.w;
  acc += bb[8] * u2.x; acc += bb[9] * u2.y; acc += bb[10] * u2.z; acc += bb[11] * u2.w;
  acc += bb[12] * u3.x; acc += bb[13] * u3.y; acc += bb[14] * u3.z; acc += bb[15] * u3.w;
  const float nr = ar * xr - ai * xi + acc[0], ni = ar * xi + ai * xr + acc[1];
  xr = nr; xi = ni;
}

__device__ __forceinline__ void s5_pass1(const Params& p, char* lds) {
  const int tid = threadIdx.x, lane = tid & 63, w = tid >> 6;
  const bf16_t* zb = (const bf16_t*)(p.ws + WS_SCR + SCR_ZB);
  const float* ab = (const float*)(p.ws + WS_S5AB);
  const float* bbrp = (const float*)(p.ws + WS_S5BB);
  float* xloc = (float*)(p.ws + WS_XLOC);
  char* ul = lds + w * 4096;
  const int nitem = 8 * 32 * 32;
  for (int base = blockIdx.x * 8; base < nitem; base += gridDim.x * 8) {
    const int item = base + w;
    const bool valid = item < nitem;
    const int it = valid ? item : 0;
    const int bg = it >> 5, c = it & 31, b = bg >> 5, g = bg & 31;
    const int row0 = b * TP + (c == 0 ? 0 : 16 + 64 * (c - 1));
    const int len = c == 0 ? 16 : 64;
    const int idx = g * 64 + lane;
    f32x2 bb[16];
    s5_load_bb(bbrp, idx, bb);
    const float ar = ab[idx], ai = ab[2048 + idx];
    __syncthreads();
    s5_load_u(zb, row0, len, g, lane, ul);
    __syncthreads();
    float xr = 0.f, xi = 0.f;
    for (int t = 0; t < len; ++t) s5_step(ul, t, bb, ar, ai, xr, xi);
    if (valid) {
      xloc[(size_t)(bg * 33 + c) * 64 + lane] = xr;
      xloc[540672 + (size_t)(bg * 33 + c) * 64 + lane] = xi;
    }
  }
}

__device__ __forceinline__ void s5_pass2(const Params& p) {
  const int gt = blockIdx.x * 512 + threadIdx.x;
  if (gt >= 16384) return;
  const int bg = gt >> 6, pp = gt & 63, g = bg & 31, idx = g * 64 + pp;
  const float* ab = (const float*)(p.ws + WS_S5AB);
  const float* xloc = (const float*)(p.ws + WS_XLOC);
  float* xst = (float*)(p.ws + WS_XST);
  const float a16r = ab[4096 + idx], a16i = ab[6144 + idx], a64r = ab[8192 + idx], a64i = ab[10240 + idx];
  float xr = 0.f, xi = 0.f;
  const size_t o0 = (size_t)bg * 33 * 64 + pp;
  xst[o0] = 0.f; xst[540672 + o0] = 0.f;
#pragma unroll 1
  for (int c0 = 0; c0 < 32; c0 += 8) {
    float lr_[8], li_[8];
#pragma unroll
    for (int q = 0; q < 8; ++q) { lr_[q] = xloc[o0 + (c0 + q) * 64]; li_[q] = xloc[540672 + o0 + (c0 + q) * 64]; }
#pragma unroll
    for (int q = 0; q < 8; ++q) {
      const int c = c0 + q;
      const float Ar = c == 0 ? a16r : a64r, Ai = c == 0 ? a16i : a64i;
      const float nr = Ar * xr - Ai * xi + lr_[q], ni = Ar * xi + Ai * xr + li_[q];
      xr = nr; xi = ni;
      xst[o0 + (c + 1) * 64] = xr; xst[540672 + o0 + (c + 1) * 64] = xi;
    }
  }
}

__device__ __forceinline__ void s5_pass3(const Params& p, char* lds) {
  const int tid = threadIdx.x, lane = tid & 63, w = tid >> 6, lr = lane & 15, lq = lane >> 4;
  bf16_t* zb = (bf16_t*)(p.ws + WS_SCR + SCR_ZB);
  const float* ab = (const float*)(p.ws + WS_S5AB);
  const float* bbrp = (const float*)(p.ws + WS_S5BB);
  const float* xst = (const float*)(p.ws + WS_XST);
  const bf16_t* cc = (const bf16_t*)(p.ws + WS_S5CC);
  char* ul = lds + w * 4096;
  char* X = lds + 32768 + w * 8192;
  const int nprompt = 8 * 32 * 33, nitem = nprompt + 128 * 32;
  for (int base = blockIdx.x * 8; base < nitem; base += gridDim.x * 8) {
    const int item = base + w;
    const bool valid = item < nitem;
    const int it = valid ? item : 0;
    int b, g, c, row0, len; bool last, smp;
    float xr, xi;
    if (it < nprompt) {
      const int bg = it / 33; c = it - bg * 33; b = bg >> 5; g = bg & 31; smp = false;
      row0 = b * TP + (c == 0 ? 0 : 16 + 64 * (c - 1)); len = c == 0 ? 16 : 64; last = c == 32;
      xr = xst[(size_t)it * 64 + lane]; xi = xst[540672 + (size_t)it * 64 + lane];
    } else {
      const int i2 = it - nprompt; b = i2 >> 5; g = i2 & 31; c = 0; smp = true;
      row0 = NPR + b; len = 1; last = true;
      xr = p.in[3][(b * 32 + g) * 64 + lane]; xi = p.in[4][(b * 32 + g) * 64 + lane];
    }
    const int idx = g * 64 + lane;
    f32x2 bb[16];
    s5_load_bb(bbrp, idx, bb);
    const float ar = ab[idx], ai = ab[2048 + idx];
    bf16x8 bC[4];
#pragma unroll
    for (int s = 0; s < 4; ++s) bC[s] = *(const bf16x8*)(cc + (g * 16 + lr) * 128 + 32 * s + 8 * lq);
    const float4 dd = *(const float4*)(p.in[21] + g * 16 + lq * 4);
    __syncthreads();
    s5_load_u(zb, row0, len, g, lane, ul);
    __syncthreads();
#pragma unroll 1
    for (int half = 0; half < 2; ++half) {
      const int tl = len - 32 * half < 32 ? len - 32 * half : 32;
      for (int tt = 0; tt < tl; ++tt) {
        s5_step(ul, 32 * half + tt, bb, ar, ai, xr, xi);
        *(uint32_t*)(X + tt * 256 + ((((lane >> 2) ^ (tt & 15))) << 4) + (lane & 3) * 4) = pack2(xr, xi);
      }
      __syncthreads();
      f32x4 y[2];
#pragma unroll
      for (int m = 0; m < 2; ++m) {
        y[m] = (f32x4){0.f, 0.f, 0.f, 0.f};
        const int row = 16 * m + lr;
#pragma unroll
        for (int s = 0; s < 4; ++s) {
          const bf16x8 a = *(const bf16x8*)(X + row * 256 + ((((s * 4 + lq) ^ (row & 15))) << 4));
          y[m] = mfma16(bC[s], a, y[m]);
        }
      }
#pragma unroll
      for (int m = 0; m < 2; ++m) {
        const int t = 32 * half + 16 * m + lr;
        if (valid && t < len) {
          const float4 u4 = *(const float4*)(ul + t * 64 + lq * 16);
          const float y0 = gelu_t(y[m][0] + dd.x * u4.x), y1 = gelu_t(y[m][1] + dd.y * u4.y);
          const float y2 = gelu_t(y[m][2] + dd.z * u4.z), y3 = gelu_t(y[m][3] + dd.w * u4.w);
          uint2 o; o.x = pack2(y0, y1); o.y = pack2(y2, y3);
          *(uint2*)(zb + (size_t)(row0 + t) * 2048 + 1536 + g * 16 + lq * 4) = o;
        }
      }
      __syncthreads();
    }
    if (valid && last) {
      if (smp) { p.out[O_S5RS + (b * 32 + g) * 64 + lane] = xr; p.out[O_S5IS + (b * 32 + g) * 64 + lane] = xi; }
      else { p.out[O_S5RP + (b * 32 + g) * 64 + lane] = xr; p.out[O_S5IP + (b * 32 + g) * 64 + lane] = xi; }
    }
  }
}

__device__ __forceinline__ void phase_mix_a(const Params& p, char* lds) {
  { const int hf = threadIdx.x >> 8; for (int pr = blockIdx.x; pr < 16 * 33; pr += gridDim.x) gla_chunk(p, pr * 2 + hf, 0, lds + hf * HALF_LDS); }
  __syncthreads();
  s5_pass1(p, lds);
}
__device__ __forceinline__ void phase_mix_b(const Params& p) {
  float* slocb = (float*)(p.ws + WS_SCR + SCR_SLOC);
  const float* dec = (const float*)(p.ws + WS_DEC);
  const int gt = blockIdx.x * 512 + threadIdx.x, ngt = gridDim.x * 512;
#pragma unroll 1
  for (int idx = gt; idx < 32 * 8192; idx += ngt) {
    const int bh = idx >> 13, ed = idx & 8191, e = ed >> 6, d = ed & 63;
    float S = 0.f;
#pragma unroll 1
    for (int c0 = 0; c0 < 33; c0 += 11) {
      float tmp[11], dc[11];
#pragma unroll
      for (int q = 0; q < 11; ++q) { tmp[q] = slocb[(size_t)(bh * 33 + c0 + q) * 8192 + ed]; dc[q] = dec[(bh * 33 + c0 + q) * 64 + d]; }
#pragma unroll
      for (int q = 0; q < 11; ++q) { slocb[(size_t)(bh * 33 + c0 + q) * 8192 + ed] = S; S = dc[q] * S + tmp[q]; }
    }
    p.out[O_GLAP + (size_t)(bh * 64 + d) * 128 + e] = S;
  }
  s5_pass2(p);
}
__device__ __forceinline__ void phase_mix_c(const Params& p, char* lds) {
  const int hf = threadIdx.x >> 8;
  for (int pr = blockIdx.x; pr < 16 * 33; pr += gridDim.x) gla_chunk(p, pr * 2 + hf, 1, lds + hf * HALF_LDS);
  __syncthreads();
  for (int pr = blockIdx.x; pr < 256; pr += gridDim.x) gla_sample(p, pr * 2 + hf, lds + hf * HALF_LDS);
  __syncthreads();
  s5_pass3(p, lds);
}

__device__ __forceinline__ void phase_glu(const Params& p, char* lds) {
  int tid, lane, w, wr, wc, lr, lq; TREFRESH();
  const bf16_t* zp = (const bf16_t*)(p.ws + WS_ZERO);
  bf16_t* zb = (bf16_t*)(p.ws + WS_SCR + SCR_ZB);
  const bf16_t* W = (const bf16_t*)p.out + W_GLU;
  TileSched ts; ts.init(65, 2);
  for (int ti = ts.local; ti < ts.ntiles; ti += ts.nloc) {
    int mt, nt; ts.get(ti, mt, nt);
    f32x4 acc[8][4];
    gemm_tile256(acc, (const bf16_t*)zb + 1536, [&](int i) { return (mt * 256 + i) * 2048; }, W + (size_t)nt * 256 * 512, 512, 512, lds, zp);
    TREFRESH(); int zE = 0; asm volatile("" : "+v"(zE));
#pragma unroll
    for (int m = 0; m < 8; ++m) {
      const int row = mt * 256 + (m >> 2) * 128 + wr * 64 + (m & 3) * 16 + lr + zE;
#pragma unroll
      for (int n = 0; n < 4; ++n) {
        const int col = nt * 256 + (n >> 1) * 128 + wc * 32 + (n & 1) * 16 + lq * 4 + zE;
        const uint2 y2 = *(const uint2*)(zb + (size_t)row * 2048 + 1536 + col);
        const float4 bg = *(const float4*)(p.in[23] + col);
        uint2 o;
        o.x = pack2(lo2f(y2.x) * sigm(acc[m][n][0] + bg.x), hi2f(y2.x) * sigm(acc[m][n][1] + bg.y));
        o.y = pack2(lo2f(y2.y) * sigm(acc[m][n][2] + bg.z), hi2f(y2.y) * sigm(acc[m][n][3] + bg.w));
        *(uint2*)(zb + (size_t)row * 2048 + 1024 + col) = o;
      }
      asm volatile("" ::: "memory");
    }
  }
}

__device__ __forceinline__ void phase_resid(const Params& p, char* lds, const bf16_t* A, int lda, const bf16_t* W, int K, int tkbase, int site) {
  int tid, lane, w, wr, wc, lr, lq; TREFRESH();
  const bf16_t* zp = (const bf16_t*)(p.ws + WS_ZERO);
  bf16_t* xb = (bf16_t*)(p.ws + WS_XB);
  float* ssq = (float*)(p.ws + WS_SSQ2) + (size_t)site * 4 * NR;
  const int ks = K >> 8;
  const bool isunit = (int)blockIdx.x < 4 * ks;
  const int unt = (int)blockIdx.x / ks, uksi = (int)blockIdx.x - unt * ks;
  unsigned* tick = (unsigned*)(p.ws + WS_FLAG) + 4352 + tkbase;
  if (isunit) {
    const int nt = unt, k0 = uksi * 256;
    f32x4 acc[8][4];
    gemm_tile256(acc, A + k0, [&](int i) { return (16384 + i) * lda; }, W + (size_t)nt * 256 * K + k0, K, 256, lds, zp);
    TREFRESH(); int zE = 0; asm volatile("" : "+v"(zE));
    float* slab = (float*)(p.ws + WS_SLAB) + (size_t)(nt * ks + uksi) * 65536;
#pragma unroll
    for (int m = 0; m < 8; ++m)
#pragma unroll
      for (int n = 0; n < 4; ++n)
        *(float4*)(slab + ((m >> 2) * 128 + wr * 64 + (m & 3) * 16 + lr + zE) * 256 + (n >> 1) * 128 + wc * 32 + (n & 1) * 16 + lq * 4 + zE) = make_float4(acc[m][n][0], acc[m][n][1], acc[m][n][2], acc[m][n][3]);
    asm volatile("s_waitcnt vmcnt(0)" ::: "memory");
    __syncthreads();
    if (tid == 0) {
      __builtin_amdgcn_fence(__ATOMIC_RELEASE, "agent");
      asm volatile("s_waitcnt vmcnt(0)" ::: "memory");
      (void)xb_add(&tick[nt], 1u);
    }
  }
  TileSched ts; ts.init(64, 4);
  for (int ti = ts.local; ti < ts.ntiles; ti += ts.nloc) {
    int mt, nt; ts.get(ti, mt, nt);
    f32x4 acc[8][4];
    gemm_tile256(acc, A, [&](int i) { return (mt * 256 + i) * lda; }, W + (size_t)nt * 256 * K, K, K, lds, zp);
    TREFRESH(); int zE = 0; asm volatile("" : "+v"(zE));
#pragma unroll
    for (int m = 0; m < 8; ++m) {
      const int row = mt * 256 + (m >> 2) * 128 + wr * 64 + (m & 3) * 16 + lr + zE;
      float ss0 = 0.f, ss1 = 0.f;
#pragma unroll
      for (int n = 0; n < 4; ++n) {
        const int col = nt * 256 + (n >> 1) * 128 + wc * 32 + (n & 1) * 16 + lq * 4 + zE;
        const uint2 u = *(const uint2*)(xb + (size_t)row * 1024 + col);
        uint2 o; o.x = pack2(lo2f(u.x) + acc[m][n][0], hi2f(u.x) + acc[m][n][1]); o.y = pack2(lo2f(u.y) + acc[m][n][2], hi2f(u.y) + acc[m][n][3]);
        *(uint2*)(xb + (size_t)row * 1024 + col) = o;
        const float y0 = lo2f(o.x), y1 = hi2f(o.x), y2 = lo2f(o.y), y3 = hi2f(o.y);
        const float q = y0 * y0 + y1 * y1 + y2 * y2 + y3 * y3;
        if (n < 2) ss0 += q; else ss1 += q;
      }
      float ssw = ss0 + ss1;
      ssw += __shfl_xor(ssw, 16); ssw += __shfl_xor(ssw, 32);
      if (lq == 0) ((float*)lds)[((m >> 2) * 128 + wr * 64 + (m & 3) * 16 + lr) * 4 + wc] = ssw;
      asm volatile("" ::: "memory");
    }
    __syncthreads();
    if (tid < 256) { const float4 q4 = *(const float4*)((const float*)lds + tid * 4); ssq[(size_t)nt * NR + mt * 256 + tid] = (q4.x + q4.y) + (q4.z + q4.w); }
    __syncthreads();
  }
  if (isunit) {
    const int nt = unt;
    if (tid == 0) {
      XB_SPIN(xb_ld(&tick[nt]) < (unsigned)ks, (unsigned*)(p.ws + WS_BAR));
      __builtin_amdgcn_fence(__ATOMIC_ACQUIRE, "agent");
      asm volatile("s_waitcnt vmcnt(0)" ::: "memory");
    }
    __syncthreads();
    const int rpb = (256 + ks - 1) / ks, r0 = uksi * rpb, r1 = r0 + rpb < 256 ? r0 + rpb : 256;
    const float* sl = (const float*)(p.ws + WS_SLAB) + (size_t)(nt * ks) * 65536;
    for (int rr = r0 + (tid >> 6); rr < r1; rr += 8) {
      const int c4 = tid & 63, row = 16384 + rr, col = nt * 256 + c4 * 4;
      const float* s4 = sl + rr * 256 + c4 * 4;
      float4 sum = make_float4(0.f, 0.f, 0.f, 0.f);
      for (int q = 0; q < ks; ++q) { const float4 v = *(const float4*)(s4 + (size_t)q * 65536); sum.x += v.x; sum.y += v.y; sum.z += v.z; sum.w += v.w; }
      const uint2 u2 = *(const uint2*)(xb + (size_t)row * 1024 + col);
      uint2 o;
      o.x = pack2(lo2f(u2.x) + sum.x, hi2f(u2.x) + sum.y);
      o.y = pack2(lo2f(u2.y) + sum.z, hi2f(u2.y) + sum.w);
      *(uint2*)(xb + (size_t)row * 1024 + col) = o;
      const float y0 = lo2f(o.x), y1 = hi2f(o.x), y2 = lo2f(o.y), y3 = hi2f(o.y);
      float ss = wave_sum(y0 * y0 + y1 * y1 + y2 * y2 + y3 * y3);
      if (c4 == 0) ssq[(size_t)nt * NR + row] = ss;
    }
  }
}

__device__ __forceinline__ void phase_ffn_up(const Params& p, char* lds, int layer, int site) {
  int tid, lane, w, wr, wc, lr, lq; TREFRESH();
  const bf16_t* zp = (const bf16_t*)(p.ws + WS_ZERO);
  const bf16_t* xb = (const bf16_t*)(p.ws + WS_XB);
  const bf16_t* W = (const bf16_t*)p.out + W_UP + (size_t)layer * 5632 * 1024;
  const float* ssq = (const float*)(p.ws + WS_SSQ2) + (size_t)site * 4 * NR;
  bf16_t* act = (bf16_t*)(p.ws + WS_SCR + SCR_ACT);
  const float* cw = p.in[37] + (size_t)layer * 3 * 2816;
  const float* cb = p.in[38] + (size_t)layer * 2816;
  const float* cache = p.in[7] + (size_t)layer * 128 * 2 * 2816;
  float* srs = (float*)(lds + LDS_SRS);
  TileSched ts; ts.init_even(67, 22);
  for (int ti = ts.local; ti < ts.ntiles; ti += ts.nloc) {
    int mt, nt; ts.get_even(ti, mt, nt);
    const bool smp = mt == 66;
    const int gbase = 254 * mt - 2;
    auto growf = [&](int i) -> int { if (smp) return i < 128 ? NPR + i : -1; const int g = gbase + i; return (g >= 0 && g < NPR) ? g : -1; };
    if (tid < 256) { const int gr = growf(tid); srs[tid] = gr >= 0 ? row_rstd(ssq, gr) : 0.f; }
    f32x4 acc[8][4];
    gemm_tile256(acc, xb, [&](int i) -> int { int gr = smp ? NPR + (i < 128 ? i : 127) : gbase + i; gr = gr < 0 ? 0 : (gr > NR - 1 ? NR - 1 : gr); return gr * 1024; }, W + (size_t)nt * 256 * 1024, 1024, 1024, lds, zp);
    TREFRESH(); int zE = 0; asm volatile("" : "+v"(zE));
    {
      int z0 = 0; asm volatile("" : "+v"(z0));
      bf16_t* gl = (bf16_t*)lds + z0; bf16_t* vl = gl + 256 * 136;
#pragma unroll
      for (int m = 0; m < 8; ++m) {
        const int r = (m >> 2) * 128 + wr * 64 + (m & 3) * 16 + lr + zE;
        const float rs = srs[r];
#pragma unroll
        for (int n = 0; n < 2; ++n) {
          const int ch = wc * 32 + n * 16 + lq * 4;
          uint2 og, ov;
          og.x = pack2_sw(acc[m][n][0] * rs, acc[m][n][1] * rs); og.y = pack2_sw(acc[m][n][2] * rs, acc[m][n][3] * rs);
          ov.x = pack2_sw(acc[m][n + 2][0] * rs, acc[m][n + 2][1] * rs); ov.y = pack2_sw(acc[m][n + 2][2] * rs, acc[m][n + 2][3] * rs);
          *(uint2*)(gl + r * 136 + ch) = og;
          *(uint2*)(vl + r * 136 + ch) = ov;
        }
        asm volatile("" ::: "memory");
      }
      __syncthreads();
      float wv[4][8];
      {
        const int gch0 = nt * 128 + (tid & 15) * 8;
#pragma unroll
        for (int q = 0; q < 4; ++q) {
          const float* sp = (q < 3 ? cw + q * 2816 : cb) + gch0;
          const float4 x0 = *(const float4*)sp, x1 = *(const float4*)(sp + 4);
          wv[q][0] = x0.x; wv[q][1] = x0.y; wv[q][2] = x0.z; wv[q][3] = x0.w; wv[q][4] = x1.x; wv[q][5] = x1.y; wv[q][6] = x1.z; wv[q][7] = x1.w;
        }
      }
#pragma unroll 2
      for (int it = 0; it < 8; ++it) {
        const int idx = tid + 512 * it, r = idx >> 4, c8 = (idx & 15) * 8, gch = nt * 128 + c8;
        const int g = gbase + r;
        const bool valid = smp ? (r < 128) : (r >= 2 && g < NPR);
        if (valid) {
          const int grow = smp ? NPR + r : g;
          const int b = smp ? 0 : g / TP, t = smp ? 2 : g - b * TP;
          float g0[8], g1[8], g2[8], vv[8];
          {
            const uint4 u = *(const uint4*)(gl + r * 136 + c8);
            g2[0] = lo2f(u.x); g2[1] = hi2f(u.x); g2[2] = lo2f(u.y); g2[3] = hi2f(u.y); g2[4] = lo2f(u.z); g2[5] = hi2f(u.z); g2[6] = lo2f(u.w); g2[7] = hi2f(u.w);
            const uint4 v4 = *(const uint4*)(vl + r * 136 + c8);
            vv[0] = lo2f(v4.x); vv[1] = hi2f(v4.x); vv[2] = lo2f(v4.y); vv[3] = hi2f(v4.y); vv[4] = lo2f(v4.z); vv[5] = hi2f(v4.z); vv[6] = lo2f(v4.w); vv[7] = hi2f(v4.w);
          }
          if (smp) {
            const float4 a0 = *(const float4*)(cache + (size_t)(r * 2 + 0) * 2816 + gch), a1 = *(const float4*)(cache + (size_t)(r * 2 + 0) * 2816 + gch + 4);
            const float4 b0 = *(const float4*)(cache + (size_t)(r * 2 + 1) * 2816 + gch), b1 = *(const float4*)(cache + (size_t)(r * 2 + 1) * 2816 + gch + 4);
            g0[0] = a0.x; g0[1] = a0.y; g0[2] = a0.z; g0[3] = a0.w; g0[4] = a1.x; g0[5] = a1.y; g0[6] = a1.z; g0[7] = a1.w;
            g1[0] = b0.x; g1[1] = b0.y; g1[2] = b0.z; g1[3] = b0.w; g1[4] = b1.x; g1[5] = b1.y; g1[6] = b1.z; g1[7] = b1.w;
          } else {
            uint4 u0 = make_uint4(0, 0, 0, 0), u1 = make_uint4(0, 0, 0, 0);
            if (t >= 2) u0 = *(const uint4*)(gl + (r - 2) * 136 + c8);
            if (t >= 1) u1 = *(const uint4*)(gl + (r - 1) * 136 + c8);
            g0[0] = lo2f(u0.x); g0[1] = hi2f(u0.x); g0[2] = lo2f(u0.y); g0[3] = hi2f(u0.y); g0[4] = lo2f(u0.z); g0[5] = hi2f(u0.z); g0[6] = lo2f(u0.w); g0[7] = hi2f(u0.w);
            g1[0] = lo2f(u1.x); g1[1] = hi2f(u1.x); g1[2] = lo2f(u1.y); g1[3] = hi2f(u1.y); g1[4] = lo2f(u1.z); g1[5] = hi2f(u1.z); g1[6] = lo2f(u1.w); g1[7] = hi2f(u1.w);
          }
          float ov[8];
#pragma unroll
          for (int e = 0; e < 8; ++e) ov[e] = gelu_t(wv[3][e] + wv[0][e] * g0[e] + wv[1][e] * g1[e] + wv[2][e] * g2[e]) * vv[e];
          *(uint4*)(act + (size_t)grow * 2816 + gch) = make_uint4(pack2(ov[0], ov[1]), pack2(ov[2], ov[3]), pack2(ov[4], ov[5]), pack2(ov[6], ov[7]));
          if (smp) {
            float* oc = p.out + O_FCS + (size_t)((layer * 128 + r) * 2) * 2816 + gch;
            *(float4*)oc = make_float4(g1[0], g1[1], g1[2], g1[3]); *(float4*)(oc + 4) = make_float4(g1[4], g1[5], g1[6], g1[7]);
            *(float4*)(oc + 2816) = make_float4(g2[0], g2[1], g2[2], g2[3]); *(float4*)(oc + 2820) = make_float4(g2[4], g2[5], g2[6], g2[7]);
          } else if (t >= TP - 2) {
            float* oc = p.out + O_FCP + (size_t)((layer * 8 + b) * 2 + (t - (TP - 2))) * 2816 + gch;
            *(float4*)oc = make_float4(g2[0], g2[1], g2[2], g2[3]); *(float4*)(oc + 4) = make_float4(g2[4], g2[5], g2[6], g2[7]);
          }
        }
      }
    }
    __syncthreads();
  }
}

__device__ __forceinline__ void phase_g5(const Params& p, char* lds) {
  int tid, lane, w, wr, wc, lr, lq; TREFRESH();
  const bf16_t* zp = (const bf16_t*)(p.ws + WS_ZERO);
  const bf16_t* xb = (const bf16_t*)(p.ws + WS_XB);
  const bf16_t* W = (const bf16_t*)p.out + W_IN1;
  const float* ssq = (const float*)(p.ws + WS_SSQ2) + (size_t)2 * 4 * NR;
  bf16_t* xr = (bf16_t*)(p.ws + WS_SCR + SCR_XR);
  bf16_t* gg = (bf16_t*)(p.ws + WS_SCR + SCR_GG);
  float* srs = (float*)(lds + LDS_SRS);
  if (blockIdx.x < 48) {
    const int u = blockIdx.x, nt = u >> 2, ksi = u & 3, k0 = ksi * 256;
    f32x4 acc[8][4];
    gemm_tile256(acc, xb + k0, [&](int i) { return (16384 + i) * 1024; }, W + (size_t)nt * 256 * 1024 + k0, 1024, 256, lds, zp);
    TREFRESH(); int zE = 0; asm volatile("" : "+v"(zE));
    float* slab = (float*)(p.ws + WS_SLAB) + (size_t)(nt * 4 + ksi) * 65536;
#pragma unroll
    for (int m = 0; m < 8; ++m)
#pragma unroll
      for (int n = 0; n < 4; ++n)
        *(float4*)(slab + ((m >> 2) * 128 + wr * 64 + (m & 3) * 16 + lr + zE) * 256 + (n >> 1) * 128 + wc * 32 + (n & 1) * 16 + lq * 4 + zE) = make_float4(acc[m][n][0], acc[m][n][1], acc[m][n][2], acc[m][n][3]);
    asm volatile("s_waitcnt vmcnt(0)" ::: "memory");
    __syncthreads();
    if (tid == 0) {
      __builtin_amdgcn_fence(__ATOMIC_RELEASE, "agent");
      asm volatile("s_waitcnt vmcnt(0)" ::: "memory");
      (void)xb_add((unsigned*)(p.ws + WS_FLAG) + 4416 + nt, 1u);
    }
  }
  TileSched ts; ts.init(64, 12);
  for (int ti = ts.local; ti < ts.ntiles; ti += ts.nloc) {
    int mt, nt; ts.get(ti, mt, nt);
    if (tid < 256) srs[tid] = row_rstd(ssq, mt * 256 + tid);
    f32x4 acc[8][4];
    gemm_tile256(acc, xb, [&](int i) { return (mt * 256 + i) * 1024; }, W + (size_t)nt * 256 * 1024, 1024, 1024, lds, zp);
    TREFRESH(); int zE = 0; asm volatile("" : "+v"(zE));
#pragma unroll
    for (int m = 0; m < 8; ++m) {
      const int r = (m >> 2) * 128 + wr * 64 + (m & 3) * 16 + lr + zE, row = mt * 256 + r;
      const float rs = srs[r];
#pragma unroll
      for (int n = 0; n < 4; ++n) {
        const int col = nt * 256 + (n >> 1) * 128 + wc * 32 + (n & 1) * 16 + lq * 4 + zE;
        const f32x4 v = acc[m][n] * rs;
        uint2 o;
        if (nt < 6) {
          o.x = pack2(gelu_t(v[0]), gelu_t(v[1])); o.y = pack2(gelu_t(v[2]), gelu_t(v[3]));
          *(uint2*)(gg + (size_t)row * 1536 + col) = o;
        } else {
          o.x = pack2(v[0], v[1]); o.y = pack2(v[2], v[3]);
          *(uint2*)(xr + (size_t)row * 1536 + (col - 1536)) = o;
        }
      }
    }
    __syncthreads();
  }
  if (blockIdx.x < 48) {
    const int u = blockIdx.x, nt = u >> 2, ksi = u & 3;
    if (tid == 0) {
      XB_SPIN(xb_ld((unsigned*)(p.ws + WS_FLAG) + 4416 + nt) < 4u, (unsigned*)(p.ws + WS_BAR));
      __builtin_amdgcn_fence(__ATOMIC_ACQUIRE, "agent");
      asm volatile("s_waitcnt vmcnt(0)" ::: "memory");
    }
    __syncthreads();
    const float* sl = (const float*)(p.ws + WS_SLAB) + (size_t)(nt * 4) * 65536;
    for (int rr = ksi * 64 + (tid >> 6); rr < ksi * 64 + 64; rr += 8) {
      const int c4 = tid & 63, row = 16384 + rr, col = nt * 256 + c4 * 4;
      const float* s4 = sl + rr * 256 + c4 * 4;
      const float4 s0 = *(const float4*)s4, s1 = *(const float4*)(s4 + 65536), s2 = *(const float4*)(s4 + 131072), s3 = *(const float4*)(s4 + 196608);
      const float rs = row_rstd(ssq, row);
      const float v0 = ((s0.x + s1.x) + (s2.x + s3.x)) * rs, v1 = ((s0.y + s1.y) + (s2.y + s3.y)) * rs;
      const float v2 = ((s0.z + s1.z) + (s2.z + s3.z)) * rs, v3 = ((s0.w + s1.w) + (s2.w + s3.w)) * rs;
      uint2 o;
      if (nt < 6) {
        o.x = pack2(gelu_t(v0), gelu_t(v1)); o.y = pack2(gelu_t(v2), gelu_t(v3));
        *(uint2*)(gg + (size_t)row * 1536 + col) = o;
      } else {
        o.x = pack2(v0, v1); o.y = pack2(v2, v3);
        *(uint2*)(xr + (size_t)row * 1536 + (col - 1536)) = o;
      }
    }
  }
}

__device__ __forceinline__ void rglru_item(const Params& p, int item, char* lds) {
  const int tid = threadIdx.x & 255, lane = tid & 63, w = tid >> 6, lr = lane & 15, lq = lane >> 4;
  const bool smp = item >= 4352;
  const int pass = 1;
  int b, tl, n, half;
  if (smp) { const int it = item - 4352; b = 0; tl = 0; n = it >> 1; half = it & 1; }
  else { tl = item >> 8; const int chain = item & 255; b = chain >> 5; n = (chain >> 1) & 15; half = chain & 1; }
  unsigned* flags = (unsigned*)(p.ws + WS_FLAG);
  unsigned* barw = (unsigned*)(p.ws + WS_BAR);
  const bf16_t* xr = (const bf16_t*)(p.ws + WS_SCR + SCR_XR);
  bf16_t* gg = (bf16_t*)(p.ws + WS_SCR + SCR_GG);
  const bf16_t* Wg = (const bf16_t*)p.out + W_GATE;
  const bf16_t* zp = (const bf16_t*)(p.ws + WS_ZERO);
  float* carr = (float*)(p.ws + WS_XLOC);
  char* At = lds; char* Ba = lds + 26624; char* Bx = lds + 36608;
  char* xs = lds + 46592;
  float* sa = (float*)lds; float* sbx = (float*)(lds + 24576);
  float* segA = (float*)(lds + 49152); float* segH = (float*)(lds + 49920); float* carry = (float*)(lds + 50688);
  char* ggl = lds + 51200;
  float* par = (float*)(lds + 71744);
  const int t0 = tl * 128;
  const int nvalid = smp ? 128 : (TP - t0 < 128 ? TP - t0 : 128);
  if (tid < 156) {
    const float* src;
    const int q = tid;
    if (q < 96) { const int wt = q / 24; src = p.in[27] + wt * 1536 + n * 96 + (q - wt * 24) * 4; }
    else if (q < 120) src = p.in[28] + n * 96 + (q - 96) * 4;
    else if (q < 132) src = p.in[30] + n * 96 + half * 48 + (q - 120) * 4;
    else if (q < 144) src = p.in[32] + n * 96 + half * 48 + (q - 132) * 4;
    else src = (const float*)(p.ws + WS_NSP) + n * 96 + half * 48 + (q - 144) * 4;
    __builtin_amdgcn_global_load_lds((const unsigned*)src, (unsigned*)((char*)par + q * 16), 16, 0, 0);
  }
  for (int q = tid; q < 1248; q += 256) {
    const int mat = q >= 624 ? 1 : 0, q2 = q - mat * 624, d = q2 / 13, ch = q2 - d * 13;
    const bf16_t* src = Wg + (size_t)((mat * 16 + n) * 96 + half * 48 + d) * 96 + (ch < 12 ? ch : 0) * 8;
    __builtin_amdgcn_global_load_lds((const unsigned*)src, (unsigned*)(Ba + q * 16), 16, 0, 0);
  }
  if (!smp) {
    for (int q = tid; q < 1572; q += 256) {
      const int r = q / 12, ch = q - r * 12, t = t0 + r - 3;
      const bf16_t* src = (t >= 0 && t < TP) ? xr + (size_t)(b * TP + t) * 1536 + n * 96 + ch * 8 : zp;
      __builtin_amdgcn_global_load_lds((const unsigned*)src, (unsigned*)(xs + q * 16), 16, 0, 0);
    }
  }
  asm volatile("s_waitcnt vmcnt(0)" ::: "memory");
  __syncthreads();
#pragma unroll 2
  for (int i = 0; i < 6; ++i) {
    const int idx = tid + 256 * i, r = idx / 12, ch8 = idx - r * 12, c0 = n * 96 + ch8 * 8;
    float xc[8];
    if (r < nvalid) {
      const float4 b0 = *(const float4*)(par + 384 + ch8 * 8), b1 = *(const float4*)(par + 384 + ch8 * 8 + 4);
      xc[0] = b0.x; xc[1] = b0.y; xc[2] = b0.z; xc[3] = b0.w; xc[4] = b1.x; xc[5] = b1.y; xc[6] = b1.z; xc[7] = b1.w;
#pragma unroll
      for (int wt = 0; wt < 4; ++wt) {
        float xv[8];
        if (smp && wt < 3) {
          const float4 a0 = *(const float4*)(p.in[6] + (size_t)(r * 3 + wt) * 1536 + c0), a1 = *(const float4*)(p.in[6] + (size_t)(r * 3 + wt) * 1536 + c0 + 4);
          xv[0] = a0.x; xv[1] = a0.y; xv[2] = a0.z; xv[3] = a0.w; xv[4] = a1.x; xv[5] = a1.y; xv[6] = a1.z; xv[7] = a1.w;
        } else {
          uint4 u;
          if (smp) u = *(const uint4*)(xr + (size_t)(NPR + r) * 1536 + c0);
          else u = *(const uint4*)(xs + (r + wt) * 192 + ch8 * 16);
          xv[0] = lo2f(u.x); xv[1] = hi2f(u.x); xv[2] = lo2f(u.y); xv[3] = hi2f(u.y); xv[4] = lo2f(u.z); xv[5] = hi2f(u.z); xv[6] = lo2f(u.w); xv[7] = hi2f(u.w);
        }
        const float4 w0 = *(const float4*)(par + wt * 96 + ch8 * 8), w1 = *(const float4*)(par + wt * 96 + ch8 * 8 + 4);
        xc[0] += w0.x * xv[0]; xc[1] += w0.y * xv[1]; xc[2] += w0.z * xv[2]; xc[3] += w0.w * xv[3];
        xc[4] += w1.x * xv[4]; xc[5] += w1.y * xv[5]; xc[6] += w1.z * xv[6]; xc[7] += w1.w * xv[7];
      }
    } else {
#pragma unroll
      for (int e = 0; e < 8; ++e) xc[e] = 0.f;
    }
    *(uint4*)(At + r * 208 + ch8 * 16) = make_uint4(pack2(xc[0], xc[1]), pack2(xc[2], xc[3]), pack2(xc[4], xc[5]), pack2(xc[6], xc[7]));
  }
  __syncthreads();
  if (pass == 1 && !smp) {
    for (int q = tid; q < 768; q += 256) {
      const int r = q / 6, c = q - r * 6;
      const bf16_t* src = r < nvalid ? gg + (size_t)(b * TP + t0 + r) * 1536 + n * 96 + half * 48 + c * 8 : zp;
      __builtin_amdgcn_global_load_lds((const unsigned*)src, (unsigned*)(ggl + q * 16), 16, 0, 0);
    }
  }
  f32x4 aa[2][3], ax[2][3];
#pragma unroll
  for (int m = 0; m < 2; ++m)
#pragma unroll
    for (int q = 0; q < 3; ++q) { aa[m][q] = (f32x4){0.f, 0.f, 0.f, 0.f}; ax[m][q] = (f32x4){0.f, 0.f, 0.f, 0.f}; }
#pragma unroll
  for (int s2 = 0; s2 < 3; ++s2) {
    bf16x8 a[2];
#pragma unroll
    for (int m = 0; m < 2; ++m) a[m] = *(const bf16x8*)(At + (32 * w + 16 * m + lr) * 208 + (s2 * 4 + lq) * 16);
#pragma unroll
    for (int q = 0; q < 3; ++q) {
      const bf16x8 ba = *(const bf16x8*)(Ba + (16 * q + lr) * 208 + (s2 * 4 + lq) * 16);
      const bf16x8 bx = *(const bf16x8*)(Bx + (16 * q + lr) * 208 + (s2 * 4 + lq) * 16);
#pragma unroll
      for (int m = 0; m < 2; ++m) { aa[m][q] = mfma16(ba, a[m], aa[m][q]); ax[m][q] = mfma16(bx, a[m], ax[m][q]); }
    }
  }
  uint2 xcv[2][3];
#pragma unroll
  for (int m = 0; m < 2; ++m)
#pragma unroll
    for (int q = 0; q < 3; ++q) xcv[m][q] = *(const uint2*)(At + (32 * w + 16 * m + lr) * 208 + (half * 48 + 16 * q + lq * 4) * 2);
  float4 pba[3], pbx[3], plm[3];
#pragma unroll
  for (int q = 0; q < 3; ++q) {
    pba[q] = *(const float4*)(par + 480 + 16 * q + lq * 4);
    pbx[q] = *(const float4*)(par + 528 + 16 * q + lq * 4);
    plm[q] = *(const float4*)(par + 576 + 16 * q + lq * 4);
  }
  __syncthreads();
#pragma unroll
  for (int m = 0; m < 2; ++m) {
    const int row = 32 * w + 16 * m + lr;
#pragma unroll
    for (int q = 0; q < 3; ++q) {
      const int d0 = 16 * q + lq * 4;
      const float bav[4] = {pba[q].x, pba[q].y, pba[q].z, pba[q].w}, bxv[4] = {pbx[q].x, pbx[q].y, pbx[q].z, pbx[q].w}, lmv[4] = {plm[q].x, plm[q].y, plm[q].z, plm[q].w};
      const float xcf[4] = {lo2f(xcv[m][q].x), hi2f(xcv[m][q].x), lo2f(xcv[m][q].y), hi2f(xcv[m][q].y)};
      float av[4], bv[4];
#pragma unroll
      for (int e = 0; e < 4; ++e) {
        const float r_ = sigm(aa[m][q][e] + bav[e]);
        const float i_ = sigm(ax[m][q][e] + bxv[e]);
        const float la = r_ * lmv[e];
        float a = __expf(la);
        float bxx = __builtin_sqrtf(fmaxf(1.f - a * a, 0.f)) * (i_ * xcf[e]);
        if (row >= nvalid) { a = 1.f; bxx = 0.f; }
        av[e] = a; bv[e] = bxx;
      }
      *(float4*)(sa + row * 48 + d0) = make_float4(av[0], av[1], av[2], av[3]);
      *(float4*)(sbx + row * 48 + d0) = make_float4(bv[0], bv[1], bv[2], bv[3]);
    }
  }
  __syncthreads();
  if (smp) {
    for (int idx = tid; idx < 128 * 48; idx += 256) {
      const int row = idx / 48, ch = idx - row * 48, cgl = n * 96 + half * 48 + ch;
      const float hh = sa[idx] * p.in[5][row * 1536 + cgl] + sbx[idx];
      p.out[O_HS + row * 1536 + cgl] = hh;
      const size_t go = (size_t)(NPR + row) * 1536 + cgl;
      gg[go] = f2bf(hh * bf2f(gg[go]));
    }
  } else {
    const int ch = tid % 48, seg = tid / 48;
    if (tid < 192) {
      float A = 1.f, H = 0.f;
#pragma unroll 8
      for (int r = seg * 32; r < seg * 32 + 32; ++r) { const float a = sa[r * 48 + ch]; H = a * H + sbx[r * 48 + ch]; A *= a; }
      segA[seg * 48 + ch] = A; segH[seg * 48 + ch] = H;
    }
    asm volatile("s_waitcnt vmcnt(0)" ::: "memory");
    __syncthreads();
    {
      float At_ = 1.f, Ht_ = 0.f;
      if (tid < 48) {
#pragma unroll
        for (int s2 = 0; s2 < 4; ++s2) { Ht_ = segA[s2 * 48 + tid] * Ht_ + segH[s2 * 48 + tid]; At_ *= segA[s2 * 48 + tid]; }
      }
      if (tl > 0 && tid == 0) XB_SPIN(xb_ld(&flags[item - 256]) == 0u, barw);
      __syncthreads();
      if (tid < 48) {
        const int cgl = n * 96 + half * 48 + tid;
        float h0 = 0.f;
        if (tl > 0) h0 = __hip_atomic_load(&carr[(size_t)((b * 17 + tl - 1) * 32 + n * 2 + half) * 64 + tid], __ATOMIC_RELAXED, __HIP_MEMORY_SCOPE_AGENT);
        carry[tid] = h0;
        const float hend = At_ * h0 + Ht_;
        if (tl < 16) __hip_atomic_store(&carr[(size_t)((b * 17 + tl) * 32 + n * 2 + half) * 64 + tid], hend, __ATOMIC_RELAXED, __HIP_MEMORY_SCOPE_AGENT);
        else p.out[O_HP + b * 1536 + cgl] = hend;
      }
      asm volatile("s_waitcnt vmcnt(0)" ::: "memory");
      __syncthreads();
      if (tid == 0 && tl < 16) (void)xb_add(&flags[item], 1u);
    }
    if (tid < 192) {
      float hin = carry[ch];
      for (int s2 = 0; s2 < seg; ++s2) hin = segA[s2 * 48 + ch] * hin + segH[s2 * 48 + ch];
      const int cgl = n * 96 + half * 48 + ch;
#pragma unroll 8
      for (int r = seg * 32; r < seg * 32 + 32; ++r) {
        hin = sa[r * 48 + ch] * hin + sbx[r * 48 + ch];
        if (r < nvalid) gg[(size_t)(b * TP + t0 + r) * 1536 + cgl] = f2bf(hin * bf2f(*(const bf16_t*)(ggl + r * 96 + ch * 2)));
      }
    }
  }
  if (pass == 1) {
    if (!smp) {
      if (tl == 16 && half == 0 && tid < 96) {
#pragma unroll
        for (int wv = 0; wv < 3; ++wv) p.out[O_RCP + (b * 3 + wv) * 1536 + n * 96 + tid] = bf2f(xr[(size_t)(b * TP + TP - 3 + wv) * 1536 + n * 96 + tid]);
      }
    } else if (half == 0) {
      for (int idx = tid; idx < 128 * 96; idx += 256) {
        const int s2 = idx / 96, cc_ = idx - s2 * 96, cgl = n * 96 + cc_;
        p.out[O_RCS + (size_t)(s2 * 3 + 0) * 1536 + cgl] = p.in[6][(size_t)(s2 * 3 + 1) * 1536 + cgl];
        p.out[O_RCS + (size_t)(s2 * 3 + 1) * 1536 + cgl] = p.in[6][(size_t)(s2 * 3 + 2) * 1536 + cgl];
        p.out[O_RCS + (size_t)(s2 * 3 + 2) * 1536 + cgl] = bf2f(xr[(size_t)(NPR + s2) * 1536 + cgl]);
      }
    }
  }
  __syncthreads();
}

__device__ __forceinline__ void phase_final(const Params& p) {
  const int tid = threadIdx.x, lane = tid & 63;
  const bf16_t* xres = (const bf16_t*)(p.ws + WS_XB);
  const float* ssq = (const float*)(p.ws + WS_SSQ2);
  const int gw = blockIdx.x * 8 + (tid >> 6), nw = gridDim.x * 8;
  for (int r = gw; r < NR; r += nw) {
    float* dst;
    if (r >= NPR) dst = p.out + O_YS + (size_t)(r - NPR) * 1024;
    else { const int b = r / TP, t = r - b * TP; if (t < 16) continue; dst = p.out + O_YP + ((size_t)b * 2048 + (t - 16)) * 1024; }
    float s = lane < 4 ? ssq[(size_t)lane * NR + r] : 0.f;
    s = wave_sum(s);
    const float rstd = rsqrtf(s * (1.f / 1024.f) + EPSN);
    const uint2* src = (const uint2*)(xres + (size_t)r * 1024);
    const float4* nf = (const float4*)p.in[40];
#pragma unroll
    for (int j = 0; j < 4; ++j) {
      const uint2 u = src[lane + 64 * j];
      const float4 v = make_float4(lo2f(u.x), hi2f(u.x), lo2f(u.y), hi2f(u.y)), g = nf[lane + 64 * j];
      __builtin_nontemporal_store((f32x4){v.x * rstd * g.x, v.y * rstd * g.y, v.z * rstd * g.z, v.w * rstd * g.w}, (f32x4*)dst + lane + 64 * j);
    }
  }
}

__global__ void __launch_bounds__(512, 2) mega_kernel(Params p) {
  extern __shared__ __attribute__((aligned(16))) char lds[];
  cg::grid_group grid = cg::this_grid();
  const bf16_t* wb = (const bf16_t*)p.out;
  volatile LAS unsigned* xst_ = (volatile LAS unsigned*)(lds + LDS_ST);
  if (threadIdx.x < 4) xst_[threadIdx.x] = 0u;
  __syncthreads();
  XcdBarrier xbar = xcd_barrier_post((unsigned*)(p.ws + WS_BAR), xst_);
  if (p.ph_hi > 1000) grid.sync();
#define PH(k, body) if (p.ph_lo <= (k) && (k) < p.ph_hi) { body; } if (p.ph_lo <= (k) && (k) + 1 < p.ph_hi) xcd_barrier(xbar);
  PH(0, phase_prep(p, lds))
  PH(1, phase_g1(p, lds))
  PH(2, phase_mix_a(p, lds))
  PH(3, phase_mix_b(p))
  PH(4, phase_mix_c(p, lds))
  PH(5, phase_glu(p, lds))
  PH(6, phase_resid(p, lds, (const bf16_t*)(p.ws + WS_SCR + SCR_ZB) + 512, 2048, wb + W_OUT0, 1024, 0, 1))
  PH(7, phase_ffn_up(p, lds, 0, 1))
  PH(8, phase_resid(p, lds, (const bf16_t*)(p.ws + WS_SCR + SCR_ACT), 2816, wb + W_DOWN, 2816, 16, 2))
  PH(9, phase_g5(p, lds))
  PH(10, for (int pr = blockIdx.x; pr < 2192; pr += gridDim.x) rglru_item(p, pr * 2 + (threadIdx.x >> 8), lds + (threadIdx.x >> 8) * HALF_LDS))
  PH(11, phase_resid(p, lds, (const bf16_t*)(p.ws + WS_SCR + SCR_GG), 1536, wb + W_OUT1, 1536, 32, 3))
  PH(12, phase_ffn_up(p, lds, 1, 3))
  PH(13, phase_resid(p, lds, (const bf16_t*)(p.ws + WS_SCR + SCR_ACT), 2816, wb + W_DOWN + (size_t)1024 * 2816, 2816, 48, 0))
  PH(14, phase_final(p))
}

extern "C" void kernel_launch(void* const* d_in, const int* in_sizes, int n_in, void* d_out, int out_size, void* d_ws, size_t ws_size, hipStream_t stream) {
  static int grid_blocks = 0;
  if (!grid_blocks) {
    int dev = 0, cus = 0, per_cu = 0;
    hipGetDevice(&dev);
    hipDeviceGetAttribute(&cus, hipDeviceAttributeMultiprocessorCount, dev);
    hipFuncSetAttribute((const void*)mega_kernel, hipFuncAttributeMaxDynamicSharedMemorySize, LDS_BYTES);
    hipOccupancyMaxActiveBlocksPerMultiprocessor(&per_cu, (const void*)mega_kernel, NTHR, LDS_BYTES);
    if (per_cu > 1) per_cu = 1;
    if (per_cu < 1) per_cu = 1;
    grid_blocks = cus * per_cu;
    if (n_in != 41 || ws_size < WS_NEED) fprintf(stderr, "kernel_launch: unexpected n_in %d or ws_size %zu (need %llu)\n", n_in, ws_size, (unsigned long long)WS_NEED);
  }
  Params p{};
  for (int i = 0; i < 41; ++i) p.in[i] = (const float*)d_in[i];
  p.out = (float*)d_out;
  p.ws = (char*)d_ws;
  (void)hipMemsetAsync((char*)d_ws + WS_BAR, 0, 16384, stream);
  (void)hipMemsetAsync((char*)d_ws + WS_FLAG, 0, 20480, stream);
#if MK_MULTI
  for (int ph = 0; ph < NPHASE; ++ph) {
    p.ph_lo = ph; p.ph_hi = ph + 1;
    hipLaunchKernelGGL(mega_kernel, dim3(grid_blocks), dim3(NTHR), LDS_BYTES, stream, p);
  }
#else
  p.ph_lo = 0; p.ph_hi = NPHASE;
  void* args[] = {&p};
  hipError_t e = hipLaunchCooperativeKernel((const void*)mega_kernel, dim3(grid_blocks), dim3(NTHR), args, LDS_BYTES, stream);
  if (e != hipSuccess) fprintf(stderr, "cooperative launch failed: %s (grid %d)\n", hipGetErrorString(e), grid_blocks);
#endif
}
```
